# Optimizing an MI355X kernel written in HIP

```python
import math
import jax, jax.numpy as jnp
from jax import lax
import numpy as np

D_MODEL = 1024
BATCH = 2
SEQ = 8192
DEPTH = 4

N_A = DEPTH // 2
N_B = DEPTH - N_A
CONV_WIDTH = 31
N_HEADS = 8
HEAD_DIM = 64
V_DIM = 2 * HEAD_DIM
QK_WIDTH = 2 * N_HEADS * HEAD_DIM
V_WIDTH = N_HEADS * V_DIM
N_BUCKETS = 32
MAX_DISTANCE = 128
Q_BLOCK = 128
N_EXPERTS = 16
N_GROUPS = 4
EXPERTS_PER_GROUP = N_EXPERTS // N_GROUPS
TOP_K = 2
D_EXPERT = 512
ALPHA = (2.0 * DEPTH) ** 0.25
BETA = (8.0 * DEPTH) ** -0.25
LN_EPS = 1e-5

kernel_name = "yoco_conformer_diffattn_grouped_moe"


def layer_norm(x, g, b):
    xf = x.astype(jnp.float32)
    mu = jnp.mean(xf, -1, keepdims=True)
    var = jnp.mean(jnp.square(xf - mu), -1, keepdims=True)
    return ((xf - mu) * lax.rsqrt(var + LN_EPS) * g.astype(jnp.float32) + b.astype(jnp.float32)).astype(x.dtype)


def conformer_conv(x, w_pw1, b_pw1, w_dw, b_dw, g, b, w_pw2, b_pw2):
    h = x @ w_pw1 + b_pw1
    a, gate = jnp.split(h, 2, axis=-1)
    h = a * jax.nn.sigmoid(gate)
    h = lax.conv_general_dilated(
        h, w_dw[:, None, :].astype(h.dtype), window_strides=(1,),
        padding=[(CONV_WIDTH - 1, 0)],
        dimension_numbers=("NWC", "WIO", "NWC"),
        feature_group_count=D_MODEL) + b_dw
    h = jax.nn.silu(layer_norm(h, g, b))
    return h @ w_pw2 + b_pw2


def t5_bucket(n):
    n = jnp.maximum(n, 0)
    max_exact = N_BUCKETS // 2
    nf = jnp.maximum(n, 1).astype(jnp.float32)
    large = max_exact + (jnp.log(nf / max_exact) / math.log(MAX_DISTANCE / max_exact)
                         * (N_BUCKETS - max_exact)).astype(jnp.int32)
    large = jnp.minimum(large, N_BUCKETS - 1)
    return jnp.where(n < max_exact, n, large)


def diff_attention(x, k1, k2, v, w_q, lam_params, subln_g, w_o, rel_bias, layer_idx):
    bsz, seq, _ = x.shape
    n_blk = seq // Q_BLOCK
    lambda_init = 0.8 - 0.6 * math.exp(-0.3 * layer_idx)
    lp = lam_params.astype(jnp.float32)
    lam = jnp.exp(jnp.sum(lp[0] * lp[1])) - jnp.exp(jnp.sum(lp[2] * lp[3])) + lambda_init
    q = (x @ w_q).reshape(bsz, n_blk, Q_BLOCK, 2, N_HEADS, HEAD_DIM)
    q = jnp.transpose(q, (3, 1, 0, 4, 2, 5))
    scale = HEAD_DIM ** -0.5
    k_pos = jnp.arange(seq)

    def block(args):
        qb1, qb2, i = args
        q_pos = i * Q_BLOCK + jnp.arange(Q_BLOCK)
        rel = q_pos[:, None] - k_pos[None, :]
        bias = jnp.transpose(jnp.take(rel_bias, t5_bucket(rel), axis=0), (2, 0, 1)).astype(jnp.float32)
        causal = rel >= 0

        def probs(qb, k):
            s = jnp.einsum("bhqd,bhkd->bhqk", qb, k).astype(jnp.float32) * scale + bias
            return jax.nn.softmax(jnp.where(causal, s, -jnp.inf), axis=-1)

        a = probs(qb1, k1) - lam * probs(qb2, k2)
        return jnp.einsum("bhqk,bhkv->bhqv", a.astype(v.dtype), v)

    out = lax.map(block, (q[0], q[1], jnp.arange(n_blk)))
    out = jnp.transpose(out, (1, 0, 3, 2, 4)).reshape(bsz, seq, N_HEADS, V_DIM)
    of = out.astype(jnp.float32)
    of = of * lax.rsqrt(jnp.mean(jnp.square(of), -1, keepdims=True) + LN_EPS) * subln_g.astype(jnp.float32)
    of = of * (1.0 - lambda_init)
    return of.astype(x.dtype).reshape(bsz, seq, V_WIDTH) @ w_o


def grouped_moe(x, router_w, router_bias, w_gate, w_up, w_down):
    bsz, seq, d = x.shape
    x2 = x.reshape(-1, d)
    aff = jax.nn.sigmoid((x2 @ router_w).astype(jnp.float32))
    sel = (aff + router_bias.astype(jnp.float32)).reshape(-1, N_GROUPS, EXPERTS_PER_GROUP)
    grp_score = jnp.sum(lax.top_k(sel, 2)[0], -1)
    g_idx = jnp.argmax(grp_score, -1)
    in_grp = jnp.take_along_axis(sel, g_idx[:, None, None], axis=1)[:, 0]
    _, local = lax.top_k(in_grp, TOP_K)
    e_idx = g_idx[:, None] * EXPERTS_PER_GROUP + local
    w = jnp.take_along_axis(aff, e_idx, -1)
    w = w / jnp.sum(w, -1, keepdims=True)
    gates = jnp.sum(jax.nn.one_hot(e_idx, N_EXPERTS, dtype=jnp.float32) * w[..., None], axis=1)

    def step(acc, ew):
        g_e, wg_e, wu_e, wd_e = ew
        h = jax.nn.silu(x2 @ wg_e) * (x2 @ wu_e)
        return acc + (h @ wd_e) * g_e[:, None].astype(x2.dtype), None

    out, _ = lax.scan(step, jnp.zeros_like(x2), (gates.T, w_gate, w_up, w_down))
    return out.reshape(bsz, seq, d)


def setup_inputs(seed: int = 0) -> dict:
    key = jax.random.key(seed)
    ks = jax.random.split(key, 32)
    nrm = jax.random.normal
    D, f32 = D_MODEL, jnp.float32
    w_kv_k = nrm(ks[9], (D, QK_WIDTH), f32) * D ** -0.5
    w_kv_v = nrm(ks[10], (D, V_WIDTH), f32) * D ** -0.5 * BETA
    return {
        "x": nrm(ks[0], (BATCH, SEQ, D), f32),
        "a_w_pw1": nrm(ks[1], (N_A, D, 2 * D), f32) * D ** -0.5,
        "a_b_pw1": 0.02 * nrm(ks[2], (N_A, 2 * D), f32),
        "a_w_dw": nrm(ks[3], (N_A, CONV_WIDTH, D), f32) * CONV_WIDTH ** -0.5,
        "a_b_dw": 0.02 * nrm(ks[4], (N_A, D), f32),
        "a_ln_g": 1.0 + 0.02 * nrm(ks[5], (N_A, D), f32),
        "a_ln_b": 0.02 * nrm(ks[6], (N_A, D), f32),
        "a_w_pw2": nrm(ks[7], (N_A, D, D), f32) * D ** -0.5 * BETA,
        "a_b_pw2": 0.02 * nrm(ks[8], (N_A, D), f32),
        "w_kv": jnp.concatenate([w_kv_k, w_kv_v], axis=1),
        "b_w_q": nrm(ks[11], (N_B, D, QK_WIDTH), f32) * D ** -0.5,
        "b_lambda": 0.1 * nrm(ks[12], (N_B, 4, HEAD_DIM), f32),
        "b_subln_g": 1.0 + 0.02 * nrm(ks[13], (N_B, V_DIM), f32),
        "b_w_o": nrm(ks[14], (N_B, V_WIDTH, D), f32) * V_WIDTH ** -0.5 * BETA,
        "rel_bias": 0.5 * nrm(ks[15], (N_BUCKETS, N_HEADS), f32),
        "ln_mix_g": 1.0 + 0.02 * nrm(ks[16], (DEPTH, D), f32),
        "ln_mix_b": 0.02 * nrm(ks[17], (DEPTH, D), f32),
        "ln_ffn_g": 1.0 + 0.02 * nrm(ks[18], (DEPTH, D), f32),
        "ln_ffn_b": 0.02 * nrm(ks[19], (DEPTH, D), f32),
        "router_w": nrm(ks[20], (D, N_EXPERTS), f32) * D ** -0.5,
        "router_bias": 0.01 * nrm(ks[21], (N_EXPERTS,), f32),
        "moe_w_gate": nrm(ks[22], (DEPTH, N_EXPERTS, D, D_EXPERT), f32) * D ** -0.5,
        "moe_w_up": nrm(ks[23], (DEPTH, N_EXPERTS, D, D_EXPERT), f32) * D ** -0.5,
        "moe_w_down": nrm(ks[24], (DEPTH, N_EXPERTS, D_EXPERT, D), f32) * D_EXPERT ** -0.5 * BETA,
    }


def reference(x, a_w_pw1, a_b_pw1, a_w_dw, a_b_dw, a_ln_g, a_ln_b, a_w_pw2, a_b_pw2,
              w_kv, b_w_q, b_lambda, b_subln_g, b_w_o, rel_bias,
              ln_mix_g, ln_mix_b, ln_ffn_g, ln_ffn_b,
              router_w, router_bias, moe_w_gate, moe_w_up, moe_w_down):
    bsz, seq, _ = x.shape
    k1 = k2 = v = None
    for l in range(DEPTH):
        if l < N_A:
            mix = conformer_conv(x, a_w_pw1[l], a_b_pw1[l], a_w_dw[l], a_b_dw[l],
                                 a_ln_g[l], a_ln_b[l], a_w_pw2[l], a_b_pw2[l])
        else:
            if l == N_A:
                kv = x @ w_kv
                k = kv[..., :QK_WIDTH].reshape(bsz, seq, 2, N_HEADS, HEAD_DIM)
                k = jnp.transpose(k, (2, 0, 3, 1, 4))
                k1, k2 = k[0], k[1]
                v = jnp.transpose(kv[..., QK_WIDTH:].reshape(bsz, seq, N_HEADS, V_DIM), (0, 2, 1, 3))
            j = l - N_A
            mix = diff_attention(x, k1, k2, v, b_w_q[j], b_lambda[j], b_subln_g[j], b_w_o[j], rel_bias, l)
        x = layer_norm(ALPHA * x + mix, ln_mix_g[l], ln_mix_b[l])
        ffn = grouped_moe(x, router_w, router_bias, moe_w_gate[l], moe_w_up[l], moe_w_down[l])
        x = layer_norm(ALPHA * x + ffn, ln_ffn_g[l], ln_ffn_b[l])
    return x
```

```cpp
#include <hip/hip_runtime.h>
#include <cstdio>
#include <cstdint>
#include <cmath>
namespace pg8 {
#define PG8_LAS __attribute__((address_space(3)))
typedef unsigned short bf16_t;
typedef short bf16x8 __attribute__((ext_vector_type(8)));
typedef float f32x4 __attribute__((ext_vector_type(4)));
typedef unsigned u32x4 __attribute__((ext_vector_type(4)));
constexpr int BM = 256, BK = 64, HALF = 128, HTB = HALF * BK * 2  , STAGE_BYTES = 8 * HTB, NXCD = 8, WGM = 8;

__host__ __device__ __forceinline__ int lds_byte(int r, int c) { const int st = (r >> 4) * 2 + (c >> 5), rr = r & 15, cc = c & 31, ob = rr * 64 + cc * 2; return st * 1024 + (ob ^ (((ob >> 9) & 1) << 5)); }
__host__ __device__ __forceinline__ void stage_rc(int b, int& R, int& C) { const int st = b / 1024, sb = b % 1024, swz = sb ^ (((sb >> 9) & 1) << 5); R = (st >> 1) * 16 + swz / 64; C = (st & 1) * 32 + (swz % 64) / 2; }
__host__ __device__ __forceinline__ int perm32(int rho) { const int n = rho >> 4, i = rho & 15; return 8 * (i >> 2) + 4 * n + (i & 3); }

struct Unit { int pm, pn; size_t boff; };
struct Gemm { const bf16_t* A; const bf16_t* Bt; int M, N, K; };

struct StaticOrder {
    int nM, nN, nwg, G, c;
    __host__ __device__ void init(int M, int N, int G_, int c_) { nM = M / BM; nN = N / BM; nwg = nM * nN; G = G_; c = c_; }
    __host__ __device__ bool next(int i, Unit& u) const {
        const long L = (long)i * G + c; if (L >= nwg) return false;
        int wgid = (int)L; { const int q = nwg / NXCD, r = nwg % NXCD, xcd = wgid % NXCD, off = wgid / NXCD; wgid = (xcd < r ? xcd * (q + 1) : r * (q + 1) + (xcd - r) * q) + off; }
        const int nig = WGM * nN, gid = wgid / nig, fm = gid * WGM, gsz = (nM - fm) < WGM ? (nM - fm) : WGM;
        u.pm = fm + ((wgid % nig) % gsz); u.pn = (wgid % nig) / gsz; u.boff = 0; return true;
    }
    __device__ __forceinline__ void a_ready(const Unit&) const {}
    __device__ __forceinline__ void done(const Unit&) const {}
};

__device__ __forceinline__ unsigned cvt_pk_bf16(float lo, float hi) { unsigned r; asm volatile("v_cvt_pk_bf16_f32 %0, %1, %2" : "=v"(r) : "v"(lo), "v"(hi)); return r; }
typedef float f32x2 __attribute__((ext_vector_type(2)));
__device__ __forceinline__ f32x2 gelu_pk(f32x2 v) {
    const f32x2 av = __builtin_elementwise_abs(v), d = av * 0.2316418882f + 1.0f;
    f32x2 t; t.x = __builtin_amdgcn_rcpf(d.x); t.y = __builtin_amdgcn_rcpf(d.y);
    f32x2 q = t * 0.5307027145f + (-0.7265760135f); q = q * t + 0.7107068705f; q = q * t + (-0.142248368f); q = q * t + 0.127414796f; q = q * t;
    const f32x2 s = (v * v) * (-0.72134752044f);
    f32x2 e; e.x = __builtin_amdgcn_exp2f(s.x); e.y = __builtin_amdgcn_exp2f(s.y);
    const f32x2 m = v * (q * e), r = v - m;
    f32x2 o; o.x = v.x < 0.f ? m.x : r.x; o.y = v.y < 0.f ? m.y : r.y; return o;
}

template <int ACT  > struct EpiBf16 {
    static constexpr bool PERM = true, AFTER_DRAIN = false; static_assert(ACT == 0 || ACT == 1, "EpiBf16: ACT is 0 (none) or 1 (gelu_pk)");
    bf16_t* O; int ldc; const float* bias; int split_cols; size_t split_stride; float scale0;
    __device__ __forceinline__ void operator()(const f32x4 (&acc)[2][2][4][2], const Unit& u, int wr, int wc, int fr, int fq) const {
        const int row0 = u.pm * BM + wr * 64 + fr; int colt = u.pn * BM; bf16_t* base = O;
        float sc = 1.f; if (split_cols) { const int t = colt / split_cols; base += (size_t)t * split_stride; colt -= t * split_cols; if (t == 0) sc = scale0; }
        const int col0 = colt + wc * 32 + 8 * fq, bcol0 = u.pn * BM + wc * 32 + 8 * fq;
        f32x4 bv[2][2];
#pragma unroll
        for (int bj = 0; bj < 2; ++bj)
#pragma unroll
            for (int n = 0; n < 2; ++n) bv[bj][n] = bias ? *(const f32x4*)(bias + bcol0 + bj * HALF + 4 * n) : (f32x4){0.f, 0.f, 0.f, 0.f};
#pragma unroll
        for (int ai = 0; ai < 2; ++ai)
#pragma unroll
            for (int m = 0; m < 4; ++m) { bf16_t* rowp = base + (size_t)(row0 + ai * HALF + m * 16) * ldc + col0;
#pragma unroll
                for (int bj = 0; bj < 2; ++bj) { f32x4 v0 = acc[ai][bj][m][0] + bv[bj][0], v1 = acc[ai][bj][m][1] + bv[bj][1];
                    if (ACT == 1) { f32x2 a = gelu_pk((f32x2){v0[0], v0[1]}), b = gelu_pk((f32x2){v0[2], v0[3]}), c = gelu_pk((f32x2){v1[0], v1[1]}), d = gelu_pk((f32x2){v1[2], v1[3]});
                        v0 = (f32x4){a.x, a.y, b.x, b.y}; v1 = (f32x4){c.x, c.y, d.x, d.y}; }
                    v0 = v0 * sc; v1 = v1 * sc; u32x4 w; w.x = cvt_pk_bf16(v0[0], v0[1]); w.y = cvt_pk_bf16(v0[2], v0[3]); w.z = cvt_pk_bf16(v1[0], v1[1]); w.w = cvt_pk_bf16(v1[2], v1[3]);
                    *(u32x4*)(rowp + bj * HALF) = w; } }
    }
};

struct EpiF32 {
    static constexpr bool PERM = false, AFTER_DRAIN = false;
    float* C; int ldc; const float* bias;
    __device__ __forceinline__ void operator()(const f32x4 (&acc)[2][2][4][2], const Unit& u, int wr, int wc, int fr, int fq) const {
        const int row0 = u.pm * BM + wr * 64 + fr, col0 = u.pn * BM + wc * 32 + 4 * fq;
        f32x4 bv[2][2];
#pragma unroll
        for (int bj = 0; bj < 2; ++bj)
#pragma unroll
            for (int n = 0; n < 2; ++n) bv[bj][n] = bias ? *(const f32x4*)(bias + col0 + bj * HALF + n * 16) : (f32x4){0.f, 0.f, 0.f, 0.f};
#pragma unroll
        for (int ai = 0; ai < 2; ++ai)
#pragma unroll
            for (int m = 0; m < 4; ++m) { float* rowp = C + (size_t)(row0 + ai * HALF + m * 16) * ldc + col0;
#pragma unroll
                for (int bj = 0; bj < 2; ++bj)
#pragma unroll
                    for (int n = 0; n < 2; ++n) *(f32x4*)(rowp + bj * HALF + n * 16) = acc[ai][bj][m][n] + bv[bj][n]; }
    }
};
struct PanelStats {
    unsigned* xbuf;
    unsigned* cnt;
    unsigned* tmo;
    int ntn; float eps;
    unsigned code;
    __device__ __forceinline__ bool run(const f32x4 (&v)[2][2][4][2], const Unit& u, int wr, int wc, int fr, int fq, PG8_LAS unsigned char* lds, int wid, int lane) const {
        typedef float f32x2v __attribute__((ext_vector_type(2)));
        PG8_LAS f32x2v* P = (PG8_LAS f32x2v*)lds;
        PG8_LAS f32x2v* S = (PG8_LAS f32x2v*)(lds + 8192);
        PG8_LAS unsigned* flag = (PG8_LAS unsigned*)(lds + 8192 + 2048);
#pragma unroll
        for (int ai = 0; ai < 2; ++ai)
#pragma unroll
            for (int m = 0; m < 4; ++m) {
                float s = 0.f;
#pragma unroll
                for (int bj = 0; bj < 2; ++bj)
#pragma unroll
                    for (int n = 0; n < 2; ++n) { const f32x4 x = v[ai][bj][m][n]; s += (x[0] + x[1]) + (x[2] + x[3]); }
                s += __shfl_xor(s, 16); s += __shfl_xor(s, 32);
                const float mw = s * (1.0f / 64.0f); float q = 0.f;
#pragma unroll
                for (int bj = 0; bj < 2; ++bj)
#pragma unroll
                    for (int n = 0; n < 2; ++n) { const f32x4 d = v[ai][bj][m][n] - mw; q += (d[0] * d[0] + d[1] * d[1]) + (d[2] * d[2] + d[3] * d[3]); }
                q += __shfl_xor(q, 16); q += __shfl_xor(q, 32);
                if (fq == 0) P[(ai * HALF + wr * 64 + m * 16 + fr) * 4 + wc] = (f32x2v){mw, q};
            }
        asm volatile("s_waitcnt lgkmcnt(0)" ::: "memory"); __builtin_amdgcn_s_barrier(); asm volatile("" ::: "memory");
#if defined(BROKEN_EXCHANGE_NO_WAIT)
#warning BROKEN CONTROL BUILD: the row-statistics exchange does not wait; results are wrong by design
        if (blockIdx.x >= 64) { const long long t0_ = clock64(); while (clock64() - t0_ < 60000) __builtin_amdgcn_s_sleep(8); }
#endif
        const int row = wid * 32 + (lane & 31);
        if (lane < 32) {
            const f32x2v a = P[row * 4 + 0], b = P[row * 4 + 1], c = P[row * 4 + 2], d = P[row * 4 + 3];
            const float mt = (a.x + b.x + c.x + d.x) * 0.25f;
            const float da = a.x - mt, db = b.x - mt, dc = c.x - mt, dd = d.x - mt;
            const float m2 = (a.y + b.y) + (c.y + d.y) + 64.0f * ((da * da + db * db) + (dc * dc + dd * dd));
            unsigned long long* slot = (unsigned long long*)xbuf + ((size_t)(u.pm * BM + row) * 4 + u.pn);
            __hip_atomic_store(slot, ((unsigned long long)__float_as_uint(m2) << 32) | __float_as_uint(mt), __ATOMIC_RELAXED, __HIP_MEMORY_SCOPE_AGENT);
        }
        asm volatile("s_waitcnt vmcnt(0)" ::: "memory");
        if (lane == 0) __hip_atomic_fetch_add(cnt + 64 * u.pm, 1u, __ATOMIC_RELAXED, __HIP_MEMORY_SCOPE_AGENT);
        if (wid == 0) {
            bool dead = false; const unsigned long long t0 = __builtin_amdgcn_s_memrealtime(); const unsigned want = 8u * (unsigned)ntn;
            for (;;) {
#if defined(BROKEN_EXCHANGE_NO_WAIT)
                break;
#endif
                if ((unsigned)__builtin_amdgcn_readfirstlane(__hip_atomic_load(cnt + 64 * u.pm, __ATOMIC_RELAXED, __HIP_MEMORY_SCOPE_AGENT)) >= want) break;
                if (__builtin_amdgcn_s_memrealtime() - t0 > 2000000ull) {
                    if (lane == 0) { unsigned expect = 0u; __hip_atomic_compare_exchange_strong(tmo + 1, &expect, code | (unsigned)(u.pm & 0xff), __ATOMIC_RELAXED, __ATOMIC_RELAXED, __HIP_MEMORY_SCOPE_AGENT);
                                     __hip_atomic_store(tmo, 1u, __ATOMIC_RELAXED, __HIP_MEMORY_SCOPE_AGENT); }
                    dead = true; break; }
                __builtin_amdgcn_s_sleep(2);
            }
            __builtin_amdgcn_fence(__ATOMIC_ACQUIRE, "agent");
            if (lane == 0) flag[0] = dead ? 1u : 0u;
        }
        asm volatile("s_waitcnt vmcnt(0) lgkmcnt(0)" ::: "memory"); __builtin_amdgcn_s_barrier(); asm volatile("" ::: "memory");
        const bool bad = flag[0] != 0u;
        if (lane < 32) {
            const unsigned long long* slot = (const unsigned long long*)xbuf + (size_t)(u.pm * BM + row) * 4; float mt[4], m2[4]; float ms = 0.f;
#pragma unroll
            for (int t = 0; t < 4; ++t) { if (t < ntn) { const unsigned long long w = __hip_atomic_load(slot + t, __ATOMIC_RELAXED, __HIP_MEMORY_SCOPE_AGENT); mt[t] = __uint_as_float((unsigned)w); m2[t] = __uint_as_float((unsigned)(w >> 32)); } else { mt[t] = 0.f; m2[t] = 0.f; } ms += mt[t]; }
            const float mean = ms / (float)ntn; float q = 0.f;
#pragma unroll
            for (int t = 0; t < 4; ++t) if (t < ntn) { const float dm = mt[t] - mean; q += m2[t] + 256.0f * dm * dm; }
            S[row] = (f32x2v){mean, 1.0f / sqrtf(q / (256.0f * (float)ntn) + eps)};
        }
        asm volatile("s_waitcnt lgkmcnt(0)" ::: "memory"); __builtin_amdgcn_s_barrier(); asm volatile("" ::: "memory");
        return bad;
    }
};
struct EpiLnRes {
    static constexpr bool PERM = false, AFTER_DRAIN = true;
    const float* base; float* out; int ldc; const float* bias; PanelStats st; unsigned poison;
    __device__ __forceinline__ void fused(f32x4 (&acc)[2][2][4][2], const Unit& u, int wr, int wc, int fr, int fq, PG8_LAS unsigned char* lds, int wid, int lane) const {
        typedef float f32x2v __attribute__((ext_vector_type(2)));
        const PG8_LAS f32x2v* S = (const PG8_LAS f32x2v*)(lds + 8192);
        const int col0 = u.pn * BM + wc * 32 + 4 * fq;
#pragma unroll
        for (int bj = 0; bj < 2; ++bj)
#pragma unroll
            for (int n = 0; n < 2; ++n) { const f32x4 bv = bias ? *(const f32x4*)(bias + col0 + bj * HALF + n * 16) : (f32x4){0.f, 0.f, 0.f, 0.f};
#pragma unroll
                for (int ai = 0; ai < 2; ++ai)
#pragma unroll
                    for (int m = 0; m < 4; ++m) acc[ai][bj][m][n] += bv; }
        f32x4 pre[4][2][2];
#pragma unroll
        for (int m = 0; m < 4; ++m) { const size_t off = (size_t)(u.pm * BM + wr * 64 + m * 16 + fr) * ldc + col0;
#pragma unroll
            for (int bj = 0; bj < 2; ++bj)
#pragma unroll
                for (int n = 0; n < 2; ++n) pre[m][bj][n] = *(const f32x4*)(base + off + bj * HALF + n * 16); }
        const bool bad = st.run(acc, u, wr, wc, fr, fq, lds, wid, lane) || poison != 0u;
        const float qnan = __builtin_nanf("");
#pragma unroll
        for (int ai = 0; ai < 2; ++ai)
#pragma unroll
            for (int m = 0; m < 4; ++m) { const int r = ai * HALF + wr * 64 + m * 16 + fr; const f32x2v sr = S[r]; const size_t off = (size_t)(u.pm * BM + r) * ldc + col0;
#pragma unroll
                for (int bj = 0; bj < 2; ++bj)
#pragma unroll
                    for (int n = 0; n < 2; ++n) { const f32x4 bs = ai == 0 ? pre[m][bj][n] : *(const f32x4*)(base + off + bj * HALF + n * 16); f32x4 o = bs + (acc[ai][bj][m][n] - sr.x) * sr.y;
                        if (bad) o = (f32x4){qnan, qnan, qnan, qnan}; *(f32x4*)(out + off + bj * HALF + n * 16) = o; }
                if (m & 1) asm volatile("" ::: "memory"); }
    }
};
struct EpiLnResLn {
    static constexpr bool PERM = false, AFTER_DRAIN = true;
    const float* base; float* out; bf16_t* xn; int ldc; const float* bias; PanelStats st1, st2; unsigned poison;
    __device__ __forceinline__ void fused(f32x4 (&acc)[2][2][4][2], const Unit& u, int wr, int wc, int fr, int fq, PG8_LAS unsigned char* lds, int wid, int lane) const {
        typedef float f32x2v __attribute__((ext_vector_type(2))); typedef unsigned u32x2v __attribute__((ext_vector_type(2)));
        const PG8_LAS f32x2v* S = (const PG8_LAS f32x2v*)(lds + 8192);
        const int col0 = u.pn * BM + wc * 32 + 4 * fq;
#pragma unroll
        for (int bj = 0; bj < 2; ++bj)
#pragma unroll
            for (int n = 0; n < 2; ++n) { const f32x4 bv = bias ? *(const f32x4*)(bias + col0 + bj * HALF + n * 16) : (f32x4){0.f, 0.f, 0.f, 0.f};
#pragma unroll
                for (int ai = 0; ai < 2; ++ai)
#pragma unroll
                    for (int m = 0; m < 4; ++m) acc[ai][bj][m][n] += bv; }
        bool bad = st1.run(acc, u, wr, wc, fr, fq, lds, wid, lane) || poison != 0u;
        const float qnan = __builtin_nanf("");
#pragma unroll
        for (int ai = 0; ai < 2; ++ai)
#pragma unroll
            for (int m = 0; m < 4; ++m) { const int r = ai * HALF + wr * 64 + m * 16 + fr; const f32x2v sr = S[r]; const size_t off = (size_t)(u.pm * BM + r) * ldc + col0;
#pragma unroll
                for (int bj = 0; bj < 2; ++bj)
#pragma unroll
                    for (int n = 0; n < 2; ++n) { const f32x4 bs = *(const f32x4*)(base + off + bj * HALF + n * 16); acc[ai][bj][m][n] = bs + (acc[ai][bj][m][n] - sr.x) * sr.y; }
                asm volatile("" : "+v"(acc[ai][0][m][0]), "+v"(acc[ai][0][m][1]), "+v"(acc[ai][1][m][0]), "+v"(acc[ai][1][m][1]));
                if (m & 1) asm volatile("" ::: "memory"); }
        const bool bad1 = bad;
        bad = st2.run(acc, u, wr, wc, fr, fq, lds, wid, lane) || bad;
#pragma unroll
        for (int ai = 0; ai < 2; ++ai)
#pragma unroll
            for (int m = 0; m < 4; ++m) { const int r = ai * HALF + wr * 64 + m * 16 + fr; const f32x2v sr = S[r]; const size_t off = (size_t)(u.pm * BM + r) * ldc + col0;
#pragma unroll
                for (int bj = 0; bj < 2; ++bj)
#pragma unroll
                    for (int n = 0; n < 2; ++n) { const f32x4 x1 = acc[ai][bj][m][n]; *(f32x4*)(out + off + bj * HALF + n * 16) = bad1 ? (f32x4){qnan, qnan, qnan, qnan} : x1;
                        const f32x4 o = (x1 - sr.x) * sr.y; u32x2v w; w.x = cvt_pk_bf16(o[0], o[1]); w.y = cvt_pk_bf16(o[2], o[3]);
                        if (bad) { w.x = 0x7fc07fc0u; w.y = 0x7fc07fc0u; } *(u32x2v*)(xn + off + bj * HALF + n * 16) = w; }
                asm volatile("" ::: "memory"); }
    }
};

template <class Epi, class Sched, bool ALIGN_EPI = false, bool SP2 = false>
__device__ __forceinline__ void gemm_phase(PG8_LAS unsigned char* lds, const Gemm g, const Sched& S, const Epi& E) {
    int tid_ = threadIdx.x; asm volatile("" : "+v"(tid_));
    const int tid = tid_, wid = __builtin_amdgcn_readfirstlane(tid >> 6), lane = tid & 63, wr = wid >> 2, wc = wid & 3, fr = lane & 15, fq = lane >> 4;
    const int K = g.K, nt = K / BK;
    unsigned voffA[2], voffB[2];
#pragma unroll
    for (int i = 0; i < 2; ++i) { int R, C; stage_rc(tid * 16 + i * 8192, R, C); const int Rb = Epi::PERM ? ((R & ~31) + perm32(R & 31)) : R;
        voffA[i] = (unsigned)(R * K + C) * 2u; voffB[i] = (unsigned)(Rb * K + C) * 2u; }
    const size_t kstep = (size_t)(BK * 2);
    const size_t hstep = (size_t)HALF * K * 2;
    const size_t tstep = 2 * hstep;
    const unsigned ldsw = (unsigned)wid * 1024u;
    const int aoff = lds_byte(wr * 64 + fr, fq * 8), boff = lds_byte(wc * 32 + fr, fq * 8);
#define PG8_SA(b, h) (((b) * 2 + (h)) * HTB)
#define PG8_SB(b, h) ((4 + (b) * 2 + (h)) * HTB)
#define PG8_STAGE(bufoff, gbase, voff) do { _Pragma("unroll") for (int _i = 0; _i < 2; ++_i) \
        __builtin_amdgcn_global_load_lds((const unsigned*)((const char*)(gbase) + (voff)[_i]), (PG8_LAS unsigned*)(lds + (bufoff) + ldsw + _i * 8192), 16, 0, 0); } while (0)
#define PG8_LDA(dst, b, h) do { _Pragma("unroll") for (int m = 0; m < 4; ++m) _Pragma("unroll") for (int k = 0; k < 2; ++k) dst[m][k] = *(const PG8_LAS bf16x8*)(lds + PG8_SA(b, h) + aoff + m * 2048 + k * 1024); } while (0)
#define PG8_LDB(dst, b, h) do { _Pragma("unroll") for (int n = 0; n < 2; ++n) _Pragma("unroll") for (int k = 0; k < 2; ++k) dst[n][k] = *(const PG8_LAS bf16x8*)(lds + PG8_SB(b, h) + boff + n * 2048 + k * 1024); } while (0)
#define PG8_MMA(ai, bj, At, Bt) do { __builtin_amdgcn_s_setprio(1); _Pragma("unroll") for (int m = 0; m < 4; ++m) _Pragma("unroll") for (int n = 0; n < 2; ++n) _Pragma("unroll") for (int k = 0; k < 2; ++k) \
        acc[ai][bj][m][n] = __builtin_amdgcn_mfma_f32_16x16x32_bf16(Bt[n][k], At[m][k], acc[ai][bj][m][n], 0, 0, 0); __builtin_amdgcn_s_setprio(0); } while (0)
#define PG8_WAIT_V(n) asm volatile("s_waitcnt vmcnt(" #n ")" ::: "memory")
#define PG8_WAIT_L(n) asm volatile("s_waitcnt lgkmcnt(" #n ")" ::: "memory")
#define PG8_BAR __builtin_amdgcn_s_barrier()
#define PG8_SCHED __builtin_amdgcn_sched_barrier(0)
    Unit cur, nxt; int ui = 0;
    if (!S.next(0, cur)) return;
    f32x4 acc[2][2][4][2];
#pragma unroll
    for (int a = 0; a < 2; ++a)
#pragma unroll
        for (int b = 0; b < 2; ++b)
#pragma unroll
            for (int m = 0; m < 4; ++m)
#pragma unroll
                for (int n = 0; n < 2; ++n) acc[a][b][m][n] = (f32x4){0.f, 0.f, 0.f, 0.f};
    bf16x8 At[4][2], B0[2][2], B1[2][2];
    const char* cA = (const char*)g.A + (size_t)cur.pm * tstep; const char* cB = (const char*)g.Bt + cur.boff + (size_t)cur.pn * tstep;
    S.a_ready(cur);
    if constexpr (SP2) {
        PG8_STAGE(PG8_SB(0, 0), cB, voffB); PG8_STAGE(PG8_SB(0, 1), cB + hstep, voffB); PG8_STAGE(PG8_SA(0, 0), cA, voffA); PG8_STAGE(PG8_SA(0, 1), cA + hstep, voffA);
        if (wr == 1) PG8_BAR;
        PG8_WAIT_V(2); PG8_BAR;
        PG8_STAGE(PG8_SB(1, 0), cB + kstep, voffB); PG8_STAGE(PG8_SA(1, 0), cA + kstep, voffA); PG8_STAGE(PG8_SB(1, 1), cB + hstep + kstep, voffB);
        PG8_WAIT_V(6); PG8_BAR;
    } else {
        PG8_STAGE(PG8_SB(0, 0), cB, voffB); PG8_STAGE(PG8_SA(0, 0), cA, voffA); PG8_STAGE(PG8_SB(0, 1), cB + hstep, voffB); PG8_STAGE(PG8_SA(0, 1), cA + hstep, voffA);
        if (wr == 1) PG8_BAR;
        PG8_WAIT_V(4); PG8_BAR;
        PG8_STAGE(PG8_SB(1, 0), cB + kstep, voffB); PG8_STAGE(PG8_SA(1, 0), cA + kstep, voffA); PG8_STAGE(PG8_SB(1, 1), cB + hstep + kstep, voffB);
        PG8_WAIT_V(6); PG8_BAR;
    }
    for (;;) {
        const bool has_next = S.next(ui + 1, nxt);
        const char* nA = has_next ? (const char*)g.A + (size_t)nxt.pm * tstep : cA; const char* nB = has_next ? (const char*)g.Bt + nxt.boff + (size_t)nxt.pn * tstep : cB;
        for (int t = 0; t < nt; t += 2) {
            const bool last = (t == nt - 2);
            const char* a1 = cA + (size_t)(t + 1) * kstep;
            const char* a2 = last ? nA : cA + (size_t)(t + 2) * kstep; const char* b2 = last ? nB : cB + (size_t)(t + 2) * kstep;
            const char* a3 = a2 + kstep; const char* b3 = b2 + kstep;
            if (last && has_next) S.a_ready(nxt);
            if constexpr (SP2) {
            PG8_LDB(B0, 0, 0); PG8_LDB(B1, 0, 1); PG8_SCHED; PG8_LDA(At, 0, 0); PG8_STAGE(PG8_SA(1, 1), a1 + hstep, voffA);
            PG8_WAIT_V(8); PG8_WAIT_L(0); PG8_BAR; PG8_MMA(0, 0, At, B0); PG8_MMA(0, 1, At, B1); PG8_BAR; PG8_SCHED;
            PG8_LDA(At, 0, 1); PG8_STAGE(PG8_SB(0, 0), b2, voffB); PG8_STAGE(PG8_SB(0, 1), b2 + hstep, voffB); PG8_STAGE(PG8_SA(0, 0), a2, voffA);
            PG8_WAIT_V(8); PG8_WAIT_L(0); PG8_BAR; PG8_MMA(1, 0, At, B0); PG8_MMA(1, 1, At, B1); PG8_BAR; PG8_SCHED;
            PG8_LDB(B0, 1, 0); PG8_LDB(B1, 1, 1); PG8_SCHED; PG8_LDA(At, 1, 0); PG8_STAGE(PG8_SA(0, 1), a2 + hstep, voffA);
            PG8_WAIT_V(8); PG8_WAIT_L(0); PG8_BAR; PG8_MMA(0, 0, At, B0); PG8_MMA(0, 1, At, B1); PG8_BAR; PG8_SCHED;
            PG8_LDA(At, 1, 1); PG8_STAGE(PG8_SB(1, 0), b3, voffB); PG8_STAGE(PG8_SB(1, 1), b3 + hstep, voffB); PG8_STAGE(PG8_SA(1, 0), a3, voffA);
            PG8_WAIT_V(8); PG8_WAIT_L(0); PG8_BAR; PG8_MMA(1, 0, At, B0); PG8_MMA(1, 1, At, B1); PG8_BAR; PG8_SCHED;
            } else {
            PG8_LDB(B0, 0, 0); PG8_SCHED; PG8_LDA(At, 0, 0); PG8_STAGE(PG8_SA(1, 1), a1 + hstep, voffA);
            PG8_WAIT_L(8); PG8_BAR; PG8_WAIT_L(0); PG8_MMA(0, 0, At, B0); PG8_BAR; PG8_SCHED;
            PG8_LDB(B1, 0, 1); PG8_STAGE(PG8_SB(0, 0), b2, voffB);
            PG8_BAR; PG8_WAIT_L(0); PG8_MMA(0, 1, At, B1); PG8_BAR;
            PG8_LDA(At, 0, 1); PG8_STAGE(PG8_SA(0, 0), a2, voffA);
            PG8_BAR; PG8_WAIT_L(0); PG8_MMA(1, 0, At, B0); PG8_BAR; PG8_SCHED;
            PG8_STAGE(PG8_SB(0, 1), b2 + hstep, voffB);
            PG8_WAIT_V(6); PG8_BAR; PG8_MMA(1, 1, At, B1); PG8_BAR;
            PG8_LDB(B0, 1, 0); PG8_SCHED; PG8_LDA(At, 1, 0); PG8_STAGE(PG8_SA(0, 1), a2 + hstep, voffA);
            PG8_WAIT_L(8); PG8_BAR; PG8_WAIT_L(0); PG8_MMA(0, 0, At, B0); PG8_BAR; PG8_SCHED;
            PG8_LDB(B1, 1, 1); PG8_STAGE(PG8_SB(1, 0), b3, voffB);
            PG8_BAR; PG8_WAIT_L(0); PG8_MMA(0, 1, At, B1); PG8_BAR;
            PG8_LDA(At, 1, 1); PG8_STAGE(PG8_SA(1, 0), a3, voffA);
            PG8_BAR; PG8_WAIT_L(0); PG8_MMA(1, 0, At, B0); PG8_BAR; PG8_SCHED;
            PG8_STAGE(PG8_SB(1, 1), b3 + hstep, voffB);
            PG8_WAIT_V(6); PG8_BAR; PG8_MMA(1, 1, At, B1); PG8_BAR;
            }
        }
        if constexpr (ALIGN_EPI) { if (wr == 0) PG8_BAR; }
        if constexpr (!Epi::AFTER_DRAIN) { E(acc, cur, wr, wc, fr, fq); S.done(cur); }
        if (!has_next) break;
#pragma unroll
        for (int a = 0; a < 2; ++a)
#pragma unroll
            for (int b = 0; b < 2; ++b)
#pragma unroll
                for (int m = 0; m < 4; ++m)
#pragma unroll
                    for (int n = 0; n < 2; ++n) acc[a][b][m][n] = (f32x4){0.f, 0.f, 0.f, 0.f};
        cur = nxt; cA = nA; cB = nB; ++ui;
        if constexpr (ALIGN_EPI) { if (wr == 1) PG8_BAR; }
    }
    PG8_WAIT_V(0);
    if constexpr (!ALIGN_EPI) { if (wr == 0) PG8_BAR; }
    PG8_BAR;
    if constexpr (Epi::AFTER_DRAIN) { E.fused(acc, cur, wr, wc, fr, fq, lds, wid, lane); S.done(cur); }
#undef PG8_SA
#undef PG8_SB
#undef PG8_STAGE
#undef PG8_LDA
#undef PG8_LDB
#undef PG8_MMA
#undef PG8_WAIT_V
#undef PG8_WAIT_L
#undef PG8_BAR
#undef PG8_SCHED
}
}

#define GAS __attribute__((address_space(1)))
#define LAS __attribute__((address_space(3)))
typedef unsigned short bf16;
typedef unsigned v4u __attribute__((ext_vector_type(4)));
typedef float f32x4 __attribute__((ext_vector_type(4)));
typedef short bf16x8 __attribute__((ext_vector_type(8)));
typedef GAS unsigned gu32;
typedef GAS unsigned long long gu64;
#define RLX_AGENT __ATOMIC_RELAXED, __HIP_MEMORY_SCOPE_AGENT
#define LDS_WAIT() asm volatile("s_waitcnt lgkmcnt(0)" ::: "memory")
#define VM_WAIT() asm volatile("s_waitcnt vmcnt(0)" ::: "memory")
__device__ __forceinline__ unsigned long long rt() { return __builtin_amdgcn_s_memrealtime(); }
__device__ __forceinline__ unsigned f2bf(float f) { unsigned u = __builtin_bit_cast(unsigned, f); return (u + 0x7fffu + ((u >> 16) & 1u)) >> 16; }
__device__ __forceinline__ unsigned pk2(float lo, float hi) { return f2bf(lo) | (f2bf(hi) << 16); }

#define XB_TMO      128
#define XB_XCNT(j)  (256  + 64 * (j))
#define XB_XSUB(j)  (1280 + 64 * (j))
#define XB_XGEN(j)  (2304 + 64 * (j))
#define XB_TOP      3328
#define XB_TOPGEN   3392
#define XCD_BAR_WORDS 3456
#define XB_SPIN_CAP (1u << 18)

__device__ __forceinline__ unsigned xb_ld(unsigned* p)              { return __hip_atomic_load(p, __ATOMIC_RELAXED, __HIP_MEMORY_SCOPE_AGENT); }
__device__ __forceinline__ unsigned xb_add(unsigned* p, unsigned v) { return __hip_atomic_fetch_add(p, v, __ATOMIC_RELAXED, __HIP_MEMORY_SCOPE_AGENT); }
__device__ __forceinline__ unsigned xb_xcc_id() { return (unsigned)__builtin_amdgcn_s_getreg((3 << 11) | 20) & 0xFu; }
#define XB_SPIN(cond, bar) do { unsigned _sp = 0; while (cond) { __builtin_amdgcn_s_sleep(1); \
    if ((++_sp & 255u) == 0u) { if (xb_ld(&(bar)[XB_TMO])) break; if (_sp > XB_SPIN_CAP) { atomicAdd(&(bar)[XB_TMO], 1u); break; } } } } while (0)

struct XcdBarrier {
    unsigned* bar; unsigned x;
    volatile LAS unsigned* st;
};

__device__ __forceinline__ XcdBarrier xcd_barrier_post(unsigned* bar, volatile LAS unsigned* st) {
    XcdBarrier b; b.bar = bar; b.x = xb_xcc_id(); b.st = st;
    if (threadIdx.x == 0) (void)xb_add(&bar[XB_XCNT(b.x)], 1u);
    return b;
}
__device__ __forceinline__ void xcd_barrier_complete(unsigned* bar, unsigned x, unsigned& nloc, unsigned& nx) {
    const unsigned G = gridDim.x * gridDim.y * gridDim.z;
    unsigned sum, cnt, mine, sp = 0u;
    for (;;) {
        sum = 0u; cnt = 0u; mine = 0u;
#pragma unroll
        for (unsigned j = 0; j < 16; ++j) { const unsigned c = xb_ld(&bar[XB_XCNT(j)]); sum += c; cnt += (c > 0u) ? 1u : 0u; mine = (j == x) ? c : mine; }
        if (sum == G) break;
        __builtin_amdgcn_s_sleep(1);
        if ((++sp & 255u) == 0u) { if (xb_ld(&bar[XB_TMO])) break; if (sp > XB_SPIN_CAP) { atomicAdd(&bar[XB_TMO], 1u); break; } }
    }
    nloc = mine > 0u ? mine : 1u; nx = cnt > 0u ? cnt : 1u;
}

__device__ __forceinline__ void xcd_barrier(const XcdBarrier& b) {
    asm volatile("s_waitcnt vmcnt(0)" ::: "memory");
    __syncthreads();
    if (threadIdx.x == 0) {
        unsigned* bar = b.bar;
        __builtin_amdgcn_s_waitcnt(0);
        unsigned nloc = b.st[0], nx = b.st[1];
        if (nloc == 0u) { xcd_barrier_complete(bar, b.x, nloc, nx); b.st[0] = nloc; b.st[1] = nx; }
        const unsigned old = xb_add(&bar[XB_XSUB(b.x)], 1u);
        const unsigned gen = old / nloc;
        if (old + 1u == (gen + 1u) * nloc) {
            __builtin_amdgcn_fence(__ATOMIC_RELEASE, "agent");
            asm volatile("s_waitcnt vmcnt(0)" ::: "memory");
            const unsigned og = xb_add(&bar[XB_TOP], 1u);
            const unsigned tg = og / nx;
            if (og + 1u == (tg + 1u) * nx) xb_add(&bar[XB_TOPGEN], 1u);
            else XB_SPIN(xb_ld(&bar[XB_TOPGEN]) == tg, bar);
            __builtin_amdgcn_fence(__ATOMIC_ACQUIRE, "agent");
            xb_add(&bar[XB_XGEN(b.x)], 1u);
            asm volatile("s_waitcnt vmcnt(0)" ::: "memory");
        } else {
            XB_SPIN(xb_ld(&bar[XB_XGEN(b.x)]) == gen, bar);
            __builtin_amdgcn_fence(__ATOMIC_ACQUIRE, "agent");
            asm volatile("s_waitcnt vmcnt(0)" ::: "memory");
        }
    }
    __syncthreads();
}


constexpr int NWAVES = 8, NTHR = 512;
constexpr int T = 16384, D = 1024, SEQ = 8192, NE = 16, DE = 512, NLAYER = 4, NSELF = 2, CONVW = 31;
constexpr int NH = 8, HD = 64, VD = 128;
constexpr float LN_EPS = 1e-5f;
constexpr float ALPHA = 1.6817928305074290f;
constexpr int XG_ROWS = 36864;
constexpr int MAXTILES = XG_ROWS / 256;

constexpr size_t MiB = 1u << 20;
constexpr size_t WS_CTL = 0, CTL_ZERO_BYTES = 1 * MiB;
constexpr size_t WS_PW1T = 2 * MiB;
constexpr size_t WS_PW2T = 10 * MiB;
constexpr size_t WS_WQ0T = 14 * MiB;
constexpr size_t WS_WKVT = 16 * MiB;
constexpr size_t WS_WQ1T = 20 * MiB;
constexpr size_t WS_WOT  = 22 * MiB;
constexpr size_t WS_ROUT = 26 * MiB;
constexpr size_t WS_WGUT = 32 * MiB;
constexpr size_t WS_WDT  = 64 * MiB;
constexpr size_t WS_X1   = 80 * MiB;
constexpr size_t WS_XBF  = 144 * MiB;
constexpr size_t WS_KB   = 176 * MiB;
constexpr size_t WS_VB   = 208 * MiB;
constexpr size_t WS_SCR  = 240 * MiB;
constexpr size_t WS_H1   = WS_SCR;
constexpr size_t WS_US   = WS_SCR + 64 * MiB;
constexpr size_t WS_Q    = WS_SCR;
constexpr size_t WS_O12  = WS_SCR + 32 * MiB;
constexpr size_t WS_MIX  = WS_SCR + 160 * MiB;
constexpr size_t WS_XG   = WS_SCR;
constexpr size_t WS_HU   = WS_SCR + 72 * MiB;
constexpr size_t WS_HH   = WS_SCR + 144 * MiB;
constexpr size_t WS_Y    = WS_SCR + 180 * MiB;
constexpr size_t WS_END  = WS_SCR + 252 * MiB;
constexpr int CW_TMO = 0, CW_CODE = 1;
constexpr int CW_BAR = 4096;
constexpr int CW_CNT = 16384;

constexpr int RING_OFF = 0, RING_BYTES = 131072;
constexpr int LDSCTL_OFF = RING_BYTES;
constexpr int LDS_BYTES = 147456;
constexpr int LI_OFF = 32, LI_NT = 49, LI_TEXP = 64, LI_CNT = 224;

__constant__ unsigned char c_bucket[128] = {0, 1, 2, 3, 4, 5, 6, 7, 8, 9, 10, 11, 12, 13, 14, 15, 16, 16, 16, 17, 17, 18, 18, 18, 19, 19, 19, 20, 20, 20, 20, 21, 21, 21, 21, 22, 22, 22, 22, 22, 23, 23, 23, 23, 23, 23, 24, 24, 24, 24, 24, 24, 25, 25, 25, 25, 25, 25, 25, 26, 26, 26, 26, 26, 26, 26, 26, 27, 27, 27, 27, 27, 27, 27, 27, 27, 27, 28, 28, 28, 28, 28, 28, 28, 28, 28, 28, 29, 29, 29, 29, 29, 29, 29, 29, 29, 29, 29, 29, 30, 30, 30, 30, 30, 30, 30, 30, 30, 30, 30, 30, 30, 30, 31, 31, 31, 31, 31, 31, 31, 31, 31, 31, 31, 31, 31, 31, 31};

struct Frame {
    LAS unsigned char* lds;
    volatile LAS unsigned* MISC;
    gu32* ctl;
    int tid, lane, wave;
    int vcu, G;
};

struct Args { const float* in[24]; float* out; unsigned char* ws; int ph_lo, ph_hi; };
typedef const __attribute__((address_space(4))) Args* KArgs;
__device__ __forceinline__ KArgs kargs() { KArgs p = (KArgs)__builtin_amdgcn_kernarg_segment_ptr(); asm volatile("" : "+s"(p)); return p; }
#define INP(k) ((const float*)kargs()->in[k])

__device__ __forceinline__ float wave_sum(float v) {
#pragma unroll
    for (int o = 1; o < 64; o <<= 1) v += __shfl_xor(v, o);
    return v;
}
__device__ __forceinline__ float bf2f(unsigned short b) { return __builtin_bit_cast(float, (unsigned)b << 16); }
__device__ __forceinline__ float bflo(unsigned w) { return __builtin_bit_cast(float, w << 16); }
__device__ __forceinline__ float bfhi(unsigned w) { return __builtin_bit_cast(float, w & 0xffff0000u); }
__device__ __forceinline__ float sigmoidf_(float x) { return 1.0f / (1.0f + __expf(-x)); }

__device__ __forceinline__ void p0_transpose_item(const float* W, int K, int N, bf16* WT, int row_off, LAS float* scr, int item, int lane) {
    const int nblk = N / 32, kb = item / nblk, nb = item % nblk, k0 = 64 * kb, n0 = 32 * nb;
#pragma unroll 8
    for (int i = 0; i < 32; ++i) { const int kk = 2 * i + (lane >> 5); scr[kk * 33 + (lane & 31)] = W[(size_t)(k0 + kk) * N + n0 + (lane & 31)]; }
    LDS_WAIT(); asm volatile("" ::: "memory");
    const int c = lane & 7;
#pragma unroll
    for (int j = 0; j < 4; ++j) { const int n = (lane >> 3) + 8 * j; const LAS float* s = scr + (8 * c) * 33 + n;
        v4u o; o.x = pk2(s[0 * 33], s[1 * 33]); o.y = pk2(s[2 * 33], s[3 * 33]); o.z = pk2(s[4 * 33], s[5 * 33]); o.w = pk2(s[6 * 33], s[7 * 33]);
        *(v4u*)(WT + (size_t)(row_off + n0 + n) * K + k0 + 8 * c) = o; }
    LDS_WAIT(); asm volatile("" ::: "memory");
}

__device__ __forceinline__ void ph_prologue(Frame& F, unsigned char* ws) {
    LAS float* scr = (LAS float*)(F.lds + RING_OFF + F.wave * 16384);
    const int gw = F.vcu * NWAVES + F.wave, NGW = F.G * NWAVES;
    constexpr int I_SQ = (D / 64) * (D / 32);
    constexpr int I_W2 = (D / 64) * (2 * D / 32);
    constexpr int NITEMS = 2 * I_W2 + 2 * I_SQ + I_W2 + 2 * I_SQ + 2 * I_SQ;
    for (int it = gw; it < NITEMS; it += NGW) {
        int r = it;
        if (r < 2 * I_W2) { const int l = r / I_W2; p0_transpose_item(INP(1) + (size_t)l * D * 2 * D, D, 2 * D, (bf16*)(ws + WS_PW1T) + (size_t)l * 2 * D * D, 0, scr, r % I_W2, F.lane); continue; } r -= 2 * I_W2;
        if (r < 2 * I_SQ) { const int l = r / I_SQ; p0_transpose_item(INP(7) + (size_t)l * D * D, D, D, (bf16*)(ws + WS_PW2T) + (size_t)l * D * D, 0, scr, r % I_SQ, F.lane); continue; } r -= 2 * I_SQ;
        if (r < I_W2) { p0_transpose_item(INP(9), D, 2 * D, (bf16*)(ws + WS_WKVT), 0, scr, r, F.lane); continue; } r -= I_W2;
        if (r < 2 * I_SQ) { const int l = r / I_SQ; p0_transpose_item(INP(10) + (size_t)l * D * D, D, D, (bf16*)(ws + (l == 0 ? WS_WQ0T : WS_WQ1T)), 0, scr, r % I_SQ, F.lane); continue; } r -= 2 * I_SQ;
        { const int l = r / I_SQ; p0_transpose_item(INP(13) + (size_t)l * D * D, D, D, (bf16*)(ws + WS_WOT) + (size_t)l * D * D, 0, scr, r % I_SQ, F.lane); }
    }
    const float* x = INP(0); bf16* xb = (bf16*)(ws + WS_XBF);
    for (int m = gw; m < T; m += NGW) {
        const f32x4* xr = (const f32x4*)(x + (size_t)m * D) + F.lane; unsigned long long* o8 = (unsigned long long*)(xb + (size_t)m * D) + F.lane;
#pragma unroll
        for (int j = 0; j < 4; ++j) { const f32x4 v = xr[64 * j]; o8[64 * j] = (unsigned long long)pk2(v.x, v.y) | ((unsigned long long)pk2(v.z, v.w) << 32); }
    }
}
__device__ __forceinline__ void ph_moe_cvt(Frame& F, unsigned char* ws, int l) {
    LAS float* scr = (LAS float*)(F.lds + RING_OFF + F.wave * 16384);
    const int gw = F.vcu * NWAVES + F.wave, NGW = F.G * NWAVES;
    constexpr int I_G = (D / 64) * (DE / 32);
    constexpr int I_D = (DE / 64) * (D / 32);
    constexpr int PER_E = 2 * I_G + I_D;
    const float* wg = INP(21) + (size_t)l * NE * D * DE; const float* wu = INP(22) + (size_t)l * NE * D * DE; const float* wd = INP(23) + (size_t)l * NE * DE * D;
    bf16* gut = (bf16*)(ws + WS_WGUT); bf16* dt = (bf16*)(ws + WS_WDT);
    for (int it = gw; it < NE * PER_E; it += NGW) {
        const int e = it / PER_E; int r = it % PER_E;
        if (r < I_G) { p0_transpose_item(wg + (size_t)e * D * DE, D, DE, gut + (size_t)e * 2 * DE * D, 0, scr, r, F.lane); continue; } r -= I_G;
        if (r < I_G) { p0_transpose_item(wu + (size_t)e * D * DE, D, DE, gut + (size_t)e * 2 * DE * D, DE, scr, r, F.lane); continue; } r -= I_G;
        p0_transpose_item(wd + (size_t)e * DE * D, DE, D, dt + (size_t)e * D * DE, 0, scr, r, F.lane);
    }
}

__device__ __forceinline__ void ph_conv(Frame& F, const bf16* h1, const float* wdw  , const float* bdw, const float* lng, const float* lnb, bf16* U) {
    const int c0 = 2 * F.tid;
    float w0[CONVW], w1[CONVW];
#pragma unroll
    for (int j = 0; j < CONVW; ++j) { w0[j] = wdw[j * D + c0]; w1[j] = wdw[j * D + c0 + 1]; }
    const float bd0 = bdw[c0], bd1 = bdw[c0 + 1], g0 = lng[c0], g1 = lng[c0 + 1], b0 = lnb[c0], b1 = lnb[c0 + 1];
    LAS float* red = (LAS float*)(F.lds + RING_OFF);
    for (int tile = blockIdx.x; tile < T / 16; tile += gridDim.x) {
        const int t0 = tile * 16, bstart = t0 & ~(SEQ - 1);
        float a0[16], a1[16];
#pragma unroll
        for (int o = 0; o < 16; ++o) { a0[o] = 0.f; a1[o] = 0.f; }
#pragma unroll
        for (int ch = 0; ch < 6; ++ch) {
            unsigned av[8], gv[8];
#pragma unroll
            for (int ii = 0; ii < 8; ++ii) { const int i = ch * 8 + ii, r = t0 - 30 + i; av[ii] = 0u; gv[ii] = 0u;
                if (i < 46 && r >= bstart) { av[ii] = *(const unsigned*)(h1 + (size_t)r * 2048 + c0); gv[ii] = *(const unsigned*)(h1 + (size_t)r * 2048 + 1024 + c0); } }
            asm volatile("" ::: "memory");
#pragma unroll
            for (int ii = 0; ii < 8; ++ii) { const int i = ch * 8 + ii;
                if (i < 46) {
                    const float x0 = bflo(av[ii]) * sigmoidf_(bflo(gv[ii])), x1 = bfhi(av[ii]) * sigmoidf_(bfhi(gv[ii]));
#pragma unroll
                    for (int o = 0; o < 16; ++o) { const int j = i - o; if (j >= 0 && j < CONVW) { a0[o] += w0[j] * x0; a1[o] += w1[j] * x1; } }
                } }
            asm volatile("" ::: "memory");
        }
        __syncthreads();
#pragma unroll
        for (int o = 0; o < 16; ++o) { a0[o] += bd0; a1[o] += bd1; const float s1 = wave_sum(a0[o] + a1[o]), s2 = wave_sum(a0[o] * a0[o] + a1[o] * a1[o]);
            if (F.lane == 0) { red[(F.wave * 16 + o) * 2] = s1; red[(F.wave * 16 + o) * 2 + 1] = s2; } }
        __syncthreads();
#pragma unroll
        for (int o = 0; o < 16; ++o) { float s1 = 0.f, s2 = 0.f;
#pragma unroll
            for (int w = 0; w < 8; ++w) { s1 += red[(w * 16 + o) * 2]; s2 += red[(w * 16 + o) * 2 + 1]; }
            const float mean = s1 * (1.f / D), var = fmaxf(s2 * (1.f / D) - mean * mean, 0.f), rstd = 1.0f / sqrtf(var + LN_EPS);
            float y0 = (a0[o] - mean) * rstd * g0 + b0, y1 = (a1[o] - mean) * rstd * g1 + b1;
            y0 = y0 * sigmoidf_(y0); y1 = y1 * sigmoidf_(y1);
            *(unsigned*)(U + (size_t)(t0 + o) * D + c0) = pk2(y0, y1); }
    }
    __syncthreads();
}

__device__ __forceinline__ void ph_router(Frame& F, const float* xin, const float* mix, const float* lng, const float* lnb, const float* rw  , const float* rb,
                                          float* X1, bf16* XBF, int2* tok_e, int2* tok_pos, float2* tok_w, unsigned* cnt  ) {
    LAS float* rwT = (LAS float*)(F.lds + RING_OFF);
    LAS int* lcount = (LAS int*)(F.lds + RING_OFF + 65536);
    LAS int* lbase = lcount + 16;
    LAS int* st_e = lcount + 32;
    LAS int* st_p = st_e + 128;
    LAS float* st_w = (LAS float*)(st_p + 128);
    for (int i = F.tid; i < 16 * 1024; i += NTHR) { const int c = i >> 4, e = i & 15; rwT[e * 1024 + c] = rw[i]; }
    float rbias[16];
#pragma unroll
    for (int e = 0; e < 16; ++e) rbias[e] = rb[e];
    __syncthreads();
    for (int chunk = blockIdx.x; chunk < T / 64; chunk += gridDim.x) {
        if (F.tid < 16) lcount[F.tid] = 0;
        __syncthreads();
        for (int k = 0; k < 8; ++k) {
            const int tl = F.wave * 8 + k, t = chunk * 64 + tl;
            const f32x4* xr = (const f32x4*)(xin + (size_t)t * D) + F.lane; const f32x4* mr = (const f32x4*)(mix + (size_t)t * D) + F.lane;
            f32x4 v[4]; float s = 0.f;
#pragma unroll
            for (int j = 0; j < 4; ++j) { v[j] = xr[64 * j] * ALPHA + mr[64 * j]; s += (v[j].x + v[j].y) + (v[j].z + v[j].w); }
            const float mean = wave_sum(s) * (1.f / D); float s2 = 0.f;
#pragma unroll
            for (int j = 0; j < 4; ++j) { v[j] = v[j] - mean; s2 += (v[j].x * v[j].x + v[j].y * v[j].y) + (v[j].z * v[j].z + v[j].w * v[j].w); }
            const float rstd = 1.f / sqrtf(wave_sum(s2) * (1.f / D) + LN_EPS);
            f32x4* o4 = (f32x4*)(X1 + (size_t)t * D) + F.lane; unsigned long long* o8 = (unsigned long long*)(XBF + (size_t)t * D) + F.lane;
#pragma unroll
            for (int j = 0; j < 4; ++j) { const f32x4 gg = *((const f32x4*)lng + F.lane + 64 * j), bb = *((const f32x4*)lnb + F.lane + 64 * j);
                v[j] = v[j] * rstd * gg + bb; o4[64 * j] = v[j]; o8[64 * j] = (unsigned long long)pk2(v[j].x, v[j].y) | ((unsigned long long)pk2(v[j].z, v[j].w) << 32); }
            float aff[16], sel[16];
#pragma unroll
            for (int e = 0; e < 16; ++e) { float p = 0.f;
#pragma unroll
                for (int j = 0; j < 4; ++j) { const f32x4 wv = *((const LAS f32x4*)(rwT + e * 1024) + F.lane + 64 * j); p += (v[j].x * wv.x + v[j].y * wv.y) + (v[j].z * wv.z + v[j].w * wv.w); }
                p = wave_sum(p); aff[e] = 1.0f / (1.0f + expf(-p)); sel[e] = aff[e] + rbias[e]; }
            int gbest = 0; float gscore = -INFINITY;
#pragma unroll
            for (int g = 0; g < 4; ++g) { float m1 = -INFINITY, m2 = -INFINITY;
#pragma unroll
                for (int j = 0; j < 4; ++j) { const float sv = sel[4 * g + j]; if (sv > m1) { m2 = m1; m1 = sv; } else if (sv > m2) m2 = sv; }
                const float sc = m1 + m2; if (sc > gscore) { gscore = sc; gbest = g; } }
            float sg[4], ag[4];
#pragma unroll
            for (int j = 0; j < 4; ++j) { sg[j] = gbest == 0 ? sel[j] : gbest == 1 ? sel[4 + j] : gbest == 2 ? sel[8 + j] : sel[12 + j]; ag[j] = gbest == 0 ? aff[j] : gbest == 1 ? aff[4 + j] : gbest == 2 ? aff[8 + j] : aff[12 + j]; }
            int i0 = 0; float best = sg[0];
#pragma unroll
            for (int j = 1; j < 4; ++j) if (sg[j] > best) { best = sg[j]; i0 = j; }
            int i1 = -1; float best2 = -INFINITY;
#pragma unroll
            for (int j = 0; j < 4; ++j) if (j != i0 && sg[j] > best2) { best2 = sg[j]; i1 = j; }
            float w0 = i0 == 0 ? ag[0] : i0 == 1 ? ag[1] : i0 == 2 ? ag[2] : ag[3], w1 = i1 == 0 ? ag[0] : i1 == 1 ? ag[1] : i1 == 2 ? ag[2] : ag[3];
            const float ws_ = w0 + w1; w0 /= ws_; w1 /= ws_;
            if (F.lane == 0) { const int e0 = 4 * gbest + i0, e1 = 4 * gbest + i1; const int p0 = atomicAdd((int*)&lcount[e0], 1), p1 = atomicAdd((int*)&lcount[e1], 1);
                st_e[2 * tl] = e0; st_e[2 * tl + 1] = e1; st_p[2 * tl] = p0; st_p[2 * tl + 1] = p1; st_w[2 * tl] = w0; st_w[2 * tl + 1] = w1; }
        }
        __syncthreads();
        if (F.tid < 16) lbase[F.tid] = (int)__hip_atomic_fetch_add(cnt + 64 * F.tid, (unsigned)lcount[F.tid], __ATOMIC_RELAXED, __HIP_MEMORY_SCOPE_AGENT);
        __syncthreads();
        if (F.tid < 64) { const int t = chunk * 64 + F.tid; const int e0 = st_e[2 * F.tid], e1 = st_e[2 * F.tid + 1];
            tok_e[t] = make_int2(e0, e1); tok_pos[t] = make_int2(lbase[e0] + st_p[2 * F.tid], lbase[e1] + st_p[2 * F.tid + 1]); tok_w[t] = make_float2(st_w[2 * F.tid], st_w[2 * F.tid + 1]); }
        __syncthreads();
    }
}

__device__ __forceinline__ void moe_offsets(Frame& F, const unsigned* cnt) {
    LAS int* li = (LAS int*)(F.lds + LDSCTL_OFF);
    __syncthreads();
    if (F.tid < NE) li[LI_CNT + F.tid] = (int)__hip_atomic_load(cnt + 64 * F.tid, __ATOMIC_RELAXED, __HIP_MEMORY_SCOPE_AGENT);
    __syncthreads();
    if (F.tid == 0) {
        int off = 0, nt = 0;
        for (int e = 0; e < NE; ++e) { const int c = li[LI_CNT + e]; li[LI_OFF + e] = off; const int tiles = (c + 255) >> 8;
            for (int k = 0; k < tiles && nt < MAXTILES; ++k) li[LI_TEXP + nt++] = e; off += tiles * 256; }
        li[LI_OFF + NE] = off; li[LI_NT] = nt;
    }
    __syncthreads();
}

__device__ __forceinline__ void ph_gather(Frame& F, const bf16* XBF, const int2* tok_e, const int2* tok_pos, bf16* XG) {
    const LAS int* li = (const LAS int*)(F.lds + LDSCTL_OFF);
    const int gw = F.vcu * NWAVES + F.wave, NGW = F.G * NWAVES;
    for (int t = gw; t < T; t += NGW) {
        const int2 e = tok_e[t], p = tok_pos[t]; const int r0 = li[LI_OFF + e.x] + p.x, r1 = li[LI_OFF + e.y] + p.y;
        const v4u* src = (const v4u*)(XBF + (size_t)t * D) + F.lane; const v4u a = src[0], b = src[64];
        v4u* d0 = (v4u*)(XG + (size_t)r0 * D) + F.lane; v4u* d1 = (v4u*)(XG + (size_t)r1 * D) + F.lane;
        d0[0] = a; d0[64] = b; d1[0] = a; d1[64] = b;
    }
}

struct GroupedOrder {
    const LAS int* texp; int ntiles, nN, G, c; size_t bstride;
    __device__ __forceinline__ bool next(int i, pg8::Unit& u) const {
        const long L = (long)i * G + c; if (L >= (long)ntiles * nN) return false;
        const int ti = (int)(L / nN); u.pm = ti; u.pn = (int)(L % nN); u.boff = (size_t)texp[ti] * bstride; return true;
    }
    __device__ __forceinline__ void a_ready(const pg8::Unit&) const {}
    __device__ __forceinline__ void done(const pg8::Unit&) const {}
};

__device__ __forceinline__ void ph_silumul(Frame& F, const bf16* HU, bf16* HH) {
    const LAS int* li = (const LAS int*)(F.lds + LDSCTL_OFF);
    const int rows = li[LI_OFF + NE];
    const long n8 = (long)rows * (DE / 8);
    for (long i = (long)blockIdx.x * NTHR + F.tid; i < n8; i += (long)gridDim.x * NTHR) {
        const long r = i / (DE / 8); const int j8 = (int)(i % (DE / 8)) * 8;
        const v4u g = *(const v4u*)(HU + r * 1024 + j8), u = *(const v4u*)(HU + r * 1024 + 512 + j8);
        v4u o;
#define SM1(gw_, uw_) ({ float a = bflo(gw_), b = bfhi(gw_); a = a * sigmoidf_(a) * bflo(uw_); b = b * sigmoidf_(b) * bfhi(uw_); pk2(a, b); })
        o.x = SM1(g.x, u.x); o.y = SM1(g.y, u.y); o.z = SM1(g.z, u.z); o.w = SM1(g.w, u.w);
#undef SM1
        *(v4u*)(HH + r * 512 + j8) = o;
    }
}

__device__ __forceinline__ void ph_combine(Frame& F, const float* X1, const bf16* Y, const int2* tok_e, const int2* tok_pos, const float2* tok_w, const float* lng, const float* lnb, float* out, bf16* XBF) {
    const LAS int* li = (const LAS int*)(F.lds + LDSCTL_OFF);
    const int gw = F.vcu * NWAVES + F.wave, NGW = F.G * NWAVES;
    for (int t = gw; t < T; t += NGW) {
        const int2 e = tok_e[t], p = tok_pos[t]; const float2 w = tok_w[t]; const int r0 = li[LI_OFF + e.x] + p.x, r1 = li[LI_OFF + e.y] + p.y;
        const f32x4* xr = (const f32x4*)(X1 + (size_t)t * D) + F.lane;
        const unsigned long long* y0 = (const unsigned long long*)(Y + (size_t)r0 * D) + F.lane; const unsigned long long* y1 = (const unsigned long long*)(Y + (size_t)r1 * D) + F.lane;
        f32x4 v[4]; float s = 0.f;
#pragma unroll
        for (int j = 0; j < 4; ++j) { const unsigned long long a = y0[64 * j], b = y1[64 * j]; const unsigned al = (unsigned)a, ah = (unsigned)(a >> 32), bl = (unsigned)b, bh = (unsigned)(b >> 32);
            const f32x4 ya = (f32x4){bflo(al), bfhi(al), bflo(ah), bfhi(ah)}, yb = (f32x4){bflo(bl), bfhi(bl), bflo(bh), bfhi(bh)};
            v[j] = xr[64 * j] * ALPHA + (ya * w.x + yb * w.y); s += (v[j].x + v[j].y) + (v[j].z + v[j].w); }
        const float mean = wave_sum(s) * (1.f / D); float s2 = 0.f;
#pragma unroll
        for (int j = 0; j < 4; ++j) { v[j] = v[j] - mean; s2 += (v[j].x * v[j].x + v[j].y * v[j].y) + (v[j].z * v[j].z + v[j].w * v[j].w); }
        const float rstd = 1.f / sqrtf(wave_sum(s2) * (1.f / D) + LN_EPS);
        f32x4* o4 = (f32x4*)(out + (size_t)t * D) + F.lane; unsigned long long* o8 = (unsigned long long*)(XBF + (size_t)t * D) + F.lane;
#pragma unroll
        for (int j = 0; j < 4; ++j) { const f32x4 gg = *((const f32x4*)lng + F.lane + 64 * j), bb = *((const f32x4*)lnb + F.lane + 64 * j);
            v[j] = v[j] * rstd * gg + bb; o4[64 * j] = v[j]; o8[64 * j] = (unsigned long long)pk2(v[j].x, v[j].y) | ((unsigned long long)pk2(v[j].z, v[j].w) << 32); }
    }
}

__device__ __forceinline__ void ph_attn_slow(Frame& F, const bf16* Q, const bf16* K, const bf16* V, const float* relb  , float* O12) {
    LAS float* Ks = (LAS float*)(F.lds + RING_OFF);
    LAS float* Vs = Ks + 32 * 64;
    LAS float* bt = Vs + 32 * 128;
    const int r = F.tid & 255, vh = F.tid >> 8;
    for (int U = blockIdx.x; U < 1024; U += gridDim.x) {
        const int rnd = U >> 8, v = U & 255, bch = v >> 3, s = v & 7;
        const int qt = rnd == 0 ? s : rnd == 1 ? 15 - s : rnd == 2 ? 16 + s : 31 - s;
        const int b = bch >> 4, comp = (bch >> 3) & 1, h = bch & 7;
        __syncthreads();
        if (F.tid < 128) bt[F.tid] = relb[(int)c_bucket[F.tid] * NH + h];
        const float bfar = relb[31 * NH + h];
        const int i = qt * 256 + r; const size_t row = (size_t)b * SEQ + i;
        float q[64];
        { const v4u* qp = (const v4u*)(Q + row * 1024 + comp * 512 + h * 64);
#pragma unroll
          for (int d8 = 0; d8 < 8; ++d8) { const v4u w = qp[d8]; q[8 * d8 + 0] = bflo(w.x) * 0.125f; q[8 * d8 + 1] = bfhi(w.x) * 0.125f; q[8 * d8 + 2] = bflo(w.y) * 0.125f; q[8 * d8 + 3] = bfhi(w.y) * 0.125f;
              q[8 * d8 + 4] = bflo(w.z) * 0.125f; q[8 * d8 + 5] = bfhi(w.z) * 0.125f; q[8 * d8 + 6] = bflo(w.w) * 0.125f; q[8 * d8 + 7] = bfhi(w.w) * 0.125f; } }
        float o[64];
#pragma unroll
        for (int d = 0; d < 64; ++d) o[d] = 0.f;
        float m = -INFINITY, l = 0.f;
        const int nkt = (qt * 256 + 256) / 32;
        for (int kt = 0; kt < nkt; ++kt) {
            __syncthreads();
            { const int kk = F.tid >> 4, c = F.tid & 15; const size_t krow = (size_t)b * SEQ + kt * 32 + kk;
              const unsigned long long kw = *(const unsigned long long*)(K + krow * 1024 + comp * 512 + h * 64 + c * 4);
              LAS float* kd = Ks + kk * 64 + c * 4; kd[0] = bflo((unsigned)kw); kd[1] = bfhi((unsigned)kw); kd[2] = bflo((unsigned)(kw >> 32)); kd[3] = bfhi((unsigned)(kw >> 32));
              const v4u vw = *(const v4u*)(V + krow * 1024 + h * 128 + c * 8);
              LAS float* vd = Vs + kk * 128 + c * 8; vd[0] = bflo(vw.x); vd[1] = bfhi(vw.x); vd[2] = bflo(vw.y); vd[3] = bfhi(vw.y); vd[4] = bflo(vw.z); vd[5] = bfhi(vw.z); vd[6] = bflo(vw.w); vd[7] = bfhi(vw.w); }
            __syncthreads();
            if (kt * 32 <= i) {
                for (int jj = 0; jj < 32; ++jj) {
                    const int j = kt * 32 + jj;
                    if (j <= i) {
                        const LAS f32x4* kp = (const LAS f32x4*)(Ks + jj * 64);
                        float sc = 0.f;
#pragma unroll
                        for (int d4 = 0; d4 < 16; ++d4) { const f32x4 kv = kp[d4]; sc += (q[4 * d4] * kv.x + q[4 * d4 + 1] * kv.y) + (q[4 * d4 + 2] * kv.z + q[4 * d4 + 3] * kv.w); }
                        const int n = i - j; sc += (n < 128) ? bt[n] : bfar;
                        if (sc > m) { const float f = __expf(m - sc); l *= f;
#pragma unroll
                            for (int d = 0; d < 64; ++d) o[d] *= f;
                            m = sc; }
                        const float p = __expf(sc - m); l += p;
                        const LAS f32x4* vp = (const LAS f32x4*)(Vs + jj * 128 + vh * 64);
#pragma unroll
                        for (int d4 = 0; d4 < 16; ++d4) { const f32x4 vv = vp[d4]; o[4 * d4] += p * vv.x; o[4 * d4 + 1] += p * vv.y; o[4 * d4 + 2] += p * vv.z; o[4 * d4 + 3] += p * vv.w; }
                    }
                }
            }
        }
        const float il = 1.0f / l;
        f32x4* op = (f32x4*)(O12 + (size_t)comp * T * 1024 + row * 1024 + h * 128 + vh * 64);
#pragma unroll
        for (int d4 = 0; d4 < 16; ++d4) op[d4] = (f32x4){o[4 * d4] * il, o[4 * d4 + 1] * il, o[4 * d4 + 2] * il, o[4 * d4 + 3] * il};
    }
    __syncthreads();
}

__device__ __forceinline__ void ph_subln(Frame& F, const float* O12, const float* lamp  , const float* sg  , int layer, bf16* U) {
    const float linit = 0.8f - 0.6f * expf(-0.3f * (float)layer);
    const float a = wave_sum(lamp[F.lane] * lamp[64 + F.lane]), b = wave_sum(lamp[128 + F.lane] * lamp[192 + F.lane]);
    const float lam = expf(a) - expf(b) + linit;
    const f32x4 g4 = *((const f32x4*)sg + (F.lane & 31));
    const int gw = F.vcu * NWAVES + F.wave, NGW = F.G * NWAVES;
    for (int t = gw; t < T; t += NGW) {
        const f32x4* p1 = (const f32x4*)(O12 + (size_t)t * 1024) + F.lane; const f32x4* p2 = (const f32x4*)(O12 + (size_t)T * 1024 + (size_t)t * 1024) + F.lane;
        unsigned long long* o8 = (unsigned long long*)(U + (size_t)t * D) + F.lane;
#pragma unroll
        for (int j = 0; j < 4; ++j) { f32x4 v = p1[64 * j] - p2[64 * j] * lam; float ss = (v.x * v.x + v.y * v.y) + (v.z * v.z + v.w * v.w);
#pragma unroll
            for (int o = 1; o < 32; o <<= 1) ss += __shfl_xor(ss, o);
            const float rs = (1.0f / sqrtf(ss * (1.f / VD) + LN_EPS)) * (1.0f - linit);
            v = v * rs * g4; o8[64 * j] = (unsigned long long)pk2(v.x, v.y) | ((unsigned long long)pk2(v.z, v.w) << 32); }
    }
}

namespace pg8 {
struct EpiBf16Split {
    static constexpr bool PERM = true, AFTER_DRAIN = false;
    bf16_t* O0; long d1, d2;
    __device__ __forceinline__ void operator()(const f32x4 (&acc)[2][2][4][2], const Unit& u, int wr, int wc, int fr, int fq) const {
        const int row0 = u.pm * BM + wr * 64 + fr; int colt = u.pn * BM; const int t = colt >> 10; bf16_t* base = O0 + (long)(t > 0) * d1 + (long)(t > 1) * d2; colt -= t << 10;
        const int col0 = colt + wc * 32 + 8 * fq;
#pragma unroll
        for (int ai = 0; ai < 2; ++ai)
#pragma unroll
            for (int m = 0; m < 4; ++m) { bf16_t* rowp = base + (size_t)(row0 + ai * HALF + m * 16) * 1024 + col0;
#pragma unroll
                for (int bj = 0; bj < 2; ++bj) { const f32x4 v0 = acc[ai][bj][m][0], v1 = acc[ai][bj][m][1];
                    u32x4 w; w.x = cvt_pk_bf16(v0[0], v0[1]); w.y = cvt_pk_bf16(v0[2], v0[3]); w.z = cvt_pk_bf16(v1[0], v1[1]); w.w = cvt_pk_bf16(v1[2], v1[3]);
                    *(u32x4*)(rowp + bj * HALF) = w; } }
    }
};
}

constexpr int PH_PER_LAYER = 16, N_PHASES = 1 + NLAYER * PH_PER_LAYER;

__global__ void __launch_bounds__(NTHR, 2) yoco_fwd(Args args) {
    extern __shared__ __attribute__((aligned(16))) unsigned char lds[];
    Frame F;
    F.lds = (LAS unsigned char*)lds;
    F.MISC = (volatile LAS unsigned*)(F.lds + LDSCTL_OFF);
    F.tid = threadIdx.x; F.lane = F.tid & 63; F.wave = __builtin_amdgcn_readfirstlane(F.tid >> 6);
    F.G = gridDim.x; { const int bx = blockIdx.x; F.vcu = (F.G % 8 == 0) ? (bx % 8) * (F.G / 8) + bx / 8 : bx; }
    unsigned char* ws = args.ws;
    F.ctl = (gu32*)(ws + WS_CTL);
    for (int u = F.tid; u < (LDS_BYTES - LDSCTL_OFF) / 4; u += NTHR) ((LAS unsigned*)(F.lds + LDSCTL_OFF))[u] = 0u;
    __syncthreads();
    const int lo = args.ph_lo, hi = args.ph_hi;
    XcdBarrier bar; bar.bar = (unsigned*)(F.ctl + CW_BAR); bar.x = 0; bar.st = nullptr;
    if (hi - lo > 1) bar = xcd_barrier_post((unsigned*)(F.ctl + CW_BAR), F.MISC + 8);
#define IN(k) (lo <= (k) && (k) < hi)
#define SEAM(k) do { if ((k) + 1 < hi) xcd_barrier(bar); } while (0)
#define FRESH() do { int t_ = threadIdx.x; asm volatile("" : "+v"(t_)); F.tid = t_; F.lane = t_ & 63; F.wave = __builtin_amdgcn_readfirstlane(t_ >> 6); } while (0)

    bf16* const XBF = (bf16*)(ws + WS_XBF); float* const X1 = (float*)(ws + WS_X1); float* const MIX = (float*)(ws + WS_MIX);
    bf16* const KB = (bf16*)(ws + WS_KB); bf16* const VB = (bf16*)(ws + WS_VB);
    int2* const tok_e = (int2*)(ws + WS_ROUT); int2* const tok_pos = tok_e + T; float2* const tok_w = (float2*)(tok_pos + T);

    if (IN(0)) { FRESH(); ph_prologue(F, ws); SEAM(0); }

    for (int l = 0; l < NLAYER; ++l) {
        const int pb = 1 + l * PH_PER_LAYER;
        const float* xin = (l == 0) ? INP(0) : args.out;
        unsigned* cnt = (unsigned*)(F.ctl + CW_CNT) + l * NE * 64;
        if (IN(pb + 0)) { FRESH(); ph_moe_cvt(F, ws, l); SEAM(pb + 0); }
        if (l < NSELF) {
            if (IN(pb + 1)) { FRESH();
                pg8::Gemm g{XBF, (const bf16*)(ws + WS_PW1T) + (size_t)l * 2 * D * D, T, 2 * D, D}; pg8::StaticOrder S; S.init(T, 2 * D, F.G, (int)blockIdx.x);
                pg8::EpiBf16<0> E{(bf16*)(ws + WS_H1), 2 * D, INP(2) + (size_t)l * 2 * D, 0, 0, 1.f};
                pg8::gemm_phase<pg8::EpiBf16<0>, pg8::StaticOrder, true, true>(F.lds + RING_OFF, g, S, E);
                SEAM(pb + 1);
            }
            if (IN(pb + 2)) { FRESH(); ph_conv(F, (const bf16*)(ws + WS_H1), INP(3) + (size_t)l * CONVW * D, INP(4) + (size_t)l * D, INP(5) + (size_t)l * D, INP(6) + (size_t)l * D, (bf16*)(ws + WS_US)); SEAM(pb + 2); }
            if (IN(pb + 4)) { FRESH();
                pg8::Gemm g{(const bf16*)(ws + WS_US), (const bf16*)(ws + WS_PW2T) + (size_t)l * D * D, T, D, D}; pg8::StaticOrder S; S.init(T, D, F.G, (int)blockIdx.x);
                pg8::EpiF32 E{MIX, D, INP(8) + (size_t)l * D};
                pg8::gemm_phase<pg8::EpiF32, pg8::StaticOrder, true, true>(F.lds + RING_OFF, g, S, E);
                SEAM(pb + 4);
            }
        } else {
            const int j = l - NSELF;
            if (IN(pb + 1)) { FRESH();
                const int N = (j == 0) ? 3 * D : D;
                pg8::Gemm g{XBF, (const bf16*)(ws + (j == 0 ? WS_WQ0T : WS_WQ1T)), T, N, D}; pg8::StaticOrder S; S.init(T, N, F.G, (int)blockIdx.x);
                pg8::EpiBf16Split E3{(bf16*)(ws + WS_Q), ((long)WS_KB - (long)WS_Q) / 2, ((long)WS_VB - (long)WS_KB) / 2};
                pg8::gemm_phase<pg8::EpiBf16Split, pg8::StaticOrder, true, true>(F.lds + RING_OFF, g, S, E3);
                SEAM(pb + 1);
            }
            if (IN(pb + 2)) { FRESH(); ph_attn_slow(F, (const bf16*)(ws + WS_Q), KB, VB, INP(14), (float*)(ws + WS_O12)); SEAM(pb + 2); }
            if (IN(pb + 3)) { FRESH(); ph_subln(F, (const float*)(ws + WS_O12), INP(11) + (size_t)j * 4 * HD, INP(12) + (size_t)j * VD, l, (bf16*)(ws + WS_Q)); SEAM(pb + 3); }
            if (IN(pb + 4)) { FRESH();
                pg8::Gemm g{(const bf16*)(ws + WS_Q), (const bf16*)(ws + WS_WOT) + (size_t)j * D * D, T, D, D}; pg8::StaticOrder S; S.init(T, D, F.G, (int)blockIdx.x);
                pg8::EpiF32 E{MIX, D, nullptr};
                pg8::gemm_phase<pg8::EpiF32, pg8::StaticOrder, true, true>(F.lds + RING_OFF, g, S, E);
                SEAM(pb + 4);
            }
        }
        if (IN(pb + 5)) { FRESH(); ph_router(F, xin, MIX, INP(15) + (size_t)l * D, INP(16) + (size_t)l * D, INP(19), INP(20), X1, XBF, tok_e, tok_pos, tok_w, cnt); SEAM(pb + 5); }
        if (IN(pb + 6)) { FRESH(); moe_offsets(F, cnt); ph_gather(F, XBF, tok_e, tok_pos, (bf16*)(ws + WS_XG)); SEAM(pb + 6); }
        if (IN(pb + 7)) { FRESH();
            moe_offsets(F, cnt);
            const LAS int* li = (const LAS int*)(F.lds + LDSCTL_OFF);
            pg8::Gemm g{(const bf16*)(ws + WS_XG), (const bf16*)(ws + WS_WGUT), XG_ROWS, 2 * DE, D};
            GroupedOrder S{li + LI_TEXP, li[LI_NT], 4, F.G, (int)blockIdx.x, (size_t)2 * DE * D * 2};
            pg8::EpiBf16<0> E{(bf16*)(ws + WS_HU), 2 * DE, nullptr, 0, 0, 1.f};
            pg8::gemm_phase<pg8::EpiBf16<0>, GroupedOrder, true, true>(F.lds + RING_OFF, g, S, E);
            SEAM(pb + 7);
        }
        if (IN(pb + 8)) { FRESH(); moe_offsets(F, cnt); ph_silumul(F, (const bf16*)(ws + WS_HU), (bf16*)(ws + WS_HH)); SEAM(pb + 8); }
        if (IN(pb + 9)) { FRESH();
            moe_offsets(F, cnt);
            const LAS int* li = (const LAS int*)(F.lds + LDSCTL_OFF);
            pg8::Gemm g{(const bf16*)(ws + WS_HH), (const bf16*)(ws + WS_WDT), XG_ROWS, D, DE};
            GroupedOrder S{li + LI_TEXP, li[LI_NT], 4, F.G, (int)blockIdx.x, (size_t)D * DE * 2};
            pg8::EpiBf16<0> E{(bf16*)(ws + WS_Y), D, nullptr, 0, 0, 1.f};
            pg8::gemm_phase<pg8::EpiBf16<0>, GroupedOrder, true, true>(F.lds + RING_OFF, g, S, E);
            SEAM(pb + 9);
        }
        if (IN(pb + 10)) { FRESH(); moe_offsets(F, cnt); ph_combine(F, X1, (const bf16*)(ws + WS_Y), tok_e, tok_pos, tok_w, INP(17) + (size_t)l * D, INP(18) + (size_t)l * D, args.out, XBF); SEAM(pb + 10); }
    }
#undef IN
#undef SEAM
}

extern "C" void kernel_launch(void* const* d_in, const int* in_sizes, int n_in, void* d_out, int out_size, void* d_ws, size_t ws_size, hipStream_t stream) {
    static int grid = 0;
    if (grid == 0) {
        if (n_in != 24 || in_sizes[0] != T * D || out_size != T * D || ws_size < WS_END) { fprintf(stderr, "kernel_launch: unexpected shapes / workspace (n_in %d, ws %zu); nothing launched\n", n_in, ws_size); grid = -1; return; }
        int dev = 0, cus = 0, per_cu = 0;
        if (hipGetDevice(&dev) != hipSuccess || hipDeviceGetAttribute(&cus, hipDeviceAttributeMultiprocessorCount, dev) != hipSuccess) { grid = -1; return; }
        if (hipFuncSetAttribute((const void*)yoco_fwd, hipFuncAttributeMaxDynamicSharedMemorySize, LDS_BYTES) != hipSuccess) { grid = -1; return; }
        if (hipOccupancyMaxActiveBlocksPerMultiprocessor(&per_cu, (const void*)yoco_fwd, NTHR, LDS_BYTES) != hipSuccess || per_cu < 1) { fprintf(stderr, "kernel_launch: occupancy query says %d\n", per_cu); }
        (void)hipGetLastError();
        grid = cus;
    }
    if (grid < 0) return;
    (void)hipMemsetAsync((char*)d_ws + WS_CTL, 0, CTL_ZERO_BYTES, stream);
    Args a{};
    for (int i = 0; i < 24; ++i) a.in[i] = (const float*)d_in[i];
    a.out = (float*)d_out; a.ws = (unsigned char*)d_ws;
#if MK_ONE_LAUNCH
    a.ph_lo = 0; a.ph_hi = N_PHASES;
    hipLaunchKernelGGL(yoco_fwd, dim3(grid), dim3(NTHR), LDS_BYTES, stream, a);
#else
    for (int ph = 0; ph < N_PHASES; ++ph) {
        const int k = (ph - 1) % PH_PER_LAYER, l = (ph - 1) / PH_PER_LAYER;
        if (ph > 0) { if (k > 10) continue; if (k == 3 && l < NSELF) continue; }
        a.ph_lo = ph; a.ph_hi = ph + 1;
        hipLaunchKernelGGL(yoco_fwd, dim3(grid), dim3(NTHR), LDS_BYTES, stream, a);
    }
#endif
}
```

```cpp
#ifndef MK_ONE_LAUNCH
#define MK_ONE_LAUNCH 1
#endif
#include <hip/hip_runtime.h>
#include <cstdio>
#include <cstdint>
#include <cmath>
namespace pg8 {
#define PG8_LAS __attribute__((address_space(3)))
typedef unsigned short bf16_t;
typedef short bf16x8 __attribute__((ext_vector_type(8)));
typedef float f32x4 __attribute__((ext_vector_type(4)));
typedef unsigned u32x4 __attribute__((ext_vector_type(4)));
constexpr int BM = 256, BK = 64, HALF = 128, HTB = HALF * BK * 2  , STAGE_BYTES = 8 * HTB, NXCD = 8, WGM = 8;

__host__ __device__ __forceinline__ int lds_byte(int r, int c) { const int st = (r >> 4) * 2 + (c >> 5), rr = r & 15, cc = c & 31, ob = rr * 64 + cc * 2; return st * 1024 + (ob ^ (((ob >> 9) & 1) << 5)); }
__host__ __device__ __forceinline__ void stage_rc(int b, int& R, int& C) { const int st = b / 1024, sb = b % 1024, swz = sb ^ (((sb >> 9) & 1) << 5); R = (st >> 1) * 16 + swz / 64; C = (st & 1) * 32 + (swz % 64) / 2; }
__host__ __device__ __forceinline__ int perm32(int rho) { const int n = rho >> 4, i = rho & 15; return 8 * (i >> 2) + 4 * n + (i & 3); }

typedef int v8i32 __attribute__((ext_vector_type(8)));
__device__ __forceinline__ v8i32 cat8(bf16x8 a, bf16x8 b) { typedef int v4i32 __attribute__((ext_vector_type(4))); const v4i32 x = __builtin_bit_cast(v4i32, a), y = __builtin_bit_cast(v4i32, b); return (v8i32){x[0], x[1], x[2], x[3], y[0], y[1], y[2], y[3]}; }
#ifndef WT_STORES
#define WT_STORES 1
#endif
__device__ __forceinline__ void st16(void* p, u32x4 v) {
#if WT_STORES
    asm volatile("global_store_dwordx4 %0, %1, off sc1\n\ts_nop 1" :: "v"(p), "v"(v) : "memory");
#else
    *(u32x4*)p = v;
#endif
}
typedef unsigned u32x2w __attribute__((ext_vector_type(2)));
__device__ __forceinline__ void st8(void* p, u32x2w v) {
#if WT_STORES
    asm volatile("global_store_dwordx2 %0, %1, off sc1\n\ts_nop 1" :: "v"(p), "v"(v) : "memory");
#else
    *(u32x2w*)p = v;
#endif
}
__device__ __forceinline__ void st4(void* p, unsigned v) {
#if WT_STORES
    asm volatile("global_store_dword %0, %1, off sc1\n\ts_nop 0" :: "v"(p), "v"(v) : "memory");
#else
    *(unsigned*)p = v;
#endif
}
struct Unit { int pm, pn; size_t boff; int slot; };
struct Gemm { const bf16_t* A; const bf16_t* Bt; int M, N, K; };

struct StaticOrder {
    int nM, nN, nwg, G, c;
    __host__ __device__ void init(int M, int N, int G_, int c_) { nM = M / BM; nN = N / BM; nwg = nM * nN; G = G_; c = c_; }
    __host__ __device__ bool next(int i, Unit& u) const {
        const long L = (long)i * G + c; if (L >= nwg) return false;
        int wgid = (int)L; { const int q = nwg / NXCD, r = nwg % NXCD, xcd = wgid % NXCD, off = wgid / NXCD; wgid = (xcd < r ? xcd * (q + 1) : r * (q + 1) + (xcd - r) * q) + off; }
        const int nig = WGM * nN, gid = wgid / nig, fm = gid * WGM, gsz = (nM - fm) < WGM ? (nM - fm) : WGM;
        u.pm = fm + ((wgid % nig) % gsz); u.pn = (wgid % nig) / gsz; u.boff = 0; u.slot = 0; return true;
    }
    __device__ __forceinline__ void a_ready(const Unit&) const {}
    __device__ __forceinline__ void done(const Unit&) const {}
};

__device__ __forceinline__ unsigned cvt_pk_bf16(float lo, float hi) { unsigned r; asm volatile("v_cvt_pk_bf16_f32 %0, %1, %2" : "=v"(r) : "v"(lo), "v"(hi)); return r; }
typedef float f32x2 __attribute__((ext_vector_type(2)));
__device__ __forceinline__ f32x2 gelu_pk(f32x2 v) {
    const f32x2 av = __builtin_elementwise_abs(v), d = av * 0.2316418882f + 1.0f;
    f32x2 t; t.x = __builtin_amdgcn_rcpf(d.x); t.y = __builtin_amdgcn_rcpf(d.y);
    f32x2 q = t * 0.5307027145f + (-0.7265760135f); q = q * t + 0.7107068705f; q = q * t + (-0.142248368f); q = q * t + 0.127414796f; q = q * t;
    const f32x2 s = (v * v) * (-0.72134752044f);
    f32x2 e; e.x = __builtin_amdgcn_exp2f(s.x); e.y = __builtin_amdgcn_exp2f(s.y);
    const f32x2 m = v * (q * e), r = v - m;
    f32x2 o; o.x = v.x < 0.f ? m.x : r.x; o.y = v.y < 0.f ? m.y : r.y; return o;
}

template <int ACT  > struct EpiBf16 {
    static constexpr bool PERM = true, AFTER_DRAIN = false; static_assert(ACT == 0 || ACT == 1, "EpiBf16: ACT is 0 (none) or 1 (gelu_pk)");
    bf16_t* O; int ldc; const float* bias; int split_cols; size_t split_stride; float scale0;
    __device__ __forceinline__ void operator()(const f32x4 (&acc)[2][2][4][2], const Unit& u, int wr, int wc, int fr, int fq) const {
        const int row0 = u.pm * BM + wr * 64 + fr; int colt = u.pn * BM; bf16_t* base = O;
        float sc = 1.f; if (split_cols) { const int t = colt / split_cols; base += (size_t)t * split_stride; colt -= t * split_cols; if (t == 0) sc = scale0; }
        const int col0 = colt + wc * 32 + 8 * fq, bcol0 = u.pn * BM + wc * 32 + 8 * fq;
        f32x4 bv[2][2];
#pragma unroll
        for (int bj = 0; bj < 2; ++bj)
#pragma unroll
            for (int n = 0; n < 2; ++n) bv[bj][n] = bias ? *(const f32x4*)(bias + bcol0 + bj * HALF + 4 * n) : (f32x4){0.f, 0.f, 0.f, 0.f};
#pragma unroll
        for (int ai = 0; ai < 2; ++ai)
#pragma unroll
            for (int m = 0; m < 4; ++m) { bf16_t* rowp = base + (size_t)(row0 + ai * HALF + m * 16) * ldc + col0;
#pragma unroll
                for (int bj = 0; bj < 2; ++bj) { f32x4 v0 = acc[ai][bj][m][0] + bv[bj][0], v1 = acc[ai][bj][m][1] + bv[bj][1];
                    if (ACT == 1) { f32x2 a = gelu_pk((f32x2){v0[0], v0[1]}), b = gelu_pk((f32x2){v0[2], v0[3]}), c = gelu_pk((f32x2){v1[0], v1[1]}), d = gelu_pk((f32x2){v1[2], v1[3]});
                        v0 = (f32x4){a.x, a.y, b.x, b.y}; v1 = (f32x4){c.x, c.y, d.x, d.y}; }
                    v0 = v0 * sc; v1 = v1 * sc; u32x4 w; w.x = cvt_pk_bf16(v0[0], v0[1]); w.y = cvt_pk_bf16(v0[2], v0[3]); w.z = cvt_pk_bf16(v1[0], v1[1]); w.w = cvt_pk_bf16(v1[2], v1[3]);
                    st16(rowp + bj * HALF, w); } }
    }
};

struct EpiF32 {
    static constexpr bool PERM = false, AFTER_DRAIN = false;
    float* C; int ldc; const float* bias;
    __device__ __forceinline__ void operator()(const f32x4 (&acc)[2][2][4][2], const Unit& u, int wr, int wc, int fr, int fq) const {
        const int row0 = u.pm * BM + wr * 64 + fr, col0 = u.pn * BM + wc * 32 + 4 * fq;
        f32x4 bv[2][2];
#pragma unroll
        for (int bj = 0; bj < 2; ++bj)
#pragma unroll
            for (int n = 0; n < 2; ++n) bv[bj][n] = bias ? *(const f32x4*)(bias + col0 + bj * HALF + n * 16) : (f32x4){0.f, 0.f, 0.f, 0.f};
#pragma unroll
        for (int ai = 0; ai < 2; ++ai)
#pragma unroll
            for (int m = 0; m < 4; ++m) { float* rowp = C + (size_t)(row0 + ai * HALF + m * 16) * ldc + col0;
#pragma unroll
                for (int bj = 0; bj < 2; ++bj)
#pragma unroll
                    for (int n = 0; n < 2; ++n) *(f32x4*)(rowp + bj * HALF + n * 16) = acc[ai][bj][m][n] + bv[bj][n]; }
    }
};
struct PanelStats {
    unsigned* xbuf;
    unsigned* cnt;
    unsigned* tmo;
    int ntn; float eps;
    unsigned code;
    __device__ __forceinline__ bool run(const f32x4 (&v)[2][2][4][2], const Unit& u, int wr, int wc, int fr, int fq, PG8_LAS unsigned char* lds, int wid, int lane) const {
        typedef float f32x2v __attribute__((ext_vector_type(2)));
        PG8_LAS f32x2v* P = (PG8_LAS f32x2v*)lds;
        PG8_LAS f32x2v* S = (PG8_LAS f32x2v*)(lds + 8192);
        PG8_LAS unsigned* flag = (PG8_LAS unsigned*)(lds + 8192 + 2048);
#pragma unroll
        for (int ai = 0; ai < 2; ++ai)
#pragma unroll
            for (int m = 0; m < 4; ++m) {
                float s = 0.f;
#pragma unroll
                for (int bj = 0; bj < 2; ++bj)
#pragma unroll
                    for (int n = 0; n < 2; ++n) { const f32x4 x = v[ai][bj][m][n]; s += (x[0] + x[1]) + (x[2] + x[3]); }
                s += __shfl_xor(s, 16); s += __shfl_xor(s, 32);
                const float mw = s * (1.0f / 64.0f); float q = 0.f;
#pragma unroll
                for (int bj = 0; bj < 2; ++bj)
#pragma unroll
                    for (int n = 0; n < 2; ++n) { const f32x4 d = v[ai][bj][m][n] - mw; q += (d[0] * d[0] + d[1] * d[1]) + (d[2] * d[2] + d[3] * d[3]); }
                q += __shfl_xor(q, 16); q += __shfl_xor(q, 32);
                if (fq == 0) P[(ai * HALF + wr * 64 + m * 16 + fr) * 4 + wc] = (f32x2v){mw, q};
            }
        asm volatile("s_waitcnt lgkmcnt(0)" ::: "memory"); __builtin_amdgcn_s_barrier(); asm volatile("" ::: "memory");
#if defined(BROKEN_EXCHANGE_NO_WAIT)
#warning BROKEN CONTROL BUILD: the row-statistics exchange does not wait; results are wrong by design
        if (blockIdx.x >= 64) { const long long t0_ = clock64(); while (clock64() - t0_ < 60000) __builtin_amdgcn_s_sleep(8); }
#endif
        const int row = wid * 32 + (lane & 31);
        if (lane < 32) {
            const f32x2v a = P[row * 4 + 0], b = P[row * 4 + 1], c = P[row * 4 + 2], d = P[row * 4 + 3];
            const float mt = (a.x + b.x + c.x + d.x) * 0.25f;
            const float da = a.x - mt, db = b.x - mt, dc = c.x - mt, dd = d.x - mt;
            const float m2 = (a.y + b.y) + (c.y + d.y) + 64.0f * ((da * da + db * db) + (dc * dc + dd * dd));
            unsigned long long* slot = (unsigned long long*)xbuf + ((size_t)(u.pm * BM + row) * 4 + u.pn);
            __hip_atomic_store(slot, ((unsigned long long)__float_as_uint(m2) << 32) | __float_as_uint(mt), __ATOMIC_RELAXED, __HIP_MEMORY_SCOPE_AGENT);
        }
        asm volatile("s_waitcnt vmcnt(0)" ::: "memory");
        if (lane == 0) __hip_atomic_fetch_add(cnt + 64 * u.pm, 1u, __ATOMIC_RELAXED, __HIP_MEMORY_SCOPE_AGENT);
        if (wid == 0) {
            bool dead = false; const unsigned long long t0 = __builtin_amdgcn_s_memrealtime(); const unsigned want = 8u * (unsigned)ntn;
            for (;;) {
#if defined(BROKEN_EXCHANGE_NO_WAIT)
                break;
#endif
                if ((unsigned)__builtin_amdgcn_readfirstlane(__hip_atomic_load(cnt + 64 * u.pm, __ATOMIC_RELAXED, __HIP_MEMORY_SCOPE_AGENT)) >= want) break;
                if (__builtin_amdgcn_s_memrealtime() - t0 > 2000000ull) {
                    if (lane == 0) { unsigned expect = 0u; __hip_atomic_compare_exchange_strong(tmo + 1, &expect, code | (unsigned)(u.pm & 0xff), __ATOMIC_RELAXED, __ATOMIC_RELAXED, __HIP_MEMORY_SCOPE_AGENT);
                                     __hip_atomic_store(tmo, 1u, __ATOMIC_RELAXED, __HIP_MEMORY_SCOPE_AGENT); }
                    dead = true; break; }
                __builtin_amdgcn_s_sleep(2);
            }
            __builtin_amdgcn_fence(__ATOMIC_ACQUIRE, "agent");
            if (lane == 0) flag[0] = dead ? 1u : 0u;
        }
        asm volatile("s_waitcnt vmcnt(0) lgkmcnt(0)" ::: "memory"); __builtin_amdgcn_s_barrier(); asm volatile("" ::: "memory");
        const bool bad = flag[0] != 0u;
        if (lane < 32) {
            const unsigned long long* slot = (const unsigned long long*)xbuf + (size_t)(u.pm * BM + row) * 4; float mt[4], m2[4]; float ms = 0.f;
#pragma unroll
            for (int t = 0; t < 4; ++t) { if (t < ntn) { const unsigned long long w = __hip_atomic_load(slot + t, __ATOMIC_RELAXED, __HIP_MEMORY_SCOPE_AGENT); mt[t] = __uint_as_float((unsigned)w); m2[t] = __uint_as_float((unsigned)(w >> 32)); } else { mt[t] = 0.f; m2[t] = 0.f; } ms += mt[t]; }
            const float mean = ms / (float)ntn; float q = 0.f;
#pragma unroll
            for (int t = 0; t < 4; ++t) if (t < ntn) { const float dm = mt[t] - mean; q += m2[t] + 256.0f * dm * dm; }
            S[row] = (f32x2v){mean, 1.0f / sqrtf(q / (256.0f * (float)ntn) + eps)};
        }
        asm volatile("s_waitcnt lgkmcnt(0)" ::: "memory"); __builtin_amdgcn_s_barrier(); asm volatile("" ::: "memory");
        return bad;
    }
};
struct EpiLnRes {
    static constexpr bool PERM = false, AFTER_DRAIN = true;
    const float* base; float* out; int ldc; const float* bias; PanelStats st; unsigned poison;
    __device__ __forceinline__ void fused(f32x4 (&acc)[2][2][4][2], const Unit& u, int wr, int wc, int fr, int fq, PG8_LAS unsigned char* lds, int wid, int lane) const {
        typedef float f32x2v __attribute__((ext_vector_type(2)));
        const PG8_LAS f32x2v* S = (const PG8_LAS f32x2v*)(lds + 8192);
        const int col0 = u.pn * BM + wc * 32 + 4 * fq;
#pragma unroll
        for (int bj = 0; bj < 2; ++bj)
#pragma unroll
            for (int n = 0; n < 2; ++n) { const f32x4 bv = bias ? *(const f32x4*)(bias + col0 + bj * HALF + n * 16) : (f32x4){0.f, 0.f, 0.f, 0.f};
#pragma unroll
                for (int ai = 0; ai < 2; ++ai)
#pragma unroll
                    for (int m = 0; m < 4; ++m) acc[ai][bj][m][n] += bv; }
        f32x4 pre[4][2][2];
#pragma unroll
        for (int m = 0; m < 4; ++m) { const size_t off = (size_t)(u.pm * BM + wr * 64 + m * 16 + fr) * ldc + col0;
#pragma unroll
            for (int bj = 0; bj < 2; ++bj)
#pragma unroll
                for (int n = 0; n < 2; ++n) pre[m][bj][n] = *(const f32x4*)(base + off + bj * HALF + n * 16); }
        const bool bad = st.run(acc, u, wr, wc, fr, fq, lds, wid, lane) || poison != 0u;
        const float qnan = __builtin_nanf("");
#pragma unroll
        for (int ai = 0; ai < 2; ++ai)
#pragma unroll
            for (int m = 0; m < 4; ++m) { const int r = ai * HALF + wr * 64 + m * 16 + fr; const f32x2v sr = S[r]; const size_t off = (size_t)(u.pm * BM + r) * ldc + col0;
#pragma unroll
                for (int bj = 0; bj < 2; ++bj)
#pragma unroll
                    for (int n = 0; n < 2; ++n) { const f32x4 bs = ai == 0 ? pre[m][bj][n] : *(const f32x4*)(base + off + bj * HALF + n * 16); f32x4 o = bs + (acc[ai][bj][m][n] - sr.x) * sr.y;
                        if (bad) o = (f32x4){qnan, qnan, qnan, qnan}; *(f32x4*)(out + off + bj * HALF + n * 16) = o; }
                if (m & 1) asm volatile("" ::: "memory"); }
    }
};
struct EpiLnResLn {
    static constexpr bool PERM = false, AFTER_DRAIN = true;
    const float* base; float* out; bf16_t* xn; int ldc; const float* bias; PanelStats st1, st2; unsigned poison;
    __device__ __forceinline__ void fused(f32x4 (&acc)[2][2][4][2], const Unit& u, int wr, int wc, int fr, int fq, PG8_LAS unsigned char* lds, int wid, int lane) const {
        typedef float f32x2v __attribute__((ext_vector_type(2))); typedef unsigned u32x2v __attribute__((ext_vector_type(2)));
        const PG8_LAS f32x2v* S = (const PG8_LAS f32x2v*)(lds + 8192);
        const int col0 = u.pn * BM + wc * 32 + 4 * fq;
#pragma unroll
        for (int bj = 0; bj < 2; ++bj)
#pragma unroll
            for (int n = 0; n < 2; ++n) { const f32x4 bv = bias ? *(const f32x4*)(bias + col0 + bj * HALF + n * 16) : (f32x4){0.f, 0.f, 0.f, 0.f};
#pragma unroll
                for (int ai = 0; ai < 2; ++ai)
#pragma unroll
                    for (int m = 0; m < 4; ++m) acc[ai][bj][m][n] += bv; }
        bool bad = st1.run(acc, u, wr, wc, fr, fq, lds, wid, lane) || poison != 0u;
        const float qnan = __builtin_nanf("");
#pragma unroll
        for (int ai = 0; ai < 2; ++ai)
#pragma unroll
            for (int m = 0; m < 4; ++m) { const int r = ai * HALF + wr * 64 + m * 16 + fr; const f32x2v sr = S[r]; const size_t off = (size_t)(u.pm * BM + r) * ldc + col0;
#pragma unroll
                for (int bj = 0; bj < 2; ++bj)
#pragma unroll
                    for (int n = 0; n < 2; ++n) { const f32x4 bs = *(const f32x4*)(base + off + bj * HALF + n * 16); acc[ai][bj][m][n] = bs + (acc[ai][bj][m][n] - sr.x) * sr.y; }
                asm volatile("" : "+v"(acc[ai][0][m][0]), "+v"(acc[ai][0][m][1]), "+v"(acc[ai][1][m][0]), "+v"(acc[ai][1][m][1]));
                if (m & 1) asm volatile("" ::: "memory"); }
        const bool bad1 = bad;
        bad = st2.run(acc, u, wr, wc, fr, fq, lds, wid, lane) || bad;
#pragma unroll
        for (int ai = 0; ai < 2; ++ai)
#pragma unroll
            for (int m = 0; m < 4; ++m) { const int r = ai * HALF + wr * 64 + m * 16 + fr; const f32x2v sr = S[r]; const size_t off = (size_t)(u.pm * BM + r) * ldc + col0;
#pragma unroll
                for (int bj = 0; bj < 2; ++bj)
#pragma unroll
                    for (int n = 0; n < 2; ++n) { const f32x4 x1 = acc[ai][bj][m][n]; *(f32x4*)(out + off + bj * HALF + n * 16) = bad1 ? (f32x4){qnan, qnan, qnan, qnan} : x1;
                        const f32x4 o = (x1 - sr.x) * sr.y; u32x2v w; w.x = cvt_pk_bf16(o[0], o[1]); w.y = cvt_pk_bf16(o[2], o[3]);
                        if (bad) { w.x = 0x7fc07fc0u; w.y = 0x7fc07fc0u; } *(u32x2v*)(xn + off + bj * HALF + n * 16) = w; }
                asm volatile("" ::: "memory"); }
    }
};

template <class Epi, class Sched, bool ALIGN_EPI = false, bool SP2 = false, bool GATHER = false, bool FP8 = false>
__device__ __forceinline__ void gemm_phase(PG8_LAS unsigned char* lds, const Gemm g, const Sched& S, const Epi& E) {
    int tid_ = threadIdx.x; asm volatile("" : "+v"(tid_));
    const int tid = tid_, wid = __builtin_amdgcn_readfirstlane(tid >> 6), lane = tid & 63, wr = wid >> 2, wc = wid & 3, fr = lane & 15, fq = lane >> 4;
    const int K = g.K, nt = K / BK;
    unsigned voffA[2], voffB[2]; int RA[2]; unsigned CA2[2];
#pragma unroll
    for (int i = 0; i < 2; ++i) { int R, C; stage_rc(tid * 16 + i * 8192, R, C); const int Rb = Epi::PERM ? ((R & ~31) + perm32(R & 31)) : R;
        voffA[i] = (unsigned)(R * K + C) * 2u; voffB[i] = (unsigned)(Rb * K + C) * 2u; RA[i] = R; CA2[i] = (unsigned)C * 2u; }
    static_assert(!GATHER || SP2, "GATHER is wired into the SP2 loop only");
    unsigned vA0[2], vA1[2], nA0[2], nA1[2];
    _Pragma("unroll") for (int i = 0; i < 2; ++i) { vA0[i] = voffA[i]; vA1[i] = voffA[i]; nA0[i] = voffA[i]; nA1[i] = voffA[i]; }
    const size_t kstep = (size_t)(BK * 2);
    const size_t hstep = (size_t)HALF * K * 2;
    const size_t tstep = 2 * hstep;
    const size_t hstepA = GATHER ? 0 : hstep;
    const unsigned ldsw = (unsigned)wid * 1024u;
    const int aoff = lds_byte(wr * 64 + fr, fq * 8), boff = lds_byte(wc * 32 + fr, fq * 8);
#define PG8_SA(b, h) (((b) * 2 + (h)) * HTB)
#define PG8_SB(b, h) ((4 + (b) * 2 + (h)) * HTB)
#define PG8_STAGE(bufoff, gbase, voff) do { _Pragma("unroll") for (int _i = 0; _i < 2; ++_i) \
        __builtin_amdgcn_global_load_lds((const unsigned*)((const char*)(gbase) + (voff)[_i]), (PG8_LAS unsigned*)(lds + (bufoff) + ldsw + _i * 8192), 16, 0, 0); } while (0)
#define PG8_LDA(dst, b, h) do { if constexpr (FP8) { __builtin_amdgcn_sched_barrier(0); _Pragma("unroll") for (int m = 0; m < 4; ++m) dst##8[m] = cat8(*(const PG8_LAS bf16x8*)(lds + PG8_SA(b, h) + aoff + m * 2048), *(const PG8_LAS bf16x8*)(lds + PG8_SA(b, h) + aoff + m * 2048 + 1024)); } \
    else { _Pragma("unroll") for (int m = 0; m < 4; ++m) _Pragma("unroll") for (int k = 0; k < 2; ++k) dst[m][k] = *(const PG8_LAS bf16x8*)(lds + PG8_SA(b, h) + aoff + m * 2048 + k * 1024); } } while (0)
#define PG8_LDB(dst, b, h) do { if constexpr (FP8) { _Pragma("unroll") for (int n = 0; n < 2; ++n) dst##8[n] = cat8(*(const PG8_LAS bf16x8*)(lds + PG8_SB(b, h) + boff + n * 2048), *(const PG8_LAS bf16x8*)(lds + PG8_SB(b, h) + boff + n * 2048 + 1024)); } \
    else { _Pragma("unroll") for (int n = 0; n < 2; ++n) _Pragma("unroll") for (int k = 0; k < 2; ++k) dst[n][k] = *(const PG8_LAS bf16x8*)(lds + PG8_SB(b, h) + boff + n * 2048 + k * 1024); } } while (0)
#define PG8_MMA(ai, bj, At, Bt) do { __builtin_amdgcn_s_setprio(1); \
        if constexpr (FP8) { _Pragma("unroll") for (int m = 0; m < 4; ++m) _Pragma("unroll") for (int n = 0; n < 2; ++n) \
            acc[ai][bj][m][n] = __builtin_amdgcn_mfma_scale_f32_16x16x128_f8f6f4(Bt##8[n], At##8[m], acc[ai][bj][m][n], 0, 0, 0, 0, 0, 0); \
            _Pragma("unroll") for (int m = 0; m < 4; ++m) asm volatile("" : "+v"(acc[ai][bj][m][0]), "+v"(acc[ai][bj][m][1]));     \
            __builtin_amdgcn_sched_barrier(0); } \
        else { _Pragma("unroll") for (int m = 0; m < 4; ++m) _Pragma("unroll") for (int n = 0; n < 2; ++n) _Pragma("unroll") for (int k = 0; k < 2; ++k) \
            acc[ai][bj][m][n] = __builtin_amdgcn_mfma_f32_16x16x32_bf16(Bt[n][k], At[m][k], acc[ai][bj][m][n], 0, 0, 0); } \
        __builtin_amdgcn_s_setprio(0); } while (0)
#define PG8_WAIT_V(n) asm volatile("s_waitcnt vmcnt(" #n ")" ::: "memory")
#define PG8_WAIT_L(n) asm volatile("s_waitcnt lgkmcnt(" #n ")" ::: "memory")
#define PG8_BAR __builtin_amdgcn_s_barrier()
#define PG8_SCHED __builtin_amdgcn_sched_barrier(0)
    Unit cur, nxt; int ui = 0;
    if (!S.next(0, cur)) return;
    f32x4 acc[2][2][4][2];
#pragma unroll
    for (int a = 0; a < 2; ++a)
#pragma unroll
        for (int b = 0; b < 2; ++b)
#pragma unroll
            for (int m = 0; m < 4; ++m)
#pragma unroll
                for (int n = 0; n < 2; ++n) acc[a][b][m][n] = (f32x4){0.f, 0.f, 0.f, 0.f};
    bf16x8 At[4][2], B0[2][2], B1[2][2];
    v8i32 At8[4], B08[2], B18[2];
    const char* cA = GATHER ? (const char*)g.A : (const char*)g.A + (size_t)cur.pm * tstep;
    if constexpr (GATHER) { _Pragma("unroll") for (int i = 0; i < 2; ++i) { vA0[i] = S.rowoff(cur, RA[i]) + CA2[i]; vA1[i] = S.rowoff(cur, HALF + RA[i]) + CA2[i]; } }
    const char* cB = (const char*)g.Bt + cur.boff + (size_t)cur.pn * tstep;
    S.a_ready(cur);
    if constexpr (SP2) {
        PG8_STAGE(PG8_SB(0, 0), cB, voffB); PG8_STAGE(PG8_SB(0, 1), cB + hstep, voffB); PG8_STAGE(PG8_SA(0, 0), cA, vA0); PG8_STAGE(PG8_SA(0, 1), cA + hstepA, vA1);
        if (wr == 1) PG8_BAR;
        PG8_WAIT_V(2); PG8_BAR;
        PG8_STAGE(PG8_SB(1, 0), cB + kstep, voffB); PG8_STAGE(PG8_SA(1, 0), cA + kstep, vA0); PG8_STAGE(PG8_SB(1, 1), cB + hstep + kstep, voffB);
        PG8_WAIT_V(6); PG8_BAR;
    } else {
        PG8_STAGE(PG8_SB(0, 0), cB, voffB); PG8_STAGE(PG8_SA(0, 0), cA, voffA); PG8_STAGE(PG8_SB(0, 1), cB + hstep, voffB); PG8_STAGE(PG8_SA(0, 1), cA + hstep, voffA);
        if (wr == 1) PG8_BAR;
        PG8_WAIT_V(4); PG8_BAR;
        PG8_STAGE(PG8_SB(1, 0), cB + kstep, voffB); PG8_STAGE(PG8_SA(1, 0), cA + kstep, voffA); PG8_STAGE(PG8_SB(1, 1), cB + hstep + kstep, voffB);
        PG8_WAIT_V(6); PG8_BAR;
    }
    for (;;) {
        const bool has_next = S.next(ui + 1, nxt);
        const char* nA = GATHER ? cA : (has_next ? (const char*)g.A + (size_t)nxt.pm * tstep : cA);
        if constexpr (GATHER) { _Pragma("unroll") for (int i = 0; i < 2; ++i) { nA0[i] = has_next ? S.rowoff(nxt, RA[i]) + CA2[i] : vA0[i]; nA1[i] = has_next ? S.rowoff(nxt, HALF + RA[i]) + CA2[i] : vA1[i]; } }
        const char* nB = has_next ? (const char*)g.Bt + nxt.boff + (size_t)nxt.pn * tstep : cB;
        for (int t = 0; t < nt; t += 2) {
            const bool last = (t == nt - 2);
            const char* a1 = cA + (size_t)(t + 1) * kstep;
            const char* a2 = last ? nA : cA + (size_t)(t + 2) * kstep; const char* b2 = last ? nB : cB + (size_t)(t + 2) * kstep;
            const char* a3 = a2 + kstep; const char* b3 = b2 + kstep;
            if (last && has_next) S.a_ready(nxt);
            unsigned sA0[2], sA1[2]; _Pragma("unroll") for (int i = 0; i < 2; ++i) { sA0[i] = last ? nA0[i] : vA0[i]; sA1[i] = last ? nA1[i] : vA1[i]; }
            if constexpr (SP2) {
            PG8_LDB(B0, 0, 0); PG8_LDB(B1, 0, 1); PG8_SCHED; PG8_LDA(At, 0, 0); PG8_STAGE(PG8_SA(1, 1), a1 + hstepA, vA1);
            PG8_WAIT_V(8); PG8_WAIT_L(0); PG8_BAR; PG8_MMA(0, 0, At, B0); PG8_MMA(0, 1, At, B1); PG8_BAR; PG8_SCHED;
            PG8_LDA(At, 0, 1); PG8_STAGE(PG8_SB(0, 0), b2, voffB); PG8_STAGE(PG8_SB(0, 1), b2 + hstep, voffB); PG8_STAGE(PG8_SA(0, 0), a2, sA0);
            PG8_WAIT_V(8); PG8_WAIT_L(0); PG8_BAR; PG8_MMA(1, 0, At, B0); PG8_MMA(1, 1, At, B1); PG8_BAR; PG8_SCHED;
            PG8_LDB(B0, 1, 0); PG8_LDB(B1, 1, 1); PG8_SCHED; PG8_LDA(At, 1, 0); PG8_STAGE(PG8_SA(0, 1), a2 + hstepA, sA1);
            PG8_WAIT_V(8); PG8_WAIT_L(0); PG8_BAR; PG8_MMA(0, 0, At, B0); PG8_MMA(0, 1, At, B1); PG8_BAR; PG8_SCHED;
            PG8_LDA(At, 1, 1); PG8_STAGE(PG8_SB(1, 0), b3, voffB); PG8_STAGE(PG8_SB(1, 1), b3 + hstep, voffB); PG8_STAGE(PG8_SA(1, 0), a3, sA0);
            PG8_WAIT_V(8); PG8_WAIT_L(0); PG8_BAR; PG8_MMA(1, 0, At, B0); PG8_MMA(1, 1, At, B1); PG8_BAR; PG8_SCHED;
            } else {
            PG8_LDB(B0, 0, 0); PG8_SCHED; PG8_LDA(At, 0, 0); PG8_STAGE(PG8_SA(1, 1), a1 + hstep, voffA);
            PG8_WAIT_L(8); PG8_BAR; PG8_WAIT_L(0); PG8_MMA(0, 0, At, B0); PG8_BAR; PG8_SCHED;
            PG8_LDB(B1, 0, 1); PG8_STAGE(PG8_SB(0, 0), b2, voffB);
            PG8_BAR; PG8_WAIT_L(0); PG8_MMA(0, 1, At, B1); PG8_BAR;
            PG8_LDA(At, 0, 1); PG8_STAGE(PG8_SA(0, 0), a2, voffA);
            PG8_BAR; PG8_WAIT_L(0); PG8_MMA(1, 0, At, B0); PG8_BAR; PG8_SCHED;
            PG8_STAGE(PG8_SB(0, 1), b2 + hstep, voffB);
            PG8_WAIT_V(6); PG8_BAR; PG8_MMA(1, 1, At, B1); PG8_BAR;
            PG8_LDB(B0, 1, 0); PG8_SCHED; PG8_LDA(At, 1, 0); PG8_STAGE(PG8_SA(0, 1), a2 + hstep, voffA);
            PG8_WAIT_L(8); PG8_BAR; PG8_WAIT_L(0); PG8_MMA(0, 0, At, B0); PG8_BAR; PG8_SCHED;
            PG8_LDB(B1, 1, 1); PG8_STAGE(PG8_SB(1, 0), b3, voffB);
            PG8_BAR; PG8_WAIT_L(0); PG8_MMA(0, 1, At, B1); PG8_BAR;
            PG8_LDA(At, 1, 1); PG8_STAGE(PG8_SA(1, 0), a3, voffA);
            PG8_BAR; PG8_WAIT_L(0); PG8_MMA(1, 0, At, B0); PG8_BAR; PG8_SCHED;
            PG8_STAGE(PG8_SB(1, 1), b3 + hstep, voffB);
            PG8_WAIT_V(6); PG8_BAR; PG8_MMA(1, 1, At, B1); PG8_BAR;
            }
        }
        if constexpr (ALIGN_EPI) { if (wr == 0) PG8_BAR; }
        if constexpr (!Epi::AFTER_DRAIN) { E(acc, cur, wr, wc, fr, fq); S.done(cur); }
        if (!has_next) break;
#pragma unroll
        for (int a = 0; a < 2; ++a)
#pragma unroll
            for (int b = 0; b < 2; ++b)
#pragma unroll
                for (int m = 0; m < 4; ++m)
#pragma unroll
                    for (int n = 0; n < 2; ++n) acc[a][b][m][n] = (f32x4){0.f, 0.f, 0.f, 0.f};
        cur = nxt; cA = nA; cB = nB; ++ui;
        _Pragma("unroll") for (int i = 0; i < 2; ++i) { vA0[i] = nA0[i]; vA1[i] = nA1[i]; }
        if constexpr (ALIGN_EPI) { if (wr == 1) PG8_BAR; }
    }
    PG8_WAIT_V(0);
    if constexpr (!ALIGN_EPI) { if (wr == 0) PG8_BAR; }
    PG8_BAR;
    if constexpr (Epi::AFTER_DRAIN) { E.fused(acc, cur, wr, wc, fr, fq, lds, wid, lane); S.done(cur); }
#undef PG8_SA
#undef PG8_SB
#undef PG8_STAGE
#undef PG8_LDA
#undef PG8_LDB
#undef PG8_MMA
#undef PG8_WAIT_V
#undef PG8_WAIT_L
#undef PG8_BAR
#undef PG8_SCHED
}
}
#define GAS __attribute__((address_space(1)))
#define LAS __attribute__((address_space(3)))
typedef unsigned short bf16;
typedef unsigned v4u __attribute__((ext_vector_type(4)));
typedef float f32x4 __attribute__((ext_vector_type(4)));
typedef short bf16x8 __attribute__((ext_vector_type(8)));
typedef GAS unsigned gu32;
typedef GAS unsigned long long gu64;
#define RLX_AGENT __ATOMIC_RELAXED, __HIP_MEMORY_SCOPE_AGENT
#define LDS_WAIT() asm volatile("s_waitcnt lgkmcnt(0)" ::: "memory")
#define VM_WAIT() asm volatile("s_waitcnt vmcnt(0)" ::: "memory")
__device__ __forceinline__ unsigned long long rt() { return __builtin_amdgcn_s_memrealtime(); }
__device__ __forceinline__ unsigned f2bf(float f) { unsigned u = __builtin_bit_cast(unsigned, f); return (u + 0x7fffu + ((u >> 16) & 1u)) >> 16; }
typedef float pk2_f32x2 __attribute__((ext_vector_type(2))); typedef __bf16 pk2_bf16x2 __attribute__((ext_vector_type(2)));
__device__ __forceinline__ unsigned pk2(float lo, float hi) { const pk2_f32x2 v = {lo, hi}; return __builtin_bit_cast(unsigned, __builtin_convertvector(v, pk2_bf16x2)); }

#define XB_TMO      128
#define XB_XCNT(j)  (256  + 64 * (j))
#define XB_XSUB(j)  (1280 + 64 * (j))
#define XB_XGEN(j)  (2304 + 64 * (j))
#define XB_TOP      3328
#define XB_TOPGEN   3392
#define XCD_BAR_WORDS 3456
#define XB_SPIN_CAP (1u << 18)

__device__ __forceinline__ unsigned xb_ld(unsigned* p)              { return __hip_atomic_load(p, __ATOMIC_RELAXED, __HIP_MEMORY_SCOPE_AGENT); }
__device__ __forceinline__ unsigned xb_add(unsigned* p, unsigned v) { return __hip_atomic_fetch_add(p, v, __ATOMIC_RELAXED, __HIP_MEMORY_SCOPE_AGENT); }
__device__ __forceinline__ unsigned xb_xcc_id() { return (unsigned)__builtin_amdgcn_s_getreg((3 << 11) | 20) & 0xFu; }
#define XB_SPIN(cond, bar) do { unsigned _sp = 0; while (cond) { __builtin_amdgcn_s_sleep(1); \
    if ((++_sp & 255u) == 0u) { if (xb_ld(&(bar)[XB_TMO])) break; if (_sp > XB_SPIN_CAP) { atomicAdd(&(bar)[XB_TMO], 1u); break; } } } } while (0)

struct XcdBarrier {
    unsigned* bar; unsigned x;
    volatile LAS unsigned* st;
};

__device__ __forceinline__ XcdBarrier xcd_barrier_post(unsigned* bar, volatile LAS unsigned* st) {
    XcdBarrier b; b.bar = bar; b.x = xb_xcc_id(); b.st = st;
    if (threadIdx.x == 0) (void)xb_add(&bar[XB_XCNT(b.x)], 1u);
    return b;
}
__device__ __forceinline__ void xcd_barrier_complete(unsigned* bar, unsigned x, unsigned& nloc, unsigned& nx) {
    const unsigned G = gridDim.x * gridDim.y * gridDim.z;
    unsigned sum, cnt, mine, sp = 0u;
    for (;;) {
        sum = 0u; cnt = 0u; mine = 0u;
#pragma unroll
        for (unsigned j = 0; j < 16; ++j) { const unsigned c = xb_ld(&bar[XB_XCNT(j)]); sum += c; cnt += (c > 0u) ? 1u : 0u; mine = (j == x) ? c : mine; }
        if (sum == G) break;
        __builtin_amdgcn_s_sleep(1);
        if ((++sp & 255u) == 0u) { if (xb_ld(&bar[XB_TMO])) break; if (sp > XB_SPIN_CAP) { atomicAdd(&bar[XB_TMO], 1u); break; } }
    }
    nloc = mine > 0u ? mine : 1u; nx = cnt > 0u ? cnt : 1u;
}

__device__ __forceinline__ void xcd_barrier(const XcdBarrier& b) {
    asm volatile("s_waitcnt vmcnt(0)" ::: "memory");
    __syncthreads();
    if (threadIdx.x == 0) {
        unsigned* bar = b.bar;
        __builtin_amdgcn_s_waitcnt(0);
        unsigned nloc = b.st[0], nx = b.st[1];
        if (nloc == 0u) { xcd_barrier_complete(bar, b.x, nloc, nx); b.st[0] = nloc; b.st[1] = nx; }
        const unsigned old = xb_add(&bar[XB_XSUB(b.x)], 1u);
        const unsigned gen = old / nloc;
        if (old + 1u == (gen + 1u) * nloc) {
            __builtin_amdgcn_fence(__ATOMIC_RELEASE, "agent");
            asm volatile("s_waitcnt vmcnt(0)" ::: "memory");
            unsigned og; { const unsigned z_ = 0u, o_ = 1u; unsigned* tp_ = &bar[XB_TOP];
              asm volatile("global_atomic_add %0, %1, %2, %3 sc0\n\tbuffer_inv sc1\n\ts_waitcnt vmcnt(0)" : "=&v"(og) : "v"(z_), "v"(o_), "s"(tp_) : "memory"); }
            const unsigned tg = og / nx;
            if (og + 1u != (tg + 1u) * nx) XB_SPIN(xb_ld(&bar[XB_TOP]) < (tg + 1u) * nx, bar);
            asm volatile("s_waitcnt vmcnt(0)" ::: "memory");
            xb_add(&bar[XB_XGEN(b.x)], 1u);
            asm volatile("s_waitcnt vmcnt(0)" ::: "memory");
        } else {
            asm volatile("buffer_inv sc1" ::: "memory");
            XB_SPIN(xb_ld(&bar[XB_XGEN(b.x)]) == gen, bar);
            asm volatile("s_waitcnt vmcnt(0)" ::: "memory");
        }
    }
    __syncthreads();
}

constexpr int NWAVES = 8, NTHR = 512;
constexpr int T = 16384, D = 1024, SEQ = 8192, NE = 16, DE = 512, NLAYER = 4, NSELF = 2, CONVW = 31;
constexpr int NH = 8, HD = 64, VD = 128;
constexpr float LN_EPS = 1e-5f;
#ifndef MOE_FP8
#define MOE_FP8 1
#endif
#ifndef DENSE_FP8_S1
#define DENSE_FP8_S1 1
#endif
#ifndef DENSE_FP8_C1
#define DENSE_FP8_C1 1
#endif
#ifndef DENSE_FP8_S3
#define DENSE_FP8_S3 1
#endif
#ifndef DENSE_FP8_C4
#define DENSE_FP8_C4 1
#endif
#ifndef ATTN_FP8
#define ATTN_FP8 1
#endif
#ifndef OUT_FP8_MIX
#define OUT_FP8_MIX 0
#endif
#ifndef OUT_FP8_Y
#define OUT_FP8_Y 0
#endif
#ifndef LN_FUSED
#define LN_FUSED 0
#endif
#ifndef ATTN_DV128
#define ATTN_DV128 1
#endif
#ifndef ATTN_SLOW
#define ATTN_SLOW 0
#endif
constexpr float ATTN_QSCALE = ATTN_SLOW ? 1.0f : 0.125f * 1.4426950408889634f;
constexpr float ALPHA = 1.6817928305074290f;
constexpr int XG_ROWS = 36864;
constexpr int MAXTILES = XG_ROWS / 256;

constexpr size_t MiB = 1u << 20;
constexpr size_t WS_CTL = 0, CTL_ZERO_BYTES = 1 * MiB;
constexpr size_t WS_PW1T = 2 * MiB;
constexpr size_t WS_PW2T = 10 * MiB;
constexpr size_t WS_WQ0T = 14 * MiB;
constexpr size_t WS_WKVT = 16 * MiB;
constexpr size_t WS_WQ1T = 20 * MiB;
constexpr size_t WS_WOT  = 22 * MiB;
constexpr size_t WS_XCH  = 28 * MiB;
constexpr size_t WS_ROUT = 26 * MiB;
__host__ __device__ constexpr size_t ws_wgut(int l) { return (l & 1) ? 80 * MiB : 32 * MiB; }
__host__ __device__ constexpr size_t ws_wdt(int l) { return (l & 1) ? 112 * MiB : 64 * MiB; }
constexpr size_t WS_XS8  = 128 * MiB;
constexpr float OUT_SCALE = 8.f;
constexpr float U_SCALE = 8.f;
constexpr float WX_SCALE = 16.f;
constexpr float WG_SCALE = 16.f, WD_SCALE = 32.f, H_SCALE = 4.f;
constexpr size_t WS_XBF  = 144 * MiB;
constexpr size_t WS_KB   = 176 * MiB;
constexpr size_t WS_VB   = 208 * MiB;
constexpr size_t WS_SCR  = 240 * MiB;
constexpr size_t WS_H1   = WS_SCR;
constexpr size_t WS_US   = WS_SCR + 64 * MiB;
constexpr size_t WS_Q    = WS_SCR;
constexpr size_t WS_O12  = WS_SCR + 32 * MiB;
constexpr size_t WS_MIX  = WS_SCR + 160 * MiB;
constexpr size_t WS_XG   = WS_SCR;
constexpr size_t WS_HU   = WS_SCR + 72 * MiB;
constexpr size_t WS_HH   = WS_SCR + 144 * MiB;
constexpr size_t WS_Y    = WS_SCR + 180 * MiB;
constexpr size_t WS_END  = WS_SCR + 252 * MiB;
constexpr int CW_TMO = 0, CW_CODE = 1;
constexpr int CW_BAR = 4096;
constexpr int CW_CNT = 16384;
constexpr int CW_SEAM = 32768;
constexpr int CW_CVT = 16384 + 4 * 16 * 64;

constexpr int RING_OFF = 0, RING_BYTES = 131072;
constexpr int LDSCTL_OFF = RING_BYTES;
constexpr int LDS_BYTES = 147456;
constexpr int LI_OFF = 32, LI_NT = 49, LI_TEXP = 64, LI_CNT = 224, LI_ROWS = 256;

__constant__ unsigned char c_bucket[128] = {0, 1, 2, 3, 4, 5, 6, 7, 8, 9, 10, 11, 12, 13, 14, 15, 16, 16, 16, 17, 17, 18, 18, 18, 19, 19, 19, 20, 20, 20, 20, 21, 21, 21, 21, 22, 22, 22, 22, 22, 23, 23, 23, 23, 23, 23, 24, 24, 24, 24, 24, 24, 25, 25, 25, 25, 25, 25, 25, 26, 26, 26, 26, 26, 26, 26, 26, 27, 27, 27, 27, 27, 27, 27, 27, 27, 27, 28, 28, 28, 28, 28, 28, 28, 28, 28, 28, 29, 29, 29, 29, 29, 29, 29, 29, 29, 29, 29, 29, 30, 30, 30, 30, 30, 30, 30, 30, 30, 30, 30, 30, 30, 30, 31, 31, 31, 31, 31, 31, 31, 31, 31, 31, 31, 31, 31, 31, 31};

#include <hip/hip_bf16.h>
#include <cmath>
namespace attn_body {
using bf16=__hip_bfloat16;
using bf16x8=__attribute__((ext_vector_type(8)))short;
using s16x4=__attribute__((ext_vector_type(4)))short;
using f32x16=__attribute__((ext_vector_type(16)))float;
using u32x4=__attribute__((ext_vector_type(4)))unsigned;
constexpr int BATCH=2,NHEAD=16,SEQ=8192,D=64,DM=NHEAD*D;
constexpr int NW=8,QBLK=32,QB=QBLK*NW,KVBLK=64,NQB=SEQ/QB;
constexpr int ATTN_PITCH=DM, ATTN_UNIT_ROWS=QB;
__device__ __forceinline__ int crow(int r,int hi){return (r&3)+8*(r>>2)+4*hi;}
#define SBAR() __builtin_amdgcn_sched_barrier(0)
__device__ __forceinline__ void cmask(f32x16&p0,f32x16&p1,int jb,int qrel,int hi){
  const float NEG=-INFINITY; int kb=64*jb+4*hi;
  #pragma unroll
  for(int r=0;r<16;++r){int kv=kb+(r&3)+8*(r>>2); if(kv>qrel)p0[r]=NEG; if(kv+32>qrel)p1[r]=NEG;}
}

__device__ __forceinline__ void cbm(f32x16&p0,f32x16&p1,int jb,int qrel,int hi,const __attribute__((address_space(3))) float*dt){
  const float NEG=-INFINITY; const int nb=qrel-64*jb-4*hi;
  #pragma unroll
  for(int r=0;r<16;++r){const int n0=nb-((r&3)+8*(r>>2)),n1=n0-32; const float d0=dt[n0<0?0:n0],d1=dt[n1<0?0:n1];
    p0[r]=n0<0?NEG:p0[r]+d0; p1[r]=n1<0?NEG:p1[r]+d1;}
}

constexpr int NSLOT=3, SLOTB=8192;
constexpr int LDS_K=0, LDS_V=NSLOT*SLOTB, LDS_WS=2*NSLOT*SLOTB, LDS_OST=LDS_WS+NW*64*4, LDS_DT=LDS_OST+NW*4096, LDS_BYTES=LDS_DT+512*4;
constexpr float C2=0.125f*1.4426950408889634f;
__device__ __forceinline__ void glds16(const void*gsrc,unsigned lds_dst){unsigned keep;
  asm volatile("s_mov_b32 %0, m0\n\ts_mov_b32 m0, %2\n\ts_nop 0\n\tglobal_load_lds_dwordx4 %1, off\n\ts_mov_b32 m0, %0":"=&s"(keep):"v"(gsrc),"s"(lds_dst):"memory");}
__device__ __forceinline__ float max3f(float a,float b,float c){float r;asm("v_max3_f32 %0, %1, %2, %3":"=v"(r):"v"(a),"v"(b),"v"(c));return r;}
__device__ __forceinline__ float max2f(float a,float b){float r;asm("v_max_f32_e32 %0, %1, %2":"=v"(r):"v"(a),"v"(b));return r;}
__device__ __forceinline__ float fadd_s(float a,float b){float r;asm("v_add_f32_e32 %0, %1, %2":"=v"(r):"v"(a),"v"(b));return r;}
__device__ __forceinline__ float fsub_s(float a,float b){float r;asm("v_sub_f32_e32 %0, %1, %2":"=v"(r):"v"(a),"v"(b));return r;}
typedef float f32x2_t __attribute__((ext_vector_type(2))); typedef __bf16 bf16x2_t __attribute__((ext_vector_type(2)));
__device__ __forceinline__ unsigned cvtpk_s(float lo,float hi){f32x2_t v={lo,hi};bf16x2_t b=__builtin_convertvector(v,bf16x2_t);return __builtin_bit_cast(unsigned,b);}
#define WAIT_BAR(N) asm volatile("s_waitcnt vmcnt(" #N ") lgkmcnt(0)\n\ts_barrier":::"memory")

__device__ __forceinline__ void qkt(f32x16&p0,f32x16&p1,const char*Kslot,const bf16x8*qr,const f32x16&negm,int r32,int hi){
  const char*kb=Kslot+hi*1024+r32*16;
  #pragma unroll
  for(int d0=0;d0<4;++d0){
    const bf16x8 b0=*reinterpret_cast<const bf16x8*>(kb+d0*2048);
    const bf16x8 b1=*reinterpret_cast<const bf16x8*>(kb+d0*2048+512);
    if(d0==0){p0=__builtin_amdgcn_mfma_f32_32x32x16_bf16(b0,qr[0],negm,0,0,0);p1=__builtin_amdgcn_mfma_f32_32x32x16_bf16(b1,qr[0],negm,0,0,0);}
    else{p0=__builtin_amdgcn_mfma_f32_32x32x16_bf16(b0,qr[d0],p0,0,0,0);p1=__builtin_amdgcn_mfma_f32_32x32x16_bf16(b1,qr[d0],p1,0,0,0);}}
}
typedef __attribute__((address_space(3))) const char* lds_cptr;
typedef short v4i16_t __attribute__((ext_vector_type(4)));
__device__ __forceinline__ void kload8(bf16x8*kf,lds_cptr kp){
  kf[0]=*(const __attribute__((address_space(3))) bf16x8*)(kp);      kf[1]=*(const __attribute__((address_space(3))) bf16x8*)(kp+512);
  kf[2]=*(const __attribute__((address_space(3))) bf16x8*)(kp+2048); kf[3]=*(const __attribute__((address_space(3))) bf16x8*)(kp+2560);
  kf[4]=*(const __attribute__((address_space(3))) bf16x8*)(kp+4096); kf[5]=*(const __attribute__((address_space(3))) bf16x8*)(kp+4608);
  kf[6]=*(const __attribute__((address_space(3))) bf16x8*)(kp+6144); kf[7]=*(const __attribute__((address_space(3))) bf16x8*)(kp+6656);
}
__device__ __forceinline__ void kload2(bf16x8*kf,lds_cptr kp,int j){ kf[2*j]=*(const __attribute__((address_space(3))) bf16x8*)(kp+j*2048); kf[2*j+1]=*(const __attribute__((address_space(3))) bf16x8*)(kp+j*2048+512); }
__device__ __forceinline__ s16x4 vtr(lds_cptr p){ return __builtin_bit_cast(s16x4,__builtin_amdgcn_ds_read_tr16_b64_v4i16((__attribute__((address_space(3))) v4i16_t*)p)); }
__device__ __forceinline__ float rowmax(const f32x16&p0,const f32x16&p1){
  float a=max3f(p0[0],p0[1],p1[0]),b=max3f(p0[2],p0[3],p1[1]);a=max3f(a,p1[2],p1[3]);
  #pragma unroll
  for(int r=4;r<16;r+=4){a=max3f(a,p0[r],p0[r+1]);b=max3f(b,p0[r+2],p0[r+3]);a=max3f(a,p1[r],p1[r+1]);b=max3f(b,p1[r+2],p1[r+3]);}
  const float m=max2f(a,b);
  auto rr=__builtin_amdgcn_permlane32_swap(__float_as_uint(m),__float_as_uint(m),false,false);
  return max2f(__uint_as_float(rr[0]),__uint_as_float(rr[1]));
}
__device__ __forceinline__ void pv(f32x16*o,int vb,bf16x8 pa0,bf16x8 pa1,bf16x8 pa2,bf16x8 pa3){
  #pragma unroll
  for(int d0=0;d0<2;++d0){s16x4 lo[4],hi[4];
    #pragma unroll
    for(int ks=0;ks<4;++ks){
      asm volatile("ds_read_b64_tr_b16 %0,%1 offset:%c2":"=&v"(lo[ks]):"v"(vb),"i"(d0*4096+ks*1024):"memory");
      asm volatile("ds_read_b64_tr_b16 %0,%1 offset:%c2":"=&v"(hi[ks]):"v"(vb),"i"(d0*4096+ks*1024+512):"memory");}
    asm volatile("s_waitcnt lgkmcnt(0)":::"memory");SBAR();
    #define PK(k) (bf16x8){lo[k][0],lo[k][1],lo[k][2],lo[k][3],hi[k][0],hi[k][1],hi[k][2],hi[k][3]}
    o[d0]=__builtin_amdgcn_mfma_f32_32x32x16_bf16(pa0,PK(0),o[d0],0,0,0);
    o[d0]=__builtin_amdgcn_mfma_f32_32x32x16_bf16(pa1,PK(1),o[d0],0,0,0);
    o[d0]=__builtin_amdgcn_mfma_f32_32x32x16_bf16(pa2,PK(2),o[d0],0,0,0);
    o[d0]=__builtin_amdgcn_mfma_f32_32x32x16_bf16(pa3,PK(3),o[d0],0,0,0);
    #undef PK
  }
}

#ifndef ATTN_STORE16
#define ATTN_STORE16(p,v) (*(u32x4*)(p)=(v))
#endif
template<int THRL> __device__ __forceinline__ void attn_unit(int b,int hq,int hv,int qb,const bf16*Q,const bf16*__restrict__ K,const bf16*__restrict__ V,bf16*O,const float*__restrict__ relb,char*shm){
  int tid_=threadIdx.x; asm volatile("":"+v"(tid_));
  const int tid=tid_,lane=tid&63,r32=lane&31,hi=lane>>5; const int wid=__builtin_amdgcn_readfirstlane(tid>>6);
  const long rowbase=(long)b*SEQ; const int q0=qb*QB;
  const bf16*Qw=Q+(rowbase+q0+wid*QBLK)*DM+hq*D;
  const bf16*Kh=K+rowbase*DM+hq*D,*Vh=V+rowbase*DM+hv*D;
  const lds_cptr shm3=(lds_cptr)shm;
  const unsigned lds0=(unsigned)(uintptr_t)shm;
  float*wsf=(float*)(shm+LDS_WS)+wid*64;
  const bf16*ksrc=Kh+(long)lane*DM+wid*8;
  const bf16*vsrc=Vh+(long)(16*(wid&3)+(lane>>2))*DM+(wid>>2)*32+(lane&3)*8;
  const unsigned kdst=lds0+LDS_K+wid*1024, vdst=lds0+LDS_V+wid*1024;
  #define DMA_K(t,slot) glds16(ksrc+(long)(t)*KVBLK*DM,(unsigned)__builtin_amdgcn_readfirstlane(kdst+(slot)))
  #define DMA_V(t,slot) glds16(vsrc+(long)(t)*KVBLK*DM,(unsigned)__builtin_amdgcn_readfirstlane(vdst+(slot)))
  const int vb0=(int)(lds0+LDS_V)+((lane>>4)&1)*32+(lane&3)*8+(4*hi+((lane&15)>>2))*64;
  const char*Kbase=shm+LDS_K; bf16x8 kf[8];
  const lds_cptr kp0=shm3+LDS_K+hi*1024+r32*16; const lds_cptr vp0=shm3+LDS_V+((lane>>4)&1)*32+(lane&3)*8+(4*hi+((lane&15)>>2))*64;
  const int NT=(q0+QB)/KVBLK;
  const __attribute__((address_space(3))) float*dtab=(const __attribute__((address_space(3))) float*)(shm3+LDS_DT);
  { const int h8=hq&7; const float bfar=relb[31*8+h8]; const float dv=(tid<113)?(relb[(int)c_bucket[tid<128?tid:0]*8+h8]-bfar)*1.4426950408889634f:0.f;
    ((__attribute__((address_space(3))) float*)(shm3+LDS_DT))[tid]=dv; }
  DMA_K(0,0);DMA_V(0,0);DMA_K(1,SLOTB);
  bf16x8 qr[4];
  #pragma unroll
  for(int d0=0;d0<4;++d0)qr[d0]=*reinterpret_cast<const bf16x8*>(&Qw[(long)r32*DM+d0*16+hi*8]);
  float mhat=0.f,l_reg=0.f;f32x16 o[2];o[0]=f32x16{};o[1]=f32x16{};f32x16 negm=f32x16{};asm volatile("":"+v"(negm));
  const int qrel=wid*QBLK+r32;
  #define CMASK(P0,P1,t) do{int jb_=(t)-(NT-4); if(jb_>=-2)cbm(P0,P1,jb_,qrel,hi,dtab);}while(0)
  bool resc=false;
  #define START(P0,P1) do{ const float rm=rowmax(P0,P1); resc=false; \
    { const float dl=rm; mhat=fadd_s(mhat,dl); \
      _Pragma("unroll") for(int r=0;r<16;++r){P0[r]=fsub_s(P0[r],dl);P1[r]=fsub_s(P1[r],dl);} \
      _Pragma("unroll") for(int r=0;r<16;++r)negm[r]=-mhat; asm volatile("":"+v"(negm)); } \
    _Pragma("unroll") for(int r=0;r<16;++r)P0[r]=__builtin_amdgcn_exp2f(P0[r]); }while(0)
  #define RESC() do{ if(resc){ asm volatile("s_waitcnt lgkmcnt(0)":::"memory"); \
      _Pragma("unroll") for(int d_=0;d_<2;++d_) _Pragma("unroll") for(int r=0;r<16;++r)o[d_][r]*=wsf[crow(r,hi)]; } }while(0)
  f32x16 pA0,pA1,pB0,pB1;
  int sl_prev=0,sl_cur=0,sl_next=SLOTB;
  #define ROT() do{sl_prev=sl_cur;sl_cur=sl_next;sl_next=(sl_next==(NSLOT-1)*SLOTB)?0:sl_next+SLOTB;}while(0)
  DMA_K(2,2*SLOTB);
  WAIT_BAR(3);
  qkt(pA0,pA1,Kbase,qr,negm,r32,hi);asm volatile("s_nop 15\n\ts_nop 7":"+v"(pA0),"+v"(pA1));CMASK(pA0,pA1,0);
  START(pA0,pA1);
  _Pragma("unroll") for(int r=0;r<16;++r)pA1[r]=__builtin_amdgcn_exp2f(pA1[r]);
  WAIT_BAR(0);
  DMA_K(3,0);DMA_V(1,SLOTB);
  ROT();
  kload8(kf,kp0+sl_cur);
  WAIT_BAR(2);
  s16x4 vlo[8],vhi[8]; u32x4 pw0,pw1,pw2,pw3;
  #define PKW(P,B) cvtpk_s(P[B],P[B+1])
  #define PAF(k) __builtin_bit_cast(bf16x8,pw##k)
  #define VFR(i) (bf16x8){vlo[i][0],vlo[i][1],vlo[i][2],vlo[i][3],vhi[i][0],vhi[i][1],vhi[i][2],vhi[i][3]}
  #define PIN(x) asm volatile("":"+v"(x))
  #define MX3(a,b,c) __builtin_fmaxf(__builtin_fmaxf((a),(b)),(c))
  #define GAPA(MF,A0,A1,A2,A3,W0,W1,PW) do{ MF; sacc+=A0; sacc+=A1; sacc+=A2; sacc+=A3; PIN(sacc); W0; W1; PIN(PW); SBAR(); }while(0)
  #define EX(v) __builtin_amdgcn_exp2f(v)
  #define GAPB(MF,X,B) do{ MF; X[B]=EX(X[B]); X[B+1]=EX(X[B+1]); X[B+2]=EX(X[B+2]); X[B+3]=EX(X[B+3]); PIN(X); SBAR(); }while(0)
  #define VRD(i) do{ vlo[i]=vtr(vp_+(((i)>>2)*4096+((i)&3)*1024)); vhi[i]=vtr(vp_+(((i)>>2)*4096+((i)&3)*1024+512)); }while(0)
  #define KRD(G,j) do{ if(G){ kload2(kf,kp0+sl_next,j); SBAR(); } }while(0)
  #define STEP(C0,C1,P0,P1,t,GK,GV,GL) do{ SBAR(); \
    const lds_cptr vp_=vp0+sl_prev; \
    VRD(0); SBAR(); float sacc=(P0[0]+P0[1]); \
    GAPA(C0=__builtin_amdgcn_mfma_f32_32x32x16_bf16(kf[0],qr[0],negm,0,0,0), P0[2],P0[3],P0[4],P0[5],     pw0[0]=PKW(P0,0), pw0[1]=PKW(P0,2), pw0); \
    VRD(4); SBAR(); GAPA(C1=__builtin_amdgcn_mfma_f32_32x32x16_bf16(kf[1],qr[0],negm,0,0,0), P0[6],P0[7],P0[8],P0[9],     pw0[2]=PKW(P0,4), pw0[3]=PKW(P0,6), pw0); \
    VRD(1); SBAR(); GAPA(C0=__builtin_amdgcn_mfma_f32_32x32x16_bf16(kf[2],qr[1],C0,0,0,0),   P0[10],P0[11],P0[12],P0[13], pw1[0]=PKW(P0,8), pw1[1]=PKW(P0,10), pw1); \
    VRD(5); SBAR(); GAPA(C1=__builtin_amdgcn_mfma_f32_32x32x16_bf16(kf[3],qr[1],C1,0,0,0),   P0[14],P0[15],P1[0],P1[1],   pw1[2]=PKW(P0,12),pw1[3]=PKW(P0,14), pw1); \
    VRD(2); SBAR(); GAPA(C0=__builtin_amdgcn_mfma_f32_32x32x16_bf16(kf[4],qr[2],C0,0,0,0),   P1[2],P1[3],P1[4],P1[5],     pw2[0]=PKW(P1,0), pw2[1]=PKW(P1,2), pw2); \
    VRD(6); SBAR(); GAPA(C1=__builtin_amdgcn_mfma_f32_32x32x16_bf16(kf[5],qr[2],C1,0,0,0),   P1[6],P1[7],P1[8],P1[9],     pw2[2]=PKW(P1,4), pw2[3]=PKW(P1,6), pw2); \
    VRD(3); SBAR(); GAPA(C0=__builtin_amdgcn_mfma_f32_32x32x16_bf16(kf[6],qr[3],C0,0,0,0),   P1[10],P1[11],P1[12],P1[13], pw3[0]=PKW(P1,8), pw3[1]=PKW(P1,10), pw3); \
    VRD(7); SBAR(); GAPA(C1=__builtin_amdgcn_mfma_f32_32x32x16_bf16(kf[7],qr[3],C1,0,0,0),   P1[14],P1[15],0.f,0.f,       pw3[2]=PKW(P1,12),pw3[3]=PKW(P1,14), pw3); \
    l_reg+=sacc; \
    if(GK){DMA_K((t)+3,sl_cur);} if(GV){DMA_V((t)+1,sl_next);} \
    CMASK(C0,C1,t); \
    { float a=MX3(C0[0],C0[1],C1[0]),b=MX3(C0[2],C0[3],C1[1]); a=MX3(a,C1[2],C1[3]); \
      _Pragma("unroll") for(int r=4;r<16;r+=4){a=MX3(a,C0[r],C0[r+1]);b=MX3(b,C0[r+2],C0[r+3]);a=MX3(a,C1[r],C1[r+1]);b=MX3(b,C1[r+2],C1[r+3]);} \
      float rm=__builtin_fmaxf(a,b); { auto rr=__builtin_amdgcn_permlane32_swap(__float_as_uint(rm),__float_as_uint(rm),false,false); rm=__builtin_fmaxf(__uint_as_float(rr[0]),__uint_as_float(rr[1])); } \
      resc=false; \
      if(__builtin_expect(__any(rm>(float)THRL),0)){ const float dl=__builtin_fmaxf(rm,0.f); mhat+=dl; \
        _Pragma("unroll") for(int r=0;r<16;++r){C0[r]-=dl;C1[r]-=dl;} \
        _Pragma("unroll") for(int r=0;r<16;++r)negm[r]=-mhat; asm volatile("":"+v"(negm)); \
        const float f=__builtin_amdgcn_exp2f(-dl); l_reg*=f; if(hi==0)wsf[r32]=f; resc=true; } } \
    SBAR(); \
    GAPB(o[0]=__builtin_amdgcn_mfma_f32_32x32x16_bf16(PAF(0),VFR(0),o[0],0,0,0), C0,0); \
    GAPB(o[1]=__builtin_amdgcn_mfma_f32_32x32x16_bf16(PAF(0),VFR(4),o[1],0,0,0), C0,4); \
    KRD(GL,0); GAPB(o[0]=__builtin_amdgcn_mfma_f32_32x32x16_bf16(PAF(1),VFR(1),o[0],0,0,0), C0,8); \
    KRD(GL,1); GAPB(o[1]=__builtin_amdgcn_mfma_f32_32x32x16_bf16(PAF(1),VFR(5),o[1],0,0,0), C0,12); \
    KRD(GL,2); GAPB(o[0]=__builtin_amdgcn_mfma_f32_32x32x16_bf16(PAF(2),VFR(2),o[0],0,0,0), C1,0); \
    KRD(GL,3); GAPB(o[1]=__builtin_amdgcn_mfma_f32_32x32x16_bf16(PAF(2),VFR(6),o[1],0,0,0), C1,4); \
    GAPB(o[0]=__builtin_amdgcn_mfma_f32_32x32x16_bf16(PAF(3),VFR(3),o[0],0,0,0), C1,8); \
    GAPB(o[1]=__builtin_amdgcn_mfma_f32_32x32x16_bf16(PAF(3),VFR(7),o[1],0,0,0), C1,12); \
    }while(0)
  int t=1;
  #undef CMASK
  #define CMASK(P0,P1,t) do{}while(0)
  for(;t+7<NT;t+=2){
    STEP(pB0,pB1,pA0,pA1,t,true,true,true);     WAIT_BAR(2); RESC(); ROT();
    STEP(pA0,pA1,pB0,pB1,t+1,true,true,true);   WAIT_BAR(2); RESC(); ROT();
  }
  #undef CMASK
  #define CMASK(P0,P1,t) do{int jb_=(t)-(NT-4); if(jb_>=-2)cbm(P0,P1,jb_,qrel,hi,dtab);}while(0)
  #define ENDW(tt) do{ if((tt)+3<NT){WAIT_BAR(2);} else if((tt)+2<NT){WAIT_BAR(1);} else {WAIT_BAR(0);} }while(0)
  for(;t+1<NT;t+=2){
    STEP(pB0,pB1,pA0,pA1,t,(t+3<NT),(t+1<NT),(t+1<NT));       ENDW(t);   RESC(); ROT();
    STEP(pA0,pA1,pB0,pB1,t+1,(t+4<NT),(t+2<NT),(t+2<NT));     ENDW(t+1); RESC(); ROT();
  }
  STEP(pB0,pB1,pA0,pA1,NT-1,false,false,false); RESC();
  { float sacc=pB0[0]+pB0[1]; _Pragma("unroll") for(int r=2;r<16;++r)sacc+=pB0[r]; _Pragma("unroll") for(int r=0;r<16;++r)sacc+=pB1[r]; l_reg+=sacc;
    pw0=(u32x4){PKW(pB0,0),PKW(pB0,2),PKW(pB0,4),PKW(pB0,6)};pw1=(u32x4){PKW(pB0,8),PKW(pB0,10),PKW(pB0,12),PKW(pB0,14)};pw2=(u32x4){PKW(pB1,0),PKW(pB1,2),PKW(pB1,4),PKW(pB1,6)};pw3=(u32x4){PKW(pB1,8),PKW(pB1,10),PKW(pB1,12),PKW(pB1,14)};
    SBAR(); pv(o,vb0+sl_cur,PAF(0),PAF(1),PAF(2),PAF(3)); }
  #undef PKW
  #undef PAF
  #undef VFR
  #undef PIN
  #undef MX3
  #undef GAPA
  #undef GAPB
  #undef EX
  #undef VRD
  #undef KRD
  #undef STEP
  #undef ENDW
  {auto rr=__builtin_amdgcn_permlane32_swap(__float_as_uint(l_reg),__float_as_uint(l_reg),false,false);l_reg=__uint_as_float(rr[0])+__uint_as_float(rr[1]);}
  if(hi==0)wsf[32+r32]=l_reg;asm volatile("s_waitcnt lgkmcnt(0)":::"memory");
  float rli[16];
  #pragma unroll
  for(int r=0;r<16;++r)rli[r]=__builtin_amdgcn_rcpf(wsf[32+crow(r,hi)]);
  bf16*Ow=O+(rowbase+q0+wid*QBLK)*DM+hv*D;
  { bf16*stg=(bf16*)(shm+LDS_OST)+wid*2048;
    #pragma unroll
    for(int r=0;r<16;++r){const int orow=crow(r,hi);
      #pragma unroll
      for(int d0=0;d0<2;++d0)stg[orow*64+d0*32+r32]=__float2bfloat16(o[d0][r]*rli[r]);}
    asm volatile("s_waitcnt lgkmcnt(0)":::"memory");
    #pragma unroll
    for(int i=0;i<4;++i){const int row=i*8+(lane>>3),ch=lane&7; const u32x4 v=*(const u32x4*)(stg+row*64+ch*8); ATTN_STORE16(Ow+(long)row*DM+ch*8,v);} }
  asm volatile("s_waitcnt lgkmcnt(0)\n\ts_barrier":::"memory");
  #undef DMA_K
  #undef DMA_V
  #undef CMASK
  #undef START
  #undef RESC
  #undef ROT
}
constexpr int ATTN_LDS_BYTES=LDS_BYTES;
template<int THRL=8> __device__ __forceinline__ void attn_phase(char*lds,const bf16*Q,const bf16*K,const bf16*V,bf16*O12,const float*relb,int vcu,int G){
  for(int U=vcu;U<2048;U+=G){ const int i=U>>8,v=U&255,c6=(v>>3)+32*(i>>2),s=v&7,k=i&3; const int qb=(k==0)?s:(k==1)?15-s:(k==2)?16+s:31-s;
    const int b=c6>>5,comp=(c6>>4)&1,h=(c6>>1)&7,vh=c6&1;
    attn_unit<THRL>(b,comp*8+h,2*h+vh,qb,Q,K,V,O12+(long)comp*BATCH*SEQ*DM,relb,lds); }
}
#undef SBAR
#undef WAIT_BAR
}
#include <hip/hip_bf16.h>
#include <cmath>
#ifndef ATTN_PRIO
#define ATTN_PRIO 1
#endif
#if ATTN_PRIO == 1
#define APRIO(n) __builtin_amdgcn_s_setprio(n)
#else
#define APRIO(n) do{}while(0)
#endif
namespace attn128 {
using bf16=__hip_bfloat16;
using bf16x8=__attribute__((ext_vector_type(8)))short;
using s16x4=__attribute__((ext_vector_type(4)))short;
using f32x16=__attribute__((ext_vector_type(16)))float;
using u32x4=__attribute__((ext_vector_type(4)))unsigned;
constexpr int BATCH=2,NHEAD=16,SEQ=8192,D=64,DM=NHEAD*D;
constexpr int NW=8,QBLK=32,QB=QBLK*NW,KVBLK=64,NQB=SEQ/QB;
constexpr int ATTN_PITCH=DM, ATTN_UNIT_ROWS=QB;
__device__ __forceinline__ int crow(int r,int hi){return (r&3)+8*(r>>2)+4*hi;}
#define SBAR() __builtin_amdgcn_sched_barrier(0)
__device__ __forceinline__ void cmask(f32x16&p0,f32x16&p1,int jb,int qrel,int hi){
  const float NEG=-INFINITY; int kb=64*jb+4*hi;
  #pragma unroll
  for(int r=0;r<16;++r){int kv=kb+(r&3)+8*(r>>2); if(kv>qrel)p0[r]=NEG; if(kv+32>qrel)p1[r]=NEG;}
}

__device__ __forceinline__ void cbm(f32x16&p0,f32x16&p1,int jb,int qrel,int hi,const __attribute__((address_space(3))) float*dt){
  const float NEG=-INFINITY; const int nb=qrel-64*jb-4*hi;
  #pragma unroll
  for(int r=0;r<16;++r){const int n0=nb-((r&3)+8*(r>>2)),n1=n0-32; const float d0=dt[n0<0?0:n0],d1=dt[n1<0?0:n1];
    p0[r]=n0<0?NEG:p0[r]+d0; p1[r]=n1<0?NEG:p1[r]+d1;}
}

constexpr int NSLOT=3, SLOTB=8192, VSLOTB=16384;
constexpr int LDS_K=0, LDS_V=NSLOT*SLOTB, LDS_WS=LDS_V+NSLOT*VSLOTB, LDS_OST=LDS_WS+NW*64*4, LDS_DT=LDS_OST+NW*4096, LDS_BYTES=LDS_DT+512*4;
constexpr float C2=0.125f*1.4426950408889634f;
__device__ __forceinline__ void glds16(const void*gsrc,unsigned lds_dst){unsigned keep;
  asm volatile("s_mov_b32 %0, m0\n\ts_mov_b32 m0, %2\n\ts_nop 0\n\tglobal_load_lds_dwordx4 %1, off\n\ts_mov_b32 m0, %0":"=&s"(keep):"v"(gsrc),"s"(lds_dst):"memory");}
__device__ __forceinline__ float max3f(float a,float b,float c){float r;asm("v_max3_f32 %0, %1, %2, %3":"=v"(r):"v"(a),"v"(b),"v"(c));return r;}
__device__ __forceinline__ float max2f(float a,float b){float r;asm("v_max_f32_e32 %0, %1, %2":"=v"(r):"v"(a),"v"(b));return r;}
__device__ __forceinline__ float fadd_s(float a,float b){float r;asm("v_add_f32_e32 %0, %1, %2":"=v"(r):"v"(a),"v"(b));return r;}
__device__ __forceinline__ float fsub_s(float a,float b){float r;asm("v_sub_f32_e32 %0, %1, %2":"=v"(r):"v"(a),"v"(b));return r;}
typedef float f32x2_t __attribute__((ext_vector_type(2))); typedef float f32x4_t __attribute__((ext_vector_type(4))); typedef __bf16 bf16x2_t __attribute__((ext_vector_type(2)));
__device__ __forceinline__ unsigned cvtpk_s(float lo,float hi){f32x2_t v={lo,hi};bf16x2_t b=__builtin_convertvector(v,bf16x2_t);return __builtin_bit_cast(unsigned,b);}
#define WAIT_BAR(N) asm volatile("s_waitcnt vmcnt(" #N ") lgkmcnt(0)\n\ts_barrier":::"memory")

__device__ __forceinline__ void qkt(f32x16&p0,f32x16&p1,const char*Kslot,const bf16x8*qr,const f32x16&negm,int r32,int hi){
  const char*kb=Kslot+hi*1024+r32*16;
  #pragma unroll
  for(int d0=0;d0<4;++d0){
    const bf16x8 b0=*reinterpret_cast<const bf16x8*>(kb+d0*2048);
    const bf16x8 b1=*reinterpret_cast<const bf16x8*>(kb+d0*2048+512);
    if(d0==0){p0=__builtin_amdgcn_mfma_f32_32x32x16_bf16(b0,qr[0],negm,0,0,0);p1=__builtin_amdgcn_mfma_f32_32x32x16_bf16(b1,qr[0],negm,0,0,0);}
    else{p0=__builtin_amdgcn_mfma_f32_32x32x16_bf16(b0,qr[d0],p0,0,0,0);p1=__builtin_amdgcn_mfma_f32_32x32x16_bf16(b1,qr[d0],p1,0,0,0);}}
}
typedef __attribute__((address_space(3))) const char* lds_cptr;
typedef short v4i16_t __attribute__((ext_vector_type(4)));
__device__ __forceinline__ void kload8(bf16x8*kf,lds_cptr kp){
  kf[0]=*(const __attribute__((address_space(3))) bf16x8*)(kp);      kf[1]=*(const __attribute__((address_space(3))) bf16x8*)(kp+512);
  kf[2]=*(const __attribute__((address_space(3))) bf16x8*)(kp+2048); kf[3]=*(const __attribute__((address_space(3))) bf16x8*)(kp+2560);
  kf[4]=*(const __attribute__((address_space(3))) bf16x8*)(kp+4096); kf[5]=*(const __attribute__((address_space(3))) bf16x8*)(kp+4608);
  kf[6]=*(const __attribute__((address_space(3))) bf16x8*)(kp+6144); kf[7]=*(const __attribute__((address_space(3))) bf16x8*)(kp+6656);
}
__device__ __forceinline__ void kload2(bf16x8*kf,lds_cptr kp,int j){ kf[2*j]=*(const __attribute__((address_space(3))) bf16x8*)(kp+j*2048); kf[2*j+1]=*(const __attribute__((address_space(3))) bf16x8*)(kp+j*2048+512); }
__device__ __forceinline__ s16x4 vtr(lds_cptr p){ return __builtin_bit_cast(s16x4,__builtin_amdgcn_ds_read_tr16_b64_v4i16((__attribute__((address_space(3))) v4i16_t*)p)); }
__device__ __forceinline__ float rowmax(const f32x16&p0,const f32x16&p1){
  float a=max3f(p0[0],p0[1],p1[0]),b=max3f(p0[2],p0[3],p1[1]);a=max3f(a,p1[2],p1[3]);
  #pragma unroll
  for(int r=4;r<16;r+=4){a=max3f(a,p0[r],p0[r+1]);b=max3f(b,p0[r+2],p0[r+3]);a=max3f(a,p1[r],p1[r+1]);b=max3f(b,p1[r+2],p1[r+3]);}
  const float m=max2f(a,b);
  auto rr=__builtin_amdgcn_permlane32_swap(__float_as_uint(m),__float_as_uint(m),false,false);
  return max2f(__uint_as_float(rr[0]),__uint_as_float(rr[1]));
}
__device__ __forceinline__ void pv(f32x16*o,int vb,bf16x8 pa0,bf16x8 pa1,bf16x8 pa2,bf16x8 pa3){
  #pragma unroll
  for(int d0=0;d0<4;++d0){s16x4 lo[4],hi[4];
    #pragma unroll
    for(int ks=0;ks<4;++ks){
      asm volatile("ds_read_b64_tr_b16 %0,%1 offset:%c2":"=&v"(lo[ks]):"v"(vb),"i"(d0*4096+ks*1024):"memory");
      asm volatile("ds_read_b64_tr_b16 %0,%1 offset:%c2":"=&v"(hi[ks]):"v"(vb),"i"(d0*4096+ks*1024+512):"memory");}
    asm volatile("s_waitcnt lgkmcnt(0)":::"memory");SBAR();
    #define PK(k) (bf16x8){lo[k][0],lo[k][1],lo[k][2],lo[k][3],hi[k][0],hi[k][1],hi[k][2],hi[k][3]}
    o[d0]=__builtin_amdgcn_mfma_f32_32x32x16_bf16(pa0,PK(0),o[d0],0,0,0);
    o[d0]=__builtin_amdgcn_mfma_f32_32x32x16_bf16(pa1,PK(1),o[d0],0,0,0);
    o[d0]=__builtin_amdgcn_mfma_f32_32x32x16_bf16(pa2,PK(2),o[d0],0,0,0);
    o[d0]=__builtin_amdgcn_mfma_f32_32x32x16_bf16(pa3,PK(3),o[d0],0,0,0);
    #undef PK
  }
}

#ifndef ATTN_STORE16
#define ATTN_STORE16(p,v) pg8::st16((void*)(p),(v))
#endif
template<int THRL,int MODE> __device__ __forceinline__ void attn_unit(int b,int hq,int vcol,int qb,const bf16*Q,const bf16*__restrict__ K,const bf16*__restrict__ V,bf16*O,bf16*Uo,const float*__restrict__ sg,float lam,float oscale,const float*__restrict__ relb,char*shm){
  int tid_=threadIdx.x; asm volatile("":"+v"(tid_));
  const int tid=tid_,lane=tid&63,r32=lane&31,hi=lane>>5; const int wid=__builtin_amdgcn_readfirstlane(tid>>6);
  const long rowbase=(long)b*SEQ; const int q0=qb*QB;
  const bf16*Qw=Q+(rowbase+q0+wid*QBLK)*DM+hq*D;
  const bf16*Kh=K+rowbase*DM+hq*D,*Vh=V+rowbase*DM+vcol;
  const lds_cptr shm3=(lds_cptr)shm;
  const unsigned lds0=(unsigned)(uintptr_t)shm;
  float*wsf=(float*)(shm+LDS_WS)+wid*64;
  const bf16*ksrc=Kh+(long)lane*DM+wid*8;
  const bf16*vsrc=Vh+(long)(16*(wid&3)+(lane>>2))*DM+(wid>>2)*32+(lane&3)*8;
  const unsigned kdst=lds0+LDS_K+wid*1024, vdst=lds0+LDS_V+wid*1024;
  #define DMA_K(t,slot) glds16(ksrc+(long)(t)*KVBLK*DM,(unsigned)__builtin_amdgcn_readfirstlane(kdst+(slot)))
  #define DMA_V(t,slot) do{ glds16(vsrc+(long)(t)*KVBLK*DM,(unsigned)__builtin_amdgcn_readfirstlane(vdst+2*(slot))); glds16(vsrc+(long)(t)*KVBLK*DM+64,(unsigned)__builtin_amdgcn_readfirstlane(vdst+2*(slot)+8192)); }while(0)
  const int vb0=(int)(lds0+LDS_V)+((lane>>4)&1)*32+(lane&3)*8+(4*hi+((lane&15)>>2))*64;
  const char*Kbase=shm+LDS_K; bf16x8 kf[8];
  const lds_cptr kp0=shm3+LDS_K+hi*1024+r32*16; const lds_cptr vp0=shm3+LDS_V+((lane>>4)&1)*32+(lane&3)*8+(4*hi+((lane&15)>>2))*64;
  const int NT=(q0+QB)/KVBLK;
  const __attribute__((address_space(3))) float*dtab=(const __attribute__((address_space(3))) float*)(shm3+LDS_DT);
  { const int h8=hq&7; const float bfar=relb[31*8+h8]; const float dv=(tid<113)?(relb[(int)c_bucket[tid<128?tid:0]*8+h8]-bfar)*1.4426950408889634f:0.f;
    ((__attribute__((address_space(3))) float*)(shm3+LDS_DT))[tid]=dv; }
  if(ATTN_PRIO==2){ if(wid>=4)__builtin_amdgcn_s_setprio(1); }
  DMA_K(0,0);DMA_V(0,0);DMA_K(1,SLOTB);
  bf16x8 qr[4];
  #pragma unroll
  for(int d0=0;d0<4;++d0)qr[d0]=*reinterpret_cast<const bf16x8*>(&Qw[(long)r32*DM+d0*16+hi*8]);
  { __attribute__((address_space(3))) bf16x8*qst=(__attribute__((address_space(3))) bf16x8*)(shm3+LDS_OST+wid*4096)+lane;
    _Pragma("unroll") for(int d0=0;d0<4;++d0)qst[d0*64]=qr[d0]; }
  const __attribute__((address_space(3))) bf16x8*qlp=(const __attribute__((address_space(3))) bf16x8*)(shm3+LDS_OST+wid*4096)+lane;
  #define QLD(d0) (qlp[(d0)*64])
  float mhat=0.f,l_reg=0.f;f32x16 o[4];o[0]=f32x16{};o[1]=f32x16{};o[2]=f32x16{};o[3]=f32x16{};const f32x16 zero16=f32x16{};
  const int qrel=wid*QBLK+r32;
  #define CMASK(P0,P1,t) do{int jb_=(t)-(NT-4); if(jb_>=-2)cbm(P0,P1,jb_,qrel,hi,dtab);}while(0)
  bool resc=false;
  #define START(P0,P1) do{ const float rm=rowmax(P0,P1); resc=false; \
    { const float dl=rm; mhat=fadd_s(mhat,dl); \
      _Pragma("unroll") for(int r=0;r<16;++r){P0[r]=fsub_s(P0[r],dl);P1[r]=fsub_s(P1[r],dl);} \
      } \
    _Pragma("unroll") for(int r=0;r<16;++r)P0[r]=__builtin_amdgcn_exp2f(P0[r]); }while(0)
  #define RESC() do{ if(resc){ asm volatile("s_waitcnt lgkmcnt(0)":::"memory"); \
      _Pragma("unroll") for(int d_=0;d_<4;++d_) _Pragma("unroll") for(int r=0;r<16;++r)o[d_][r]*=wsf[crow(r,hi)]; } }while(0)
  f32x16 pA0,pA1,pB0,pB1;
  int sl_prev=0,sl_cur=0,sl_next=SLOTB;
  #define ROT() do{sl_prev=sl_cur;sl_cur=sl_next;sl_next=(sl_next==(NSLOT-1)*SLOTB)?0:sl_next+SLOTB;}while(0)
  DMA_K(2,2*SLOTB);
  WAIT_BAR(3);
  qkt(pA0,pA1,Kbase,qr,zero16,r32,hi);asm volatile("s_nop 15\n\ts_nop 7":"+v"(pA0),"+v"(pA1));CMASK(pA0,pA1,0);
  START(pA0,pA1);
  _Pragma("unroll") for(int r=0;r<16;++r)pA1[r]=__builtin_amdgcn_exp2f(pA1[r]);
  WAIT_BAR(0);
  DMA_K(3,0);DMA_V(1,SLOTB);
  ROT();
  kload8(kf,kp0+sl_cur);
  WAIT_BAR(3);
  s16x4 vlo[8],vhi[8]; u32x4 pw0,pw1,pw2,pw3;
  #define PKW(P,B) cvtpk_s(P[B],P[B+1])
  #define PAF(k) __builtin_bit_cast(bf16x8,pw##k)
  #define VFR(i) (bf16x8){vlo[i][0],vlo[i][1],vlo[i][2],vlo[i][3],vhi[i][0],vhi[i][1],vhi[i][2],vhi[i][3]}
  #define PIN(x) asm volatile("":"+v"(x))
  #define MX3(a,b,c) __builtin_fmaxf(__builtin_fmaxf((a),(b)),(c))
  #define GAPA(MF,A0,A1,A2,A3,W0,W1,PW) do{ MF; sacc+=A0; sacc+=A1; sacc+=A2; sacc+=A3; PIN(sacc); W0; W1; PIN(PW); SBAR(); }while(0)
  #define EX(v) __builtin_amdgcn_exp2f(v)
  #define GAPM(MF,...) do{ MF; __VA_ARGS__; PIN(mxa); PIN(mxb); SBAR(); }while(0)
  #define EXE(X0,X1,i) do{ if((i)<16) X0[(i)&15]=EX(X0[(i)&15]); else X1[(i)&15]=EX(X1[(i)&15]); }while(0)
  #define GAPX(MFX,OD,X0,X1,i0,i1,i2) do{ OD=MFX; EXE(X0,X1,i0); EXE(X0,X1,i1); if((i2)!=(i1)) EXE(X0,X1,i2); PIN(X0); PIN(X1); SBAR(); }while(0)
  #define VRL(j,i) do{ vlo[j]=vtr(vp_+(((i)>>2)*4096+((i)&3)*1024)); vhi[j]=vtr(vp_+(((i)>>2)*4096+((i)&3)*1024+512)); SBAR(); }while(0)
  #define VRD(i) do{ vlo[i]=vtr(vp_+(((i)>>2)*4096+((i)&3)*1024)); vhi[i]=vtr(vp_+(((i)>>2)*4096+((i)&3)*1024+512)); }while(0)
  #define KRD(G,j) do{ if(G){ kload2(kf,kp0+sl_next,j); SBAR(); } }while(0)
  #define STEP(C0,C1,P0,P1,t,GK,GV,GL) do{ SBAR(); APRIO(1); \
    const lds_cptr vp_=vp0+2*sl_prev; \
    { const float nm_=-mhat; _Pragma("unroll") for(int r=0;r<16;++r){C0[r]=nm_;C1[r]=nm_;} } \
    VRD(0); SBAR(); float sacc=(P0[0]+P0[1]); \
    GAPA(C0=__builtin_amdgcn_mfma_f32_32x32x16_bf16(kf[0],qfa,C0,0,0,0), P0[2],P0[3],P0[4],P0[5],     pw0[0]=PKW(P0,0), pw0[1]=PKW(P0,2), pw0); \
    VRD(4); SBAR(); GAPA(C1=__builtin_amdgcn_mfma_f32_32x32x16_bf16(kf[1],qfa,C1,0,0,0), P0[6],P0[7],P0[8],P0[9],     pw0[2]=PKW(P0,4), pw0[3]=PKW(P0,6), pw0); \
    qfa=QLD(2); VRD(1); SBAR(); GAPA(C0=__builtin_amdgcn_mfma_f32_32x32x16_bf16(kf[2],qfb,C0,0,0,0),   P0[10],P0[11],P0[12],P0[13], pw1[0]=PKW(P0,8), pw1[1]=PKW(P0,10), pw1); \
    VRD(5); SBAR(); GAPA(C1=__builtin_amdgcn_mfma_f32_32x32x16_bf16(kf[3],qfb,C1,0,0,0),   P0[14],P0[15],P1[0],P1[1],   pw1[2]=PKW(P0,12),pw1[3]=PKW(P0,14), pw1); \
    qfb=QLD(3); VRD(2); SBAR(); GAPA(C0=__builtin_amdgcn_mfma_f32_32x32x16_bf16(kf[4],qfa,C0,0,0,0),   P1[2],P1[3],P1[4],P1[5],     pw2[0]=PKW(P1,0), pw2[1]=PKW(P1,2), pw2); \
    VRD(6); SBAR(); GAPA(C1=__builtin_amdgcn_mfma_f32_32x32x16_bf16(kf[5],qfa,C1,0,0,0),   P1[6],P1[7],P1[8],P1[9],     pw2[2]=PKW(P1,4), pw2[3]=PKW(P1,6), pw2); \
    qfa=QLD(0); VRD(3); SBAR(); GAPA(C0=__builtin_amdgcn_mfma_f32_32x32x16_bf16(kf[6],qfb,C0,0,0,0),   P1[10],P1[11],P1[12],P1[13], pw3[0]=PKW(P1,8), pw3[1]=PKW(P1,10), pw3); \
    VRD(7); SBAR(); GAPA(C1=__builtin_amdgcn_mfma_f32_32x32x16_bf16(kf[7],qfb,C1,0,0,0),   P1[14],P1[15],0.f,0.f,       pw3[2]=PKW(P1,12),pw3[3]=PKW(P1,14), pw3); \
    qfb=QLD(1); l_reg+=sacc; \
    if(GK){DMA_K((t)+3,sl_cur);} if(GV){DMA_V((t)+1,sl_next);} \
    CMASK(C0,C1,t); \
    SBAR(); float mxa,mxb; \
    GAPM(o[0]=__builtin_amdgcn_mfma_f32_32x32x16_bf16(PAF(0),VFR(0),o[0],0,0,0), mxa=MX3(C0[0],C0[1],C1[0]); mxb=MX3(C0[2],C0[3],C1[1]); mxa=MX3(mxa,C1[2],C1[3]); mxa=MX3(mxa,C0[4],C0[5]));  VRL(0,8); \
    GAPM(o[1]=__builtin_amdgcn_mfma_f32_32x32x16_bf16(PAF(0),VFR(4),o[1],0,0,0), mxb=MX3(mxb,C0[6],C0[7]); mxa=MX3(mxa,C1[4],C1[5]); mxb=MX3(mxb,C1[6],C1[7]); mxa=MX3(mxa,C0[8],C0[9]));  VRL(4,12); \
    KRD(GL,0); GAPM(o[0]=__builtin_amdgcn_mfma_f32_32x32x16_bf16(PAF(1),VFR(1),o[0],0,0,0), mxb=MX3(mxb,C0[10],C0[11]); mxa=MX3(mxa,C1[8],C1[9]); mxb=MX3(mxb,C1[10],C1[11]); mxa=MX3(mxa,C0[12],C0[13]));  VRL(1,9); \
    KRD(GL,1); GAPM(o[1]=__builtin_amdgcn_mfma_f32_32x32x16_bf16(PAF(1),VFR(5),o[1],0,0,0), mxb=MX3(mxb,C0[14],C0[15]); mxa=MX3(mxa,C1[12],C1[13]); mxb=MX3(mxb,C1[14],C1[15]));  VRL(5,13); \
    { float rm=__builtin_fmaxf(mxa,mxb); { auto rr=__builtin_amdgcn_permlane32_swap(__float_as_uint(rm),__float_as_uint(rm),false,false); rm=__builtin_fmaxf(__uint_as_float(rr[0]),__uint_as_float(rr[1])); } \
      resc=false; \
      if(__builtin_expect(__any(rm>(float)THRL),0)){ const float dl=__builtin_fmaxf(rm,0.f); mhat+=dl; \
        _Pragma("unroll") for(int r=0;r<16;++r){C0[r]-=dl;C1[r]-=dl;} \
        const float f=__builtin_amdgcn_exp2f(-dl); l_reg*=f; if(hi==0)wsf[r32]=f; resc=true; } } \
    SBAR(); \
    KRD(GL,2); GAPX(__builtin_amdgcn_mfma_f32_32x32x16_bf16(PAF(2),VFR(2),o[0],0,0,0),o[0],C0,C1, 0,1,2);     VRL(2,10); \
    KRD(GL,3); GAPX(__builtin_amdgcn_mfma_f32_32x32x16_bf16(PAF(2),VFR(6),o[1],0,0,0),o[1],C0,C1, 3,4,5);     VRL(6,14); \
    GAPX(__builtin_amdgcn_mfma_f32_32x32x16_bf16(PAF(3),VFR(3),o[0],0,0,0),o[0],C0,C1, 6,7,8);     VRL(3,11); \
    GAPX(__builtin_amdgcn_mfma_f32_32x32x16_bf16(PAF(3),VFR(7),o[1],0,0,0),o[1],C0,C1, 9,10,11);   VRL(7,15); \
    GAPX(__builtin_amdgcn_mfma_f32_32x32x16_bf16(PAF(0),VFR(0),o[2],0,0,0),o[2],C0,C1, 12,13,14); \
    GAPX(__builtin_amdgcn_mfma_f32_32x32x16_bf16(PAF(0),VFR(4),o[3],0,0,0),o[3],C0,C1, 15,16,17); \
    GAPX(__builtin_amdgcn_mfma_f32_32x32x16_bf16(PAF(1),VFR(1),o[2],0,0,0),o[2],C0,C1, 18,19,20); \
    GAPX(__builtin_amdgcn_mfma_f32_32x32x16_bf16(PAF(1),VFR(5),o[3],0,0,0),o[3],C0,C1, 21,22,23); \
    GAPX(__builtin_amdgcn_mfma_f32_32x32x16_bf16(PAF(2),VFR(2),o[2],0,0,0),o[2],C0,C1, 24,25,25); \
    GAPX(__builtin_amdgcn_mfma_f32_32x32x16_bf16(PAF(2),VFR(6),o[3],0,0,0),o[3],C0,C1, 26,27,27); \
    GAPX(__builtin_amdgcn_mfma_f32_32x32x16_bf16(PAF(3),VFR(3),o[2],0,0,0),o[2],C0,C1, 28,29,29); \
    GAPX(__builtin_amdgcn_mfma_f32_32x32x16_bf16(PAF(3),VFR(7),o[3],0,0,0),o[3],C0,C1, 30,31,31); APRIO(0); \
    }while(0)
  bf16x8 qfa=QLD(0),qfb=QLD(1);
  int t=1;
  #undef CMASK
  #define CMASK(P0,P1,t) do{}while(0)
  for(;t+7<NT;t+=2){
    STEP(pB0,pB1,pA0,pA1,t,true,true,true);     WAIT_BAR(3); RESC(); ROT();
    STEP(pA0,pA1,pB0,pB1,t+1,true,true,true);   WAIT_BAR(3); RESC(); ROT();
  }
  #undef CMASK
  #define CMASK(P0,P1,t) do{int jb_=(t)-(NT-4); if(jb_>=-2)cbm(P0,P1,jb_,qrel,hi,dtab);}while(0)
  #define ENDW(tt) do{ if((tt)+3<NT){WAIT_BAR(3);} else if((tt)+2<NT){WAIT_BAR(2);} else {WAIT_BAR(0);} }while(0)
  for(;t+1<NT;t+=2){
    STEP(pB0,pB1,pA0,pA1,t,(t+3<NT),(t+1<NT),(t+1<NT));       ENDW(t);   RESC(); ROT();
    STEP(pA0,pA1,pB0,pB1,t+1,(t+4<NT),(t+2<NT),(t+2<NT));     ENDW(t+1); RESC(); ROT();
  }
  STEP(pB0,pB1,pA0,pA1,NT-1,false,false,false); RESC();
  { float sacc=pB0[0]+pB0[1]; _Pragma("unroll") for(int r=2;r<16;++r)sacc+=pB0[r]; _Pragma("unroll") for(int r=0;r<16;++r)sacc+=pB1[r]; l_reg+=sacc;
    pw0=(u32x4){PKW(pB0,0),PKW(pB0,2),PKW(pB0,4),PKW(pB0,6)};pw1=(u32x4){PKW(pB0,8),PKW(pB0,10),PKW(pB0,12),PKW(pB0,14)};pw2=(u32x4){PKW(pB1,0),PKW(pB1,2),PKW(pB1,4),PKW(pB1,6)};pw3=(u32x4){PKW(pB1,8),PKW(pB1,10),PKW(pB1,12),PKW(pB1,14)};
    SBAR(); pv(o,vb0+2*sl_cur,PAF(0),PAF(1),PAF(2),PAF(3)); }
  #undef PKW
  #undef PAF
  #undef VFR
  #undef PIN
  #undef MX3
  #undef GAPA
  #undef GAPM
  #undef GAPX
  #undef EXE
  #undef VRL
  #undef EX
  #undef VRD
  #undef KRD
  #undef STEP
  #undef ENDW
  if(ATTN_PRIO==2)__builtin_amdgcn_s_setprio(0);
  {auto rr=__builtin_amdgcn_permlane32_swap(__float_as_uint(l_reg),__float_as_uint(l_reg),false,false);l_reg=__uint_as_float(rr[0])+__uint_as_float(rr[1]);}
  if(hi==0)wsf[32+r32]=l_reg;asm volatile("s_waitcnt lgkmcnt(0)":::"memory");
  float rli[16];
  #pragma unroll
  for(int r=0;r<16;++r)rli[r]=__builtin_amdgcn_rcpf(wsf[32+crow(r,hi)]);
  bf16*Ow=O+(rowbase+q0+wid*QBLK)*DM+vcol;
  { bf16*stg=(bf16*)(shm+LDS_OST)+wid*2048;
    float dd[2][4][8]; float ss[4]={0.f,0.f,0.f,0.f};
    #pragma unroll
    for(int hf=0;hf<2;++hf){
      #pragma unroll
      for(int r=0;r<16;++r){const int orow=crow(r,hi);
        #pragma unroll
        for(int d0=0;d0<2;++d0)stg[orow*64+d0*32+r32]=__float2bfloat16(o[2*hf+d0][r]*rli[r]);}
      asm volatile("s_waitcnt lgkmcnt(0)":::"memory");
      #pragma unroll
      for(int i=0;i<4;++i){const int row=i*8+(lane>>3),ch=lane&7; const u32x4 v=*(const u32x4*)(stg+row*64+ch*8);
        if constexpr(MODE==0){ ATTN_STORE16(Ow+(long)row*DM+hf*64+ch*8,v); }
        else { const u32x4 v1=*(const u32x4*)(Ow+(long)row*DM+hf*64+ch*8);
          #pragma unroll
          for(int k=0;k<4;++k){ const float a0=__uint_as_float(v1[k]<<16),a1=__uint_as_float(v1[k]&0xffff0000u),b0=__uint_as_float(v[k]<<16),b1=__uint_as_float(v[k]&0xffff0000u);
            const float e0=a0-lam*b0,e1=a1-lam*b1; dd[hf][i][2*k]=e0; dd[hf][i][2*k+1]=e1; ss[i]+=e0*e0+e1*e1; } } }
      asm volatile("s_waitcnt lgkmcnt(0)":::"memory"); }
    if constexpr(MODE==1){
      bf16*Uw=Uo+(rowbase+q0+wid*QBLK)*DM+vcol;
      #pragma unroll
      for(int i=0;i<4;++i){ float t=ss[i]; t+=__shfl_xor(t,1); t+=__shfl_xor(t,2); t+=__shfl_xor(t,4); ss[i]=oscale/sqrtf(t*(1.0f/128.0f)+1e-5f); }
      #pragma unroll
      for(int hf=0;hf<2;++hf){ const int ch=lane&7; const f32x4_t g0=*(const f32x4_t*)(sg+hf*64+ch*8),g1=*(const f32x4_t*)(sg+hf*64+ch*8+4);
        #pragma unroll
        for(int i=0;i<4;++i){ const int row=i*8+(lane>>3); const float rs=ss[i]; u32x4 w;
          w[0]=cvtpk_s(dd[hf][i][0]*rs*g0[0],dd[hf][i][1]*rs*g0[1]); w[1]=cvtpk_s(dd[hf][i][2]*rs*g0[2],dd[hf][i][3]*rs*g0[3]);
          w[2]=cvtpk_s(dd[hf][i][4]*rs*g1[0],dd[hf][i][5]*rs*g1[1]); w[3]=cvtpk_s(dd[hf][i][6]*rs*g1[2],dd[hf][i][7]*rs*g1[3]);
          ATTN_STORE16(Uw+(long)row*DM+hf*64+ch*8,w); } } } }
  asm volatile("s_waitcnt lgkmcnt(0)\n\ts_barrier":::"memory");
  #undef DMA_K
  #undef DMA_V
  #undef CMASK
  #undef START
  #undef RESC
  #undef ROT
  #undef QLD
}
constexpr int ATTN_LDS_BYTES=LDS_BYTES;
template<int THRL=8> __device__ __forceinline__ void attn_phase(char*lds,const bf16*Q,const bf16*K,const bf16*V,bf16*O1buf,bf16*U,const float*sg,float lam,float oscale,const float*relb,int vcu,int G){
  for(int X=vcu;X<512;X+=G){ const int i=X>>8,v=X&255,bh=v>>4,s=v&15; const int qb=(i==0)?s:31-s; const int b=bh>>3,h=bh&7;
    attn_unit<THRL,0>(b,h,h*128,qb,Q,K,V,O1buf,U,sg,lam,oscale,relb,lds);
    attn_unit<THRL,1>(b,8+h,h*128,qb,Q,K,V,O1buf,U,sg,lam,oscale,relb,lds); }
}
#undef SBAR
#undef WAIT_BAR
}
#include <hip/hip_bf16.h>
#include <cmath>
#ifndef ATTN_PRIO
#define ATTN_PRIO 1
#endif
#if ATTN_PRIO == 1
#define APRIO(n) __builtin_amdgcn_s_setprio(n)
#else
#define APRIO(n) do{}while(0)
#endif
namespace attn8 {
using bf16=__hip_bfloat16;
using bf16x8=__attribute__((ext_vector_type(8)))short;
using s16x4=__attribute__((ext_vector_type(4)))short;
using f32x16=__attribute__((ext_vector_type(16)))float;
using u32x4=__attribute__((ext_vector_type(4)))unsigned;
constexpr int BATCH=2,NHEAD=16,SEQ=8192,D=64,DM=NHEAD*D;
constexpr int NW=8,QBLK=32,QB=QBLK*NW,KVBLK=64,NQB=SEQ/QB;
constexpr int ATTN_PITCH=DM, ATTN_UNIT_ROWS=QB;
__device__ __forceinline__ int crow(int r,int hi){return (r&3)+8*(r>>2)+4*hi;}
#define SBAR() __builtin_amdgcn_sched_barrier(0)
__device__ __forceinline__ void cmask(f32x16&p0,f32x16&p1,int jb,int qrel,int hi){
  const float NEG=-INFINITY; int kb=64*jb+4*hi;
  #pragma unroll
  for(int r=0;r<16;++r){int kv=kb+(r&3)+8*(r>>2); if(kv>qrel)p0[r]=NEG; if(kv+32>qrel)p1[r]=NEG;}
}

__device__ __forceinline__ void cbm(f32x16&p0,f32x16&p1,int jb,int qrel,int hi,const __attribute__((address_space(3))) float*dt){
  const float NEG=-INFINITY; const int nb=qrel-64*jb-4*hi;
  #pragma unroll
  for(int r=0;r<16;++r){const int n0=nb-((r&3)+8*(r>>2)),n1=n0-32; const float d0=dt[n0<0?0:n0],d1=dt[n1<0?0:n1];
    p0[r]=n0<0?NEG:p0[r]+d0; p1[r]=n1<0?NEG:p1[r]+d1;}
}

constexpr int NSLOT=3, SLOTB=4096, VSLOTB=8192;
constexpr int LDS_K=0, LDS_V=NSLOT*SLOTB, LDS_WS=LDS_V+NSLOT*VSLOTB, LDS_OST=LDS_WS+NW*64*4, LDS_DT=LDS_OST+NW*4096, LDS_BYTES=LDS_DT+512*4;
constexpr float C2=0.125f*1.4426950408889634f;
__device__ __forceinline__ void glds16(const void*gsrc,unsigned lds_dst){unsigned keep;
  asm volatile("s_mov_b32 %0, m0\n\ts_mov_b32 m0, %2\n\ts_nop 0\n\tglobal_load_lds_dwordx4 %1, off\n\ts_mov_b32 m0, %0":"=&s"(keep):"v"(gsrc),"s"(lds_dst):"memory");}
__device__ __forceinline__ float max3f(float a,float b,float c){float r;asm("v_max3_f32 %0, %1, %2, %3":"=v"(r):"v"(a),"v"(b),"v"(c));return r;}
__device__ __forceinline__ float max2f(float a,float b){float r;asm("v_max_f32_e32 %0, %1, %2":"=v"(r):"v"(a),"v"(b));return r;}
__device__ __forceinline__ float fadd_s(float a,float b){float r;asm("v_add_f32_e32 %0, %1, %2":"=v"(r):"v"(a),"v"(b));return r;}
__device__ __forceinline__ float fsub_s(float a,float b){float r;asm("v_sub_f32_e32 %0, %1, %2":"=v"(r):"v"(a),"v"(b));return r;}
typedef float f32x2_t __attribute__((ext_vector_type(2))); typedef float f32x4_t __attribute__((ext_vector_type(4))); typedef __bf16 bf16x2_t __attribute__((ext_vector_type(2)));
__device__ __forceinline__ unsigned cvtpk_s(float lo,float hi){f32x2_t v={lo,hi};bf16x2_t b=__builtin_convertvector(v,bf16x2_t);return __builtin_bit_cast(unsigned,b);}
#define WAIT_BAR(N) asm volatile("s_waitcnt vmcnt(" #N ") lgkmcnt(0)\n\ts_barrier":::"memory")

typedef int v8i32 __attribute__((ext_vector_type(8))); typedef int v4i32 __attribute__((ext_vector_type(4)));
typedef __attribute__((address_space(3))) const char* lds_cptr;
#ifndef ATTN8_PRIO
#define ATTN8_PRIO 1
#endif
#if ATTN8_PRIO
#define A8PRIO(n) __builtin_amdgcn_s_setprio(n)
#else
#define A8PRIO(n) do{}while(0)
#endif
#define SC1 0
#define SC8 0
__device__ __forceinline__ v8i32 ld32(lds_cptr p,int step){ const v4i32 a=*(const __attribute__((address_space(3))) v4i32*)p, b=*(const __attribute__((address_space(3))) v4i32*)(p+step); return (v8i32){a[0],a[1],a[2],a[3],b[0],b[1],b[2],b[3]}; }
__device__ __forceinline__ void cbm4(f32x16&p0,f32x16&p1,int jb,int qrel,int hi,const __attribute__((address_space(3))) float*dt){
  const float NEG=-INFINITY; const int nb=qrel-64*jb-4*hi;
  #pragma unroll
  for(int g=0;g<4;++g){
    #pragma unroll
    for(int r=4*g;r<4*g+4;++r){const int n0=nb-((r&3)+8*(r>>2)),n1=n0-32; const float d0=dt[n0<0?0:n0],d1=dt[n1<0?0:n1];
      p0[r]=n0<0?NEG:p0[r]+d0; p1[r]=n1<0?NEG:p1[r]+d1;}
    asm volatile("":::"memory"); }
}
__device__ __forceinline__ unsigned pk8(float a,float b,float c,float d){ unsigned w=__builtin_amdgcn_cvt_pk_fp8_f32(a,b,0,false); return __builtin_amdgcn_cvt_pk_fp8_f32(c,d,w,true); }
__device__ __forceinline__ int pk8o(int old,float a,float b,float c,float d){ int w=__builtin_amdgcn_cvt_pk_fp8_f32(a,b,old,false); return __builtin_amdgcn_cvt_pk_fp8_f32(c,d,w,true); }
typedef float f32x2v __attribute__((ext_vector_type(2)));
#define PAIR2(X,i) ((f32x2v){X[2*(i)],X[2*(i)+1]})
__device__ __forceinline__ float rowmax(const f32x16&p0,const f32x16&p1){
  float a=max3f(p0[0],p0[1],p1[0]),b=max3f(p0[2],p0[3],p1[1]);a=max3f(a,p1[2],p1[3]);
  #pragma unroll
  for(int r=4;r<16;r+=4){a=max3f(a,p0[r],p0[r+1]);b=max3f(b,p0[r+2],p0[r+3]);a=max3f(a,p1[r],p1[r+1]);b=max3f(b,p1[r+2],p1[r+3]);}
  const float m=max2f(a,b);
  auto rr=__builtin_amdgcn_permlane32_swap(__float_as_uint(m),__float_as_uint(m),false,false);
  return max2f(__uint_as_float(rr[0]),__uint_as_float(rr[1]));
}
#ifndef ATTN_STORE16
#define ATTN_STORE16(p,v) pg8::st16((void*)(p),(v))
#endif
template<int THRL,int MODE> __device__ __forceinline__ void attn_unit(int b,int hq,int vcol,int qb,const unsigned char*Q8,const unsigned char*__restrict__ K8,const unsigned char*__restrict__ VT8,bf16*O,bf16*Uo,const float*__restrict__ sg,float lam,float oscale,const float*__restrict__ relb,char*shm){
  int tid_=threadIdx.x; asm volatile("":"+v"(tid_));
  const int tid=tid_,lane=tid&63,r32=lane&31,hi=lane>>5; const int wid=__builtin_amdgcn_readfirstlane(tid>>6);
  const long rowbase=(long)b*SEQ; const int q0=qb*QB;
  const lds_cptr shm3=(lds_cptr)shm;
  const unsigned lds0=(unsigned)(uintptr_t)shm;
  float*wsf=(float*)(shm+LDS_WS)+wid*64;
  const unsigned char*ksrc=K8+(rowbase+lane)*(long)DM+hq*64+(wid&3)*16;
  const unsigned char*vsrc=VT8+(long)(vcol+64*(wid&1)+lane)*(BATCH*SEQ)+rowbase+(wid>>1)*16;
  const unsigned kdst=lds0+LDS_K+(wid&3)*1024, vdst=lds0+LDS_V+wid*1024;
  #define DMA_K(t,slot) glds16(ksrc+(long)(t)*KVBLK*DM,(unsigned)__builtin_amdgcn_readfirstlane(kdst+(slot)))
  #define DMA_V(t,slot) glds16(vsrc+(long)(t)*KVBLK,(unsigned)__builtin_amdgcn_readfirstlane(vdst+2*(slot)))
  #define WAIT_KV(NK,NV) WAIT_BAR(NK)
  const lds_cptr kp0=shm3+LDS_K+(2*hi)*1024+r32*16;
  const lds_cptr vp0=shm3+LDS_V+(2*hi)*2048+r32*16;
  const int NT=(q0+QB)/KVBLK;
  const __attribute__((address_space(3))) float*dtab=(const __attribute__((address_space(3))) float*)(shm3+LDS_DT);
  { const int h8=hq&7; const float bfar=relb[31*8+h8]; const float dv=(tid<113)?(relb[(int)c_bucket[tid<128?tid:0]*8+h8]-bfar)*1.4426950408889634f:0.f;
    ((__attribute__((address_space(3))) float*)(shm3+LDS_DT))[tid]=dv; }
  DMA_K(0,0);DMA_V(0,0);DMA_K(1,SLOTB);
  v8i32 qf; { const unsigned char*qp=Q8+(rowbase+q0+wid*QBLK+r32)*(long)DM+hq*64+32*hi; const v4i32 a=*(const v4i32*)qp,bq=*(const v4i32*)(qp+16); qf=(v8i32){a[0],a[1],a[2],a[3],bq[0],bq[1],bq[2],bq[3]}; }
  float mhat=0.f;f32x16 o[4];
  f32x16 o4;
  int c1_=0x38383838; asm volatile("":"+v"(c1_));
  #define ones ((v8i32){c1_,c1_,c1_,c1_,c1_,c1_,c1_,c1_})
  const int qrel=wid*QBLK+r32;
  #define CMASK(P0,P1,t) do{int jb_=(t)-(NT-4); if(jb_>=-2)cbm4(P0,P1,jb_,qrel,hi,dtab);}while(0)
  bool resc=false;
  #define RESC() do{ if(resc){ asm volatile("s_waitcnt lgkmcnt(0)":::"memory"); \
      _Pragma("unroll") for(int r=0;r<16;++r){ const float f_=wsf[crow(r,hi)]; o[0][r]*=f_;o[1][r]*=f_;o[2][r]*=f_;o[3][r]*=f_;o4[r]*=f_; } } }while(0)
  f32x16 pA0,pA1;
  v8i32 vf[4]; v8i32 pw={0,0,0,0,0,0,0,0};
  int sl_prev=0,sl_cur=0,sl_next=SLOTB;
  #define ROT() do{sl_prev=sl_cur;sl_cur=sl_next;sl_next=(sl_next==(NSLOT-1)*SLOTB)?0:sl_next+SLOTB;}while(0)
  DMA_K(2,2*SLOTB);
  WAIT_BAR(0);
  v8i32 kf[2];
  kf[0]=ld32(kp0,1024); kf[1]=ld32(kp0+512,1024);
  pA0=__builtin_amdgcn_mfma_scale_f32_32x32x64_f8f6f4(kf[0],qf,f32x16{},0,0,0,SC1,0,SC8); pA1=__builtin_amdgcn_mfma_scale_f32_32x32x64_f8f6f4(kf[1],qf,f32x16{},0,0,0,SC1,0,SC8);
  asm volatile("s_nop 15\n\ts_nop 15":"+v"(pA0),"+v"(pA1));
  #define PACKP(X0,X1) do{ pw[0]=pk8o(pw[0],X0[0],X0[1],X0[2],X0[3]); pw[1]=pk8o(pw[1],X0[4],X0[5],X0[6],X0[7]); pw[2]=pk8o(pw[2],X0[8],X0[9],X0[10],X0[11]); pw[3]=pk8o(pw[3],X0[12],X0[13],X0[14],X0[15]); \
      pw[4]=pk8o(pw[4],X1[0],X1[1],X1[2],X1[3]); pw[5]=pk8o(pw[5],X1[4],X1[5],X1[6],X1[7]); pw[6]=pk8o(pw[6],X1[8],X1[9],X1[10],X1[11]); pw[7]=pk8o(pw[7],X1[12],X1[13],X1[14],X1[15]); }while(0)
  CMASK(pA0,pA1,0);
  { const float rm=rowmax(pA0,pA1); mhat=rm;
    _Pragma("unroll") for(int r=0;r<16;++r){pA0[r]=__builtin_amdgcn_exp2f(pA0[r]-rm);pA1[r]=__builtin_amdgcn_exp2f(pA1[r]-rm);} }
  PACKP(pA0,pA1);
  WAIT_BAR(0);
  DMA_K(3,0);DMA_V(1,SLOTB);
  ROT();
  kf[0]=ld32(kp0+sl_cur,1024); kf[1]=ld32(kp0+sl_cur+512,1024);
  WAIT_KV(2,1);
  #define PIN(x) asm volatile("":"+v"(x))
  #define MX3(a,b,c) __builtin_fmaxf(__builtin_fmaxf((a),(b)),(c))
  #define EX(v) __builtin_amdgcn_exp2f(v)
  #define EXE(X0,X1,i) do{ if((i)<16) X0[(i)&15]=EX(X0[(i)&15]); else X1[(i)&15]=EX(X1[(i)&15]); }while(0)
  #define STEP(t,GK,GV,GL,BAND) do{ SBAR(); A8PRIO(1);     \
    const lds_cptr vp_=vp0+2*sl_prev; \
    vf[0]=ld32(vp_,2048); vf[1]=ld32(vp_+512,2048); vf[2]=ld32(vp_+1024,2048); vf[3]=ld32(vp_+1536,2048); \
    { const float nm_=-mhat; _Pragma("unroll") for(int r=0;r<16;++r){pA0[r]=nm_;pA1[r]=nm_;} } \
    pA0=__builtin_amdgcn_mfma_scale_f32_32x32x64_f8f6f4(kf[0],qf,pA0,0,0,0,SC1,0,SC8); \
    pA1=__builtin_amdgcn_mfma_scale_f32_32x32x64_f8f6f4(kf[1],qf,pA1,0,0,0,SC1,0,SC8); \
    if(GK){DMA_K((t)+3,sl_cur);} if(GV){DMA_V((t)+1,sl_next);} \
    o[0]=__builtin_amdgcn_mfma_scale_f32_32x32x64_f8f6f4(pw,vf[0],o[0],0,0,0,SC1,0,SC8); \
    o[1]=__builtin_amdgcn_mfma_scale_f32_32x32x64_f8f6f4(pw,vf[1],o[1],0,0,0,SC1,0,SC8); PIN(o[0]); PIN(o[1]);     \
    if(BAND){ o[2]=__builtin_amdgcn_mfma_scale_f32_32x32x64_f8f6f4(pw,vf[2],o[2],0,0,0,SC1,0,SC8); o[3]=__builtin_amdgcn_mfma_scale_f32_32x32x64_f8f6f4(pw,vf[3],o[3],0,0,0,SC1,0,SC8); o4=__builtin_amdgcn_mfma_scale_f32_32x32x64_f8f6f4(pw,ones,o4,0,0,0,SC1,0,SC8); PIN(o[0]);PIN(o[1]);PIN(o[2]);PIN(o[3]);PIN(o4); } \
    SBAR(); \
    CMASK(pA0,pA1,t); \
    float mxa,mxb; \
    mxa=MX3(pA0[0],pA0[1],pA1[0]); mxb=MX3(pA0[2],pA0[3],pA1[1]); mxa=MX3(mxa,pA1[2],pA1[3]); \
    _Pragma("unroll") for(int r=4;r<16;r+=4){mxa=MX3(mxa,pA0[r],pA0[r+1]);mxb=MX3(mxb,pA0[r+2],pA0[r+3]);mxa=MX3(mxa,pA1[r],pA1[r+1]);mxb=MX3(mxb,pA1[r+2],pA1[r+3]);} \
    { float rm=__builtin_fmaxf(mxa,mxb); { auto rr=__builtin_amdgcn_permlane32_swap(__float_as_uint(rm),__float_as_uint(rm),false,false); rm=__builtin_fmaxf(__uint_as_float(rr[0]),__uint_as_float(rr[1])); } \
      resc=false; \
      if(__builtin_expect(__any(rm>(float)THRL),0)){ const float dl=__builtin_fmaxf(rm,0.f); mhat+=dl; \
        _Pragma("unroll") for(int r=0;r<16;++r){pA0[r]-=dl;pA1[r]-=dl;} \
        const float f=__builtin_amdgcn_exp2f(-dl); if(hi==0)wsf[r32]=f; resc=true; } } \
    SBAR(); \
    if(!BAND){ o[2]=__builtin_amdgcn_mfma_scale_f32_32x32x64_f8f6f4(pw,vf[2],o[2],0,0,0,SC1,0,SC8); } \
    if(GL){ kf[0]=ld32(kp0+sl_next,1024); } \
    EXE(pA0,pA1,0);EXE(pA0,pA1,1);EXE(pA0,pA1,2);EXE(pA0,pA1,3);EXE(pA0,pA1,4);EXE(pA0,pA1,5);EXE(pA0,pA1,6);EXE(pA0,pA1,7);EXE(pA0,pA1,8);EXE(pA0,pA1,9);EXE(pA0,pA1,10); PIN(pA0); SBAR(); \
    if(!BAND){ o[3]=__builtin_amdgcn_mfma_scale_f32_32x32x64_f8f6f4(pw,vf[3],o[3],0,0,0,SC1,0,SC8); } \
    if(GL){ kf[1]=ld32(kp0+sl_next+512,1024); } \
    EXE(pA0,pA1,11);EXE(pA0,pA1,12);EXE(pA0,pA1,13);EXE(pA0,pA1,14);EXE(pA0,pA1,15);EXE(pA0,pA1,16);EXE(pA0,pA1,17);EXE(pA0,pA1,18);EXE(pA0,pA1,19);EXE(pA0,pA1,20);EXE(pA0,pA1,21); PIN(pA0); PIN(pA1); SBAR(); \
    if(!BAND){ o4=__builtin_amdgcn_mfma_scale_f32_32x32x64_f8f6f4(pw,ones,o4,0,0,0,SC1,0,SC8); } \
    EXE(pA0,pA1,22);EXE(pA0,pA1,23);EXE(pA0,pA1,24);EXE(pA0,pA1,25);EXE(pA0,pA1,26);EXE(pA0,pA1,27);EXE(pA0,pA1,28);EXE(pA0,pA1,29);EXE(pA0,pA1,30);EXE(pA0,pA1,31); PIN(pA1); SBAR(); \
    PACKP(pA0,pA1); SBAR(); A8PRIO(0); \
    }while(0)
  o[0]=f32x16{};o[1]=f32x16{};o[2]=f32x16{};o[3]=f32x16{};o4=f32x16{};
  int t=1;
  #undef CMASK
  #define CMASK(P0,P1,t) do{}while(0)
  for(;t+7<NT;t+=2){
    STEP(t,true,true,true,false);     WAIT_KV(2,1); RESC(); ROT();
    STEP(t+1,true,true,true,false);   WAIT_KV(2,1); RESC(); ROT();
  }
  #undef CMASK
  #define CMASK(P0,P1,t) do{int jb_=(t)-(NT-4); if(jb_>=-2)cbm4(P0,P1,jb_,qrel,hi,dtab);}while(0)
  #define ENDW(tt) do{ if((tt)+3<NT){WAIT_KV(2,1);} else if((tt)+2<NT){WAIT_BAR(1);} else {WAIT_BAR(0);} }while(0)
  for(;t+1<NT;t+=2){
    STEP(t,(t+3<NT),(t+1<NT),(t+1<NT),true);       ENDW(t);   RESC(); ROT();
    STEP(t+1,(t+4<NT),(t+2<NT),(t+2<NT),true);     ENDW(t+1); RESC(); ROT();
  }
  STEP(NT-1,false,false,false,true); RESC();
  { const lds_cptr vq=vp0+2*sl_cur;
    #pragma unroll
    for(int db=0;db<4;++db){ vf[db]=ld32(vq+db*512,2048); }
    #pragma unroll
    for(int db=0;db<4;++db) o[db]=__builtin_amdgcn_mfma_scale_f32_32x32x64_f8f6f4(pw,vf[db],o[db],0,0,0,SC1,0,SC8);
    o4=__builtin_amdgcn_mfma_scale_f32_32x32x64_f8f6f4(pw,ones,o4,0,0,0,SC1,0,SC8); }
  #undef PACKP
  #undef PIN
  #undef MX3
  #undef EX
  #undef EXE
  #undef STEP
  #undef ENDW
  const bf16* Qdummy=nullptr; (void)Qdummy;
  float rli[16];
  #pragma unroll
  for(int r=0;r<16;++r)rli[r]=__builtin_amdgcn_rcpf(o4[r]);
  bf16*Ow=O+(rowbase+q0+wid*QBLK)*DM+vcol;
  { bf16*stg=(bf16*)(shm+LDS_OST)+wid*2048;
    float dd[2][4][8]; float ss[4]={0.f,0.f,0.f,0.f};
    #pragma unroll
    for(int hf=0;hf<2;++hf){
      #pragma unroll
      for(int r=0;r<16;++r){const int orow=crow(r,hi);
        #pragma unroll
        for(int d0=0;d0<2;++d0)stg[orow*64+d0*32+r32]=__float2bfloat16(o[2*hf+d0][r]*rli[r]);}
      asm volatile("s_waitcnt lgkmcnt(0)":::"memory");
      #pragma unroll
      for(int i=0;i<4;++i){const int row=i*8+(lane>>3),ch=lane&7; const u32x4 v=*(const u32x4*)(stg+row*64+ch*8);
        if constexpr(MODE==0){ ATTN_STORE16(Ow+(long)row*DM+hf*64+ch*8,v); }
        else { const u32x4 v1=*(const u32x4*)(Ow+(long)row*DM+hf*64+ch*8);
          #pragma unroll
          for(int k=0;k<4;++k){ const float a0=__uint_as_float(v1[k]<<16),a1=__uint_as_float(v1[k]&0xffff0000u),b0=__uint_as_float(v[k]<<16),b1=__uint_as_float(v[k]&0xffff0000u);
            const float e0=a0-lam*b0,e1=a1-lam*b1; dd[hf][i][2*k]=e0; dd[hf][i][2*k+1]=e1; ss[i]+=e0*e0+e1*e1; } } }
      asm volatile("s_waitcnt lgkmcnt(0)":::"memory"); }
    if constexpr(MODE==1){
      bf16*Uw=Uo+(rowbase+q0+wid*QBLK)*DM+vcol;
      #pragma unroll
      for(int i=0;i<4;++i){ float t=ss[i]; t+=__shfl_xor(t,1); t+=__shfl_xor(t,2); t+=__shfl_xor(t,4); ss[i]=oscale/sqrtf(t*(1.0f/128.0f)+1e-5f); }
      #pragma unroll
      for(int hf=0;hf<2;++hf){ const int ch=lane&7; const f32x4_t g0=*(const f32x4_t*)(sg+hf*64+ch*8),g1=*(const f32x4_t*)(sg+hf*64+ch*8+4);
        #pragma unroll
        for(int i=0;i<4;++i){ const int row=i*8+(lane>>3); const float rs=ss[i]; u32x4 w;
          if(DENSE_FP8_C4){ const float r8=rs*U_SCALE; pg8::u32x2w w8;
            w8.x=pk8(dd[hf][i][0]*r8*g0[0],dd[hf][i][1]*r8*g0[1],dd[hf][i][2]*r8*g0[2],dd[hf][i][3]*r8*g0[3]); w8.y=pk8(dd[hf][i][4]*r8*g1[0],dd[hf][i][5]*r8*g1[1],dd[hf][i][6]*r8*g1[2],dd[hf][i][7]*r8*g1[3]);
            pg8::st8((unsigned char*)Uo+((rowbase+q0+wid*QBLK+row)*DM+vcol+hf*64+ch*8),w8); }
          else {
          w[0]=cvtpk_s(dd[hf][i][0]*rs*g0[0],dd[hf][i][1]*rs*g0[1]); w[1]=cvtpk_s(dd[hf][i][2]*rs*g0[2],dd[hf][i][3]*rs*g0[3]);
          w[2]=cvtpk_s(dd[hf][i][4]*rs*g1[0],dd[hf][i][5]*rs*g1[1]); w[3]=cvtpk_s(dd[hf][i][6]*rs*g1[2],dd[hf][i][7]*rs*g1[3]);
          ATTN_STORE16(Uw+(long)row*DM+hf*64+ch*8,w); } } } } }
  asm volatile("s_waitcnt lgkmcnt(0)\n\ts_barrier":::"memory");
  #undef DMA_K
  #undef DMA_V
  #undef CMASK
  #undef START
  #undef RESC
  #undef ROT
  #undef WAIT_KV
}
constexpr int ATTN_LDS_BYTES=LDS_BYTES;
template<int THRL=8> __device__ __forceinline__ void attn_phase(char*lds,const unsigned char*Q8,const unsigned char*K8,const unsigned char*VT8,bf16*O1buf,bf16*U,const float*sg,float lam,float oscale,const float*relb,int vcu,int G){
  for(int X=vcu;X<512;X+=G){ const int i=X>>8,v=X&255,bh=v>>4,s=v&15; const int qb=(i==0)?s:31-s; const int b=bh>>3,h=bh&7;
    attn_unit<THRL,0>(b,h,h*128,qb,Q8,K8,VT8,O1buf,U,sg,lam,oscale,relb,lds);
    attn_unit<THRL,1>(b,8+h,h*128,qb,Q8,K8,VT8,O1buf,U,sg,lam,oscale,relb,lds); }
}
#undef SBAR
#undef WAIT_BAR
#undef SC1
#undef SC8
}
struct Frame {
    LAS unsigned char* lds;
    volatile LAS unsigned* MISC;
    gu32* ctl;
    int tid, lane, wave;
    int vcu, G, bid;
};

struct Args { const float* in[24]; float* out; unsigned char* ws; int ph_lo, ph_hi; };
typedef const __attribute__((address_space(4))) Args* KArgs;
__device__ __forceinline__ KArgs kargs() { KArgs p = (KArgs)__builtin_amdgcn_kernarg_segment_ptr(); asm volatile("" : "+s"(p)); return p; }
#define INP(k) ((const float*)kargs()->in[k])

__device__ __forceinline__ float wave_sum(float v) {
#pragma unroll
    for (int o = 1; o < 64; o <<= 1) v += __shfl_xor(v, o);
    return v;
}
__device__ __forceinline__ float bf2f(unsigned short b) { return __builtin_bit_cast(float, (unsigned)b << 16); }
__device__ __forceinline__ float bflo(unsigned w) { return __builtin_bit_cast(float, w << 16); }
__device__ __forceinline__ float bfhi(unsigned w) { return __builtin_bit_cast(float, w & 0xffff0000u); }
__device__ __forceinline__ f32x4 fp8x4_to_f32(unsigned w) {
    const float k = __builtin_bit_cast(float, 0x7b800000u);
    f32x4 r;
    r.x = __builtin_bit_cast(float, ((w << 20) & 0x07f00000u) | ((w << 24) & 0x80000000u)) * k;
    r.y = __builtin_bit_cast(float, ((w << 12) & 0x07f00000u) | ((w << 16) & 0x80000000u)) * k;
    r.z = __builtin_bit_cast(float, ((w << 4) & 0x07f00000u) | ((w << 8) & 0x80000000u)) * k;
    r.w = __builtin_bit_cast(float, ((w >> 4) & 0x07f00000u) | (w & 0x80000000u)) * k;
    return r;
}
__device__ __forceinline__ float sigmoidf_(float x) { return __builtin_amdgcn_rcpf(1.0f + __expf(-x)); }

__device__ __forceinline__ void cvt_tile64(const float* W, int N, bf16* WT, int K, int drow, int k0, int n0, LAS unsigned* scr, int lane) {
    const int a = lane & 15, q = lane >> 4;
    f32x4 lo[8], hi[8];
#pragma unroll
    for (int p = 0; p < 8; ++p) { const float* src = W + (size_t)(k0 + 8 * p + 2 * q) * N + n0 + 4 * a; lo[p] = *(const f32x4*)src; hi[p] = *(const f32x4*)(src + N); }
#pragma unroll
    for (int p = 0; p < 8; ++p)
#pragma unroll
        for (int i = 0; i < 4; ++i) scr[32 * (4 * a + i) + 4 * (p ^ (a & 7)) + q] = pg8::cvt_pk_bf16(lo[p][i], hi[p][i]);
    LDS_WAIT(); asm volatile("" ::: "memory");
#pragma unroll
    for (int j = 0; j < 8; ++j) { const int n = 8 * j + (lane >> 3), c = lane & 7;
        const v4u v = *(const LAS v4u*)(scr + 32 * n + 4 * (c ^ ((n >> 2) & 7)));
        pg8::st16(WT + (size_t)(drow + n) * K + k0 + 8 * c, v); }
    LDS_WAIT(); asm volatile("" ::: "memory");
}
__device__ __forceinline__ void cvt_tile64_f8(const float* W, int N, unsigned char* WT, int Kb, int drow, int k0, int n0, float scale, LAS unsigned* scr, int lane) {
    const int a = lane & 15, q = lane >> 4;
    f32x4 r[4][4];
#pragma unroll
    for (int pp = 0; pp < 4; ++pp)
#pragma unroll
        for (int rr = 0; rr < 4; ++rr) r[pp][rr] = *(const f32x4*)(W + (size_t)(k0 + 16 * pp + 4 * q + rr) * N + n0 + 4 * a);
#pragma unroll
    for (int pp = 0; pp < 4; ++pp)
#pragma unroll
        for (int i = 0; i < 4; ++i) { unsigned w = __builtin_amdgcn_cvt_pk_fp8_f32(r[pp][0][i] * scale, r[pp][1][i] * scale, 0, false); w = __builtin_amdgcn_cvt_pk_fp8_f32(r[pp][2][i] * scale, r[pp][3][i] * scale, w, true);
            scr[17 * (4 * a + i) + 4 * pp + q] = w; }
    LDS_WAIT(); asm volatile("" ::: "memory");
#pragma unroll
    for (int j = 0; j < 4; ++j) { const int n = 16 * j + (lane >> 2), c = lane & 3; const LAS unsigned* sp = scr + 17 * n + 4 * c;
        const v4u v = (v4u){sp[0], sp[1], sp[2], sp[3]};
        pg8::st16(WT + (size_t)(drow + n) * Kb + k0 + 16 * c, v); }
    LDS_WAIT(); asm volatile("" ::: "memory");
}
__device__ __forceinline__ int il_row(int n, int second) { return 256 * (n >> 7) + 128 * second + (n & 127); }

__device__ __forceinline__ void ph_prologue(Frame& F, unsigned char* ws) {
    LAS unsigned* scr = (LAS unsigned*)(F.lds + RING_OFF + F.wave * 8192);
    const int gw = F.vcu * NWAVES + F.wave, NGW = F.G * NWAVES;
    constexpr int I_SQ = (D / 64) * (D / 64);
    constexpr int I_W2 = (D / 64) * (2 * D / 64);
    constexpr int NITEMS = 2 * I_W2 + 2 * I_SQ + I_W2 + 2 * I_SQ + 2 * I_SQ;
    for (int it = gw; it < NITEMS; it += NGW) {
        int r = it;
        if (r < 2 * I_W2) { const int l = r / I_W2, t = r % I_W2, k0 = (t >> 5) * 64, n0 = (t & 31) * 64;
            if (DENSE_FP8_S1) cvt_tile64_f8(INP(1) + (size_t)l * D * 2 * D, 2 * D, (unsigned char*)(ws + WS_PW1T) + (size_t)l * 2 * D * D, D, il_row(n0 & 1023, n0 >> 10), k0, n0, WX_SCALE, scr, F.lane);
            else cvt_tile64(INP(1) + (size_t)l * D * 2 * D, 2 * D, (bf16*)(ws + WS_PW1T) + (size_t)l * 2 * D * D, D, il_row(n0 & 1023, n0 >> 10), k0, n0, scr, F.lane); continue; } r -= 2 * I_W2;
        if (r < 2 * I_SQ) { const int l = r / I_SQ, t = r % I_SQ, k0 = (t >> 4) * 64, n0 = (t & 15) * 64;
            if (DENSE_FP8_S3) cvt_tile64_f8(INP(7) + (size_t)l * D * D, D, (unsigned char*)(ws + WS_PW2T) + (size_t)l * D * D, D, n0, k0, n0, WX_SCALE, scr, F.lane);
            else cvt_tile64(INP(7) + (size_t)l * D * D, D, (bf16*)(ws + WS_PW2T) + (size_t)l * D * D, D, n0, k0, n0, scr, F.lane); continue; } r -= 2 * I_SQ;
        if (r < I_W2) { const int t = r, k0 = (t >> 5) * 64, n0 = (t & 31) * 64;
            if (DENSE_FP8_C1) cvt_tile64_f8(INP(9), 2 * D, (unsigned char*)(ws + WS_WQ0T) + (size_t)D * D, D, n0, k0, n0, WX_SCALE, scr, F.lane);
            else cvt_tile64(INP(9), 2 * D, (bf16*)(ws + WS_WKVT), D, n0, k0, n0, scr, F.lane); continue; } r -= I_W2;
        if (r < 2 * I_SQ) { const int l = r / I_SQ, t = r % I_SQ, k0 = (t >> 4) * 64, n0 = (t & 15) * 64;
            if (DENSE_FP8_C1) cvt_tile64_f8(INP(10) + (size_t)l * D * D, D, (unsigned char*)(ws + (l == 0 ? WS_WQ0T : WS_WQ1T)), D, n0, k0, n0, WX_SCALE, scr, F.lane);
            else cvt_tile64(INP(10) + (size_t)l * D * D, D, (bf16*)(ws + (l == 0 ? WS_WQ0T : WS_WQ1T)), D, n0, k0, n0, scr, F.lane); continue; } r -= 2 * I_SQ;
        { const int l = r / I_SQ, t = r % I_SQ, k0 = (t >> 4) * 64, n0 = (t & 15) * 64;
            if (DENSE_FP8_C4) cvt_tile64_f8(INP(13) + (size_t)l * D * D, D, (unsigned char*)(ws + WS_WOT) + (size_t)l * D * D, D, n0, k0, n0, WX_SCALE, scr, F.lane);
            else cvt_tile64(INP(13) + (size_t)l * D * D, D, (bf16*)(ws + WS_WOT) + (size_t)l * D * D, D, n0, k0, n0, scr, F.lane); }
    }
    const float* x = INP(0); bf16* xb = (bf16*)(ws + WS_XBF);
    for (int m = gw; m < T; m += NGW) {
        const f32x4* xr = (const f32x4*)(x + (size_t)m * D) + F.lane; unsigned long long* o8 = (unsigned long long*)(xb + (size_t)m * D) + F.lane;
#pragma unroll
        for (int j = 0; j < 4; ++j) { const f32x4 v = xr[64 * j]; pg8::st8(o8 + 64 * j, (pg8::u32x2w){pk2(v.x, v.y), pk2(v.z, v.w)});
            if (DENSE_FP8_S1) { unsigned w = __builtin_amdgcn_cvt_pk_fp8_f32(v.x, v.y, 0, false); w = __builtin_amdgcn_cvt_pk_fp8_f32(v.z, v.w, w, true); *((unsigned*)(ws + WS_XS8 + (size_t)m * D) + F.lane + 64 * j) = w; } }
    }
}
constexpr int MOE_CVT_ITEMS = NE * 384, MOE_CVT_SPLIT = 4096;
__device__ __forceinline__ void moe_cvt_item(unsigned char* ws, int l, int it, LAS unsigned* scr, int lane) {
    constexpr int I_G = (D / 64) * (DE / 64);
    constexpr int PER_E = 3 * I_G;
    const int e = it / PER_E; int r = it % PER_E;
    bf16* gut = (bf16*)(ws + ws_wgut(l)); bf16* dt = (bf16*)(ws + ws_wdt(l));
#if MOE_FP8
    if (r < 2 * I_G) { const int up = r >= I_G, t = r - up * I_G, k0 = (t >> 3) * 64, n0 = (t & 7) * 64;
        cvt_tile64_f8(INP(up ? 22 : 21) + ((size_t)l * NE + e) * D * DE, DE, (unsigned char*)gut + (size_t)e * 2 * DE * D, D, il_row(n0, up), k0, n0, WG_SCALE, scr, lane); }
    else { r -= 2 * I_G; const int k0 = (r >> 4) * 64, n0 = (r & 15) * 64; cvt_tile64_f8(INP(23) + ((size_t)l * NE + e) * DE * D, D, (unsigned char*)dt + (size_t)e * D * DE, DE, n0, k0, n0, WD_SCALE, scr, lane); }
#else
    if (r < 2 * I_G) { const int up = r >= I_G, t = r - up * I_G, k0 = (t >> 3) * 64, n0 = (t & 7) * 64;
        cvt_tile64(INP(up ? 22 : 21) + ((size_t)l * NE + e) * D * DE, DE, gut + (size_t)e * 2 * DE * D, D, il_row(n0, up), k0, n0, scr, lane); }
    else { r -= 2 * I_G; const int k0 = (r >> 4) * 64, n0 = (r & 15) * 64; cvt_tile64(INP(23) + ((size_t)l * NE + e) * DE * D, D, dt + (size_t)e * D * DE, DE, n0, k0, n0, scr, lane); }
#endif
}
constexpr int MOE_CVT_SIDEN = 1792;
constexpr int MOE_CVT_SIDE0 = 5376;
__device__ __forceinline__ void ph_moe_cvt(Frame& F, unsigned char* ws, int l, int lo) {
    LAS unsigned* scr = (LAS unsigned*)(F.lds + RING_OFF + F.wave * 8192);
    const int gw = F.vcu * NWAVES + F.wave, NGW = F.G * NWAVES;
    for (int it = lo + gw; it < MOE_CVT_ITEMS; it += NGW) moe_cvt_item(ws, l, it, scr, F.lane);
}
__device__ __forceinline__ void moe_cvt_tail(Frame& F, unsigned char* ws, int l, int units, int lo, int hi) {
    LAS unsigned* scr = (LAS unsigned*)(F.lds + RING_OFF + F.wave * 8192);
    const int r = units % F.G; int n_early = F.G - r, rank = F.vcu - r;
    if (r == 0 || 2 * n_early < F.G) { n_early = F.G; rank = F.vcu; }
    if (rank < 0) return;
    for (int it = lo + rank * NWAVES + F.wave; it < hi; it += n_early * NWAVES) moe_cvt_item(ws, l, it, scr, F.lane);
}

typedef float f32x2_ __attribute__((ext_vector_type(2)));
typedef _Float16 f16x2_ __attribute__((ext_vector_type(2)));
template <int I, int J> struct ConvStep { static __device__ __forceinline__ void run(f16x2_ (&acc)[32], const f16x2_ (&w)[CONVW], const f16x2_ x) {
    if constexpr (I - J >= 0 && I - J < 32) acc[I - J] += w[J] * x;
    if constexpr (J + 1 < CONVW) ConvStep<I, J + 1>::run(acc, w, x); } };
template <int I> struct ConvRow { static __device__ __forceinline__ void run(f16x2_ (&acc)[32], const f16x2_ (&w)[CONVW], const unsigned (&xv)[32 + CONVW - 1]) {
    const f16x2_ x = __builtin_bit_cast(f16x2_, __builtin_amdgcn_cvt_pkrtz(bflo(xv[I]), bfhi(xv[I])));
    ConvStep<I, 0>::run(acc, w, x);
    if constexpr (I + 1 < 32 + CONVW - 1) ConvRow<I + 1>::run(acc, w, xv); } };
__device__ __forceinline__ void ph_conv(Frame& F, const bf16* G, const float* wdw  , const float* bdw, const float* lng, const float* lnb, bf16* U) {
    constexpr int R = 32, NIN = R + CONVW - 1;
    const int c0 = 2 * F.tid;
    f16x2_ w[CONVW];
#pragma unroll
    for (int j = 0; j < CONVW; ++j) w[j] = __builtin_convertvector(*(const f32x2_*)(wdw + j * D + c0), f16x2_);
    const f32x2_ bd = *(const f32x2_*)(bdw + c0), g2 = *(const f32x2_*)(lng + c0), b2 = *(const f32x2_*)(lnb + c0);
    LAS float* red = (LAS float*)(F.lds + RING_OFF);
    LAS float* tot = red + 512;
    for (int tile = F.vcu; tile < T / R; tile += F.G) {
        const int t0 = tile * R, bstart = t0 & ~(SEQ - 1);
        unsigned xv[NIN];
#pragma unroll
        for (int i = 0; i < NIN; ++i) { const int r = t0 - (CONVW - 1) + i; xv[i] = 0u; if (r >= bstart) xv[i] = *(const unsigned*)(G + (size_t)r * D + c0); }
        f16x2_ acc16[R]; const f16x2_ bd16 = __builtin_convertvector(bd, f16x2_);
#pragma unroll
        for (int o = 0; o < R; ++o) acc16[o] = bd16;
        ConvRow<0>::run(acc16, w, xv);
        f32x2_ acc[R];
#pragma unroll
        for (int o = 0; o < R; ++o) acc[o] = __builtin_convertvector(acc16[o], f32x2_);
        float v[64];
#pragma unroll
        for (int o = 0; o < R; ++o) { v[2 * o] = acc[o].x + acc[o].y; v[2 * o + 1] = acc[o].x * acc[o].x + acc[o].y * acc[o].y; }
#define RS_STEP(MSK, N) { const bool up = (F.lane & (MSK)) != 0; _Pragma("unroll") for (int q = 0; q < (N); ++q) { const float a = up ? v[q + (N)] : v[q], b = up ? v[q] : v[q + (N)]; v[q] = a + __shfl_xor(b, (MSK)); } }
        RS_STEP(32, 32) RS_STEP(16, 16) RS_STEP(8, 8) RS_STEP(4, 4) RS_STEP(2, 2) RS_STEP(1, 1)
#undef RS_STEP
        __syncthreads();
        red[F.wave * 64 + F.lane] = v[0];
        __syncthreads();
        if (F.tid < 64) { float s = 0.f;
#pragma unroll
            for (int wv = 0; wv < 8; ++wv) s += red[wv * 64 + F.tid];
            tot[F.tid] = s; }
        __syncthreads();
#pragma unroll
        for (int o = 0; o < R; ++o) { const float mean = tot[2 * o] * (1.f / D), var = fmaxf(tot[2 * o + 1] * (1.f / D) - mean * mean, 0.f), rstd = __builtin_amdgcn_rsqf(var + LN_EPS);
            const f32x2_ y = (acc[o] - mean) * rstd * g2 + b2;
            const float y0 = y.x * sigmoidf_(y.x), y1 = y.y * sigmoidf_(y.y);
            if (DENSE_FP8_S3) *(unsigned short*)((unsigned char*)U + (size_t)(t0 + o) * D + c0) = (unsigned short)__builtin_amdgcn_cvt_pk_fp8_f32(y0 * U_SCALE, y1 * U_SCALE, 0, false);
            else pg8::st4(U + (size_t)(t0 + o) * D + c0, pk2(y0, y1)); }
    }
    __syncthreads();
}

#ifndef ROUTER_MFMA
#define ROUTER_MFMA 1
#endif
__device__ __forceinline__ void ph_router(Frame& F, bf16* XS, bf16* XSO  , unsigned char* XS8, const bf16* MIXB, const float* lng, const float* lnb, const float* rw  , const float* rb, const bf16* RWB  ,
                                          int2* tok_e, int2* tok_pos, float2* tok_w, int* elist  , unsigned* cnt  ,
                                          unsigned char* side_ws = nullptr, int side_l = 0, int side_lo = 0, int side_hi = 0  ) {
    constexpr int RWS = 1028;
    LAS float* rwT = (LAS float*)(F.lds + RING_OFF);
#if ROUTER_MFMA
    LAS unsigned char* x1l = F.lds + RING_OFF;
    LAS int* lcount = (LAS int*)(F.lds + LDSCTL_OFF + 4096);
#else
    LAS int* lcount = (LAS int*)(F.lds + RING_OFF + 16 * RWS * 4);
#endif
    LAS int* lbase = lcount + 16;
    LAS int* st_e = lcount + 32;
    LAS int* st_p = st_e + 128;
    LAS float* st_w = (LAS float*)(st_p + 128);
    LAS float* lg = st_w + 128;
    if (!ROUTER_MFMA) for (int i4 = F.tid; i4 < 4 * 1024; i4 += NTHR) { const int c = i4 >> 2, k = i4 & 3; const f32x4 wv = *((const f32x4*)rw + i4); rwT[(4 * k + 0) * RWS + c] = wv.x; rwT[(4 * k + 1) * RWS + c] = wv.y; rwT[(4 * k + 2) * RWS + c] = wv.z; rwT[(4 * k + 3) * RWS + c] = wv.w; }
    f32x4 gg[4], bb[4];
#pragma unroll
    for (int j = 0; j < 4; ++j) { gg[j] = *((const f32x4*)lng + F.lane + 64 * j); bb[j] = *((const f32x4*)lnb + F.lane + 64 * j); }
    __syncthreads();
    for (int chunk = F.bid; chunk < T / 64; chunk += F.G) {
        if (F.tid < 16) lcount[F.tid] = 0;
        for (int kb = 0; kb < 8; kb += 2) {
        unsigned long long xa[2][4], ma[2][4];
#pragma unroll
        for (int k = 0; k < 2; ++k) { const int t = chunk * 64 + F.wave * 8 + kb + k;
#pragma unroll
            for (int j = 0; j < 4; ++j) { xa[k][j] = *((const unsigned long long*)(XS + (size_t)t * D) + F.lane + 64 * j); ma[k][j] = LN_FUSED ? 0ull : (OUT_FP8_MIX ? (unsigned long long)*((const unsigned*)((const unsigned char*)MIXB + (size_t)t * D) + F.lane + 64 * j) : *((const unsigned long long*)(MIXB + (size_t)t * D) + F.lane + 64 * j)); } }
        f32x4 vv[2][4];
#pragma unroll
        for (int k = 0; k < 2; ++k) {
            const int t = chunk * 64 + F.wave * 8 + kb + k;
#if LN_FUSED
#pragma unroll
            for (int j = 0; j < 4; ++j) { const unsigned xl = (unsigned)xa[k][j], xh = (unsigned)(xa[k][j] >> 32); vv[k][j] = (f32x4){bflo(xl), bfhi(xl), bflo(xh), bfhi(xh)}; }
            (void)t; (void)ma;
#else
            float s = 0.f;
#pragma unroll
            for (int j = 0; j < 4; ++j) { const unsigned xl = (unsigned)xa[k][j], xh = (unsigned)(xa[k][j] >> 32), ml = (unsigned)ma[k][j], mh = (unsigned)(ma[k][j] >> 32);
                f32x4 mv; if (OUT_FP8_MIX) { mv = fp8x4_to_f32(ml) * (1.0f / OUT_SCALE); (void)mh; } else mv = (f32x4){bflo(ml), bfhi(ml), bflo(mh), bfhi(mh)};
                vv[k][j] = (f32x4){bflo(xl), bfhi(xl), bflo(xh), bfhi(xh)} * ALPHA + mv; s += (vv[k][j].x + vv[k][j].y) + (vv[k][j].z + vv[k][j].w); }
            float s2 = 0.f;
#pragma unroll
            for (int j = 0; j < 4; ++j) s2 += (vv[k][j].x * vv[k][j].x + vv[k][j].y * vv[k][j].y) + (vv[k][j].z * vv[k][j].z + vv[k][j].w * vv[k][j].w);
            const float mean = wave_sum(s) * (1.f / D);
            const float rstd = __builtin_amdgcn_rsqf(fmaxf(wave_sum(s2) * (1.f / D) - mean * mean, 0.f) + LN_EPS);
            unsigned long long* o8 = (unsigned long long*)(XSO + (size_t)t * D) + F.lane;
#pragma unroll
            for (int j = 0; j < 4; ++j) { vv[k][j] = (vv[k][j] - mean) * rstd * gg[j] + bb[j]; const pg8::u32x2w xw_ = (pg8::u32x2w){pk2(vv[k][j].x, vv[k][j].y), pk2(vv[k][j].z, vv[k][j].w)}; pg8::st8(o8 + 64 * j, xw_);
#if ROUTER_MFMA
                { const int tl_ = F.wave * 8 + kb + k, q_ = (F.lane >> 1) + 32 * j; *(LAS pg8::u32x2w*)(x1l + tl_ * 2048 + ((q_ ^ (tl_ & 15)) << 4) + (F.lane & 1) * 8) = xw_; }
#endif
            }
#endif
        }
#if MOE_FP8
#pragma unroll
        for (int k = 0; k < 2; ++k) { const int t = chunk * 64 + F.wave * 8 + kb + k; unsigned* o4 = (unsigned*)(XS8 + (size_t)t * D) + F.lane;
#pragma unroll
            for (int j = 0; j < 4; ++j) { unsigned w = __builtin_amdgcn_cvt_pk_fp8_f32(vv[k][j].x, vv[k][j].y, 0, false); w = __builtin_amdgcn_cvt_pk_fp8_f32(vv[k][j].z, vv[k][j].w, w, true); pg8::st4(o4 + 64 * j, w); } }
#endif
#if !ROUTER_MFMA
        float p0[16], p1[16];
#pragma unroll
        for (int e = 0; e < 16; ++e) { float a0 = 0.f, a1 = 0.f;
#pragma unroll
            for (int j = 0; j < 4; ++j) { const f32x4 wv = *((const LAS f32x4*)(rwT + e * RWS) + F.lane + 64 * j);
                a0 += (vv[0][j].x * wv.x + vv[0][j].y * wv.y) + (vv[0][j].z * wv.z + vv[0][j].w * wv.w); a1 += (vv[1][j].x * wv.x + vv[1][j].y * wv.y) + (vv[1][j].z * wv.z + vv[1][j].w * wv.w); }
            p0[e] = a0; p1[e] = a1; if ((e & 3) == 3) asm volatile("" ::: "memory"); }
#define RS_STEP(P, MSK, N) { const bool up = (F.lane & (MSK)) != 0; _Pragma("unroll") for (int q = 0; q < (N); ++q) { const float a = up ? P[q + (N)] : P[q], b = up ? P[q] : P[q + (N)]; P[q] = a + __shfl_xor(b, (MSK)); } }
        RS_STEP(p0, 32, 8) RS_STEP(p0, 16, 4) RS_STEP(p0, 8, 2) RS_STEP(p0, 4, 1)
        RS_STEP(p1, 32, 8) RS_STEP(p1, 16, 4) RS_STEP(p1, 8, 2) RS_STEP(p1, 4, 1)
#undef RS_STEP
        float l0 = p0[0], l1 = p1[0]; l0 += __shfl_xor(l0, 1); l1 += __shfl_xor(l1, 1); l0 += __shfl_xor(l0, 2); l1 += __shfl_xor(l1, 2);
        if ((F.lane & 3) == 0) { const int e = ((F.lane >> 5) & 1) * 8 + ((F.lane >> 4) & 1) * 4 + ((F.lane >> 3) & 1) * 2 + ((F.lane >> 2) & 1); const int tl = F.wave * 8 + kb; lg[tl * 16 + e] = l0; lg[(tl + 1) * 16 + e] = l1; }
#endif
        }
#if ROUTER_MFMA
        bf16x8 aw_[16];
        { const bf16* wrow0_ = RWB + (F.lane & 15) * 1024 + (F.wave >> 2) * 512 + (F.lane >> 4) * 8;
#pragma unroll
          for (int s_ = 0; s_ < 16; ++s_) aw_[s_] = *(const bf16x8*)(wrow0_ + s_ * 32); }
#endif
        __syncthreads();
#if ROUTER_MFMA
        {
            const int tb_ = F.wave & 3, kh_ = F.wave >> 2, i_ = F.lane & 15, g_ = F.lane >> 4, row_ = tb_ * 16 + i_;
            const bf16* wrow_ = RWB + i_ * 1024 + kh_ * 512 + g_ * 8;
            f32x4 acc_ = (f32x4){0.f, 0.f, 0.f, 0.f};
#pragma unroll
            for (int s_ = 0; s_ < 16; ++s_) { const bf16x8 a_ = aw_[s_]; (void)wrow_; const int q_ = kh_ * 64 + s_ * 4 + g_;
                const bf16x8 b_ = *(const LAS bf16x8*)(x1l + row_ * 2048 + ((q_ ^ (row_ & 15)) << 4));
                acc_ = __builtin_amdgcn_mfma_f32_16x16x32_bf16(a_, b_, acc_, 0, 0, 0); }
            *(LAS f32x4*)(lg + (kh_ * 64 + row_) * 16 + 4 * g_) = acc_;
        }
        __syncthreads();
#endif
        if (F.wave == 0) {
        {
            const int tl = F.lane; float aff[16], sel[16];
#pragma unroll
            for (int e = 0; e < 16; ++e) { const float lgv = ROUTER_MFMA ? lg[tl * 16 + e] + lg[(64 + tl) * 16 + e] : lg[tl * 16 + e]; aff[e] = ROUTER_MFMA ? __builtin_amdgcn_rcpf(1.0f + __builtin_amdgcn_exp2f(lgv * -1.4426950408889634f)) : 1.0f / (1.0f + expf(-lgv)); sel[e] = aff[e] + rb[e]; }
            int gbest = 0; float gscore = -INFINITY;
#pragma unroll
            for (int g = 0; g < 4; ++g) { float m1 = -INFINITY, m2 = -INFINITY;
#pragma unroll
                for (int j = 0; j < 4; ++j) { const float sv = sel[4 * g + j]; if (sv > m1) { m2 = m1; m1 = sv; } else if (sv > m2) m2 = sv; }
                const float sc = m1 + m2; if (sc > gscore) { gscore = sc; gbest = g; } }
            float sg[4], ag[4];
#pragma unroll
            for (int j = 0; j < 4; ++j) { sg[j] = gbest == 0 ? sel[j] : gbest == 1 ? sel[4 + j] : gbest == 2 ? sel[8 + j] : sel[12 + j]; ag[j] = gbest == 0 ? aff[j] : gbest == 1 ? aff[4 + j] : gbest == 2 ? aff[8 + j] : aff[12 + j]; }
            int i0 = 0; float best = sg[0];
#pragma unroll
            for (int j = 1; j < 4; ++j) if (sg[j] > best) { best = sg[j]; i0 = j; }
            int i1 = -1; float best2 = -INFINITY;
#pragma unroll
            for (int j = 0; j < 4; ++j) if (j != i0 && sg[j] > best2) { best2 = sg[j]; i1 = j; }
            if (i1 < 0) i1 = (i0 == 0) ? 1 : 0;
            float w0 = i0 == 0 ? ag[0] : i0 == 1 ? ag[1] : i0 == 2 ? ag[2] : ag[3], w1 = i1 == 0 ? ag[0] : i1 == 1 ? ag[1] : i1 == 2 ? ag[2] : ag[3];
            const float ws_ = w0 + w1; w0 /= ws_; w1 /= ws_;
            const int e0 = 4 * gbest + i0, e1 = 4 * gbest + i1; const int p0 = atomicAdd((int*)&lcount[e0], 1), p1 = atomicAdd((int*)&lcount[e1], 1);
            st_e[2 * tl] = e0; st_e[2 * tl + 1] = e1; st_p[2 * tl] = p0; st_p[2 * tl + 1] = p1; st_w[2 * tl] = w0; st_w[2 * tl + 1] = w1;
        }
        asm volatile("s_waitcnt lgkmcnt(0)" ::: "memory");
        if (F.lane < 16) lbase[F.lane] = (int)__hip_atomic_fetch_add(cnt + 64 * F.lane, (unsigned)lcount[F.lane], __ATOMIC_RELAXED, __HIP_MEMORY_SCOPE_AGENT);
        asm volatile("s_waitcnt lgkmcnt(0)" ::: "memory");
        { const int t = chunk * 64 + F.lane; const int e0 = st_e[2 * F.lane], e1 = st_e[2 * F.lane + 1];
            const int q0 = lbase[e0] + st_p[2 * F.lane], q1 = lbase[e1] + st_p[2 * F.lane + 1];
            tok_e[t] = make_int2(e0, e1); tok_pos[t] = make_int2(q0, q1); tok_w[t] = make_float2(st_w[2 * F.lane], st_w[2 * F.lane + 1]); elist[e0 * T + q0] = t; elist[e1 * T + q1] = t; }
        } else if (side_hi > side_lo && chunk == F.bid) {
            LAS unsigned* scr = (LAS unsigned*)(F.lds + RING_OFF + 73728 + (F.wave - 1) * 4608);
            for (int it = side_lo + F.vcu * 7 + (F.wave - 1); it < side_hi; it += F.G * 7) moe_cvt_item(side_ws, side_l, it, scr, F.lane);
        }
        __syncthreads();
    }
}

__device__ __forceinline__ void moe_offsets(Frame& F, const unsigned* cnt) {
    LAS int* li = (LAS int*)(F.lds + LDSCTL_OFF);
    __syncthreads();
    if (F.tid < NE) li[LI_CNT + F.tid] = (int)__hip_atomic_load(cnt + 64 * F.tid, __ATOMIC_RELAXED, __HIP_MEMORY_SCOPE_AGENT);
    __syncthreads();
    if (F.tid == 0) {
        int off = 0, nt = 0;
        for (int e = 0; e < NE; ++e) { const int c = li[LI_CNT + e]; li[LI_OFF + e] = off; const int tiles = (c + 255) >> 8;
            for (int k = 0; k < tiles && nt < MAXTILES; ++k) li[LI_TEXP + nt++] = e; off += tiles * 256; }
        li[LI_OFF + NE] = off; li[LI_NT] = nt;
    }
    __syncthreads();
}

__device__ __forceinline__ void ph_gather(Frame& F, const bf16* XBF, const int2* tok_e, const int2* tok_pos, bf16* XG) {
    const LAS int* li = (const LAS int*)(F.lds + LDSCTL_OFF);
    const int gw = F.vcu * NWAVES + F.wave, NGW = F.G * NWAVES;
    for (int t = gw; t < T; t += NGW) {
        const int2 e = tok_e[t], p = tok_pos[t]; const int r0 = li[LI_OFF + e.x] + p.x, r1 = li[LI_OFF + e.y] + p.y;
        const v4u* src = (const v4u*)(XBF + (size_t)t * D) + F.lane; const v4u a = src[0], b = src[64];
        v4u* d0 = (v4u*)(XG + (size_t)r0 * D) + F.lane; v4u* d1 = (v4u*)(XG + (size_t)r1 * D) + F.lane;
        d0[0] = a; d0[64] = b; d1[0] = a; d1[64] = b;
    }
}

struct GroupedOrder {
    const LAS int* texp; int ntiles, nN, G, c; size_t bstride; const LAS unsigned* rowsrc;
    __device__ __forceinline__ bool next(int i, pg8::Unit& u) const {
        const long L = (long)i * G + c; if (L >= (long)ntiles * nN) return false;
        const int ti = (int)(L / nN); u.pm = ti; u.pn = (int)(L % nN); u.boff = (size_t)texp[ti] * bstride; u.slot = i; return true;
    }
    __device__ __forceinline__ unsigned rowoff(const pg8::Unit& u, int r) const { return rowsrc[u.slot * 256 + r]; }
    __device__ __forceinline__ void a_ready(const pg8::Unit&) const {}
    __device__ __forceinline__ void done(const pg8::Unit&) const {}
};
__device__ __forceinline__ void moe_rowsrc(Frame& F, const unsigned* cnt, const int* elist, int c) {
    LAS int* li = (LAS int*)(F.lds + LDSCTL_OFF); LAS unsigned* rs = (LAS unsigned*)(li + LI_ROWS);
    const int nt = li[LI_NT];
    for (int idx = F.tid; idx < 3 * 256; idx += NTHR) { const int slot = idx >> 8, r = idx & 255; const long L = (long)slot * F.G + c; unsigned off = 0u;
        if (L < (long)nt * 4) { const int ti = (int)(L >> 2), e = li[LI_TEXP + ti], pos = ti * 256 + r - li[LI_OFF + e]; if (pos < li[LI_CNT + e]) off = (unsigned)elist[e * T + pos] * (unsigned)(MOE_FP8 ? D : D * 2); }
        rs[idx] = off; }
    __syncthreads();
}

__device__ __forceinline__ void ph_silumul(Frame& F, const bf16* HU, bf16* HH) {
    const LAS int* li = (const LAS int*)(F.lds + LDSCTL_OFF);
    const int rows = li[LI_OFF + NE];
    const long n8 = (long)rows * (DE / 8);
    for (long i = (long)F.bid * NTHR + F.tid; i < n8; i += (long)F.G * NTHR) {
        const long r = i / (DE / 8); const int j8 = (int)(i % (DE / 8)) * 8;
        const v4u g = *(const v4u*)(HU + r * 1024 + j8), u = *(const v4u*)(HU + r * 1024 + 512 + j8);
        v4u o;
#define SM1(gw_, uw_) ({ float a = bflo(gw_), b = bfhi(gw_); a = a * sigmoidf_(a) * bflo(uw_); b = b * sigmoidf_(b) * bfhi(uw_); pk2(a, b); })
        o.x = SM1(g.x, u.x); o.y = SM1(g.y, u.y); o.z = SM1(g.z, u.z); o.w = SM1(g.w, u.w);
#undef SM1
        *(v4u*)(HH + r * 512 + j8) = o;
    }
}

__device__ __forceinline__ void ph_combine(Frame& F, bf16* XS, bf16* XSO  , const bf16* Y, const int2* tok_e, const int2* tok_pos, const float2* tok_w, const float* lng, const float* lnb, float* out, unsigned char* XS8) {
    const LAS int* li = (const LAS int*)(F.lds + LDSCTL_OFF);
    const int gw = F.vcu * NWAVES + F.wave, NGW = F.G * NWAVES;
    f32x4 gg[4], bb[4];
#pragma unroll
    for (int j = 0; j < 4; ++j) { gg[j] = *((const f32x4*)lng + F.lane + 64 * j); bb[j] = *((const f32x4*)lnb + F.lane + 64 * j); }
    for (int tb = gw; tb < T; tb += 4 * NGW) {
        int2 e[4], p[4]; float2 w[4];
#pragma unroll
        for (int k = 0; k < 4; ++k) { const int t = tb + k * NGW < T ? tb + k * NGW : tb; e[k] = tok_e[t]; p[k] = tok_pos[t]; w[k] = tok_w[t]; }
        unsigned long long xa[4][4], ya[4][4], yb[4][4];
#pragma unroll
        for (int k = 0; k < 4; ++k) { const int t = tb + k * NGW < T ? tb + k * NGW : tb; const int r0 = li[LI_OFF + e[k].x] + p[k].x, r1 = li[LI_OFF + e[k].y] + p[k].y;
            const unsigned long long* xs = (const unsigned long long*)(XS + (size_t)t * D) + F.lane;
#if OUT_FP8_Y
            const unsigned* y0 = (const unsigned*)((const unsigned char*)Y + (size_t)r0 * D) + F.lane; const unsigned* y1 = (const unsigned*)((const unsigned char*)Y + (size_t)r1 * D) + F.lane;
#else
            const unsigned long long* y0 = (const unsigned long long*)(Y + (size_t)r0 * D) + F.lane; const unsigned long long* y1 = (const unsigned long long*)(Y + (size_t)r1 * D) + F.lane;
#endif
#pragma unroll
            for (int j = 0; j < 4; ++j) { xa[k][j] = xs[64 * j]; ya[k][j] = y0[64 * j]; yb[k][j] = y1[64 * j]; } }
#pragma unroll
        for (int k = 0; k < 4; ++k) {
            const int t = tb + k * NGW; if (t >= T) break;
            f32x4 v[4]; float s = 0.f;
#pragma unroll
            for (int j = 0; j < 4; ++j) { const unsigned long long a = ya[k][j], b = yb[k][j], x = xa[k][j]; const unsigned al = (unsigned)a, ah = (unsigned)(a >> 32), bl = (unsigned)b, bh = (unsigned)(b >> 32), xl = (unsigned)x, xh = (unsigned)(x >> 32);
                f32x4 va, vb;
                if (OUT_FP8_Y) { va = fp8x4_to_f32(al) * (1.0f / OUT_SCALE); vb = fp8x4_to_f32(bl) * (1.0f / OUT_SCALE); (void)ah; (void)bh; }
                else { va = (f32x4){bflo(al), bfhi(al), bflo(ah), bfhi(ah)}; vb = (f32x4){bflo(bl), bfhi(bl), bflo(bh), bfhi(bh)}; }
                const f32x4 xv = (f32x4){bflo(xl), bfhi(xl), bflo(xh), bfhi(xh)};
                v[j] = xv * ALPHA + (va * w[k].x + vb * w[k].y); s += (v[j].x + v[j].y) + (v[j].z + v[j].w); }
            float s2 = 0.f;
#pragma unroll
            for (int j = 0; j < 4; ++j) s2 += (v[j].x * v[j].x + v[j].y * v[j].y) + (v[j].z * v[j].z + v[j].w * v[j].w);
            const float mean = wave_sum(s) * (1.f / D);
            const float rstd = __builtin_amdgcn_rsqf(fmaxf(wave_sum(s2) * (1.f / D) - mean * mean, 0.f) + LN_EPS);
            unsigned long long* xs = (unsigned long long*)(XSO + (size_t)t * D) + F.lane;
#pragma unroll
            for (int j = 0; j < 4; ++j) { v[j] = (v[j] - mean) * rstd * gg[j] + bb[j]; if (!out) pg8::st8(xs + 64 * j, (pg8::u32x2w){pk2(v[j].x, v[j].y), pk2(v[j].z, v[j].w)}); }
            if (XS8) { unsigned* o4 = (unsigned*)(XS8 + (size_t)t * D) + F.lane;
#pragma unroll
                for (int j = 0; j < 4; ++j) { unsigned w = __builtin_amdgcn_cvt_pk_fp8_f32(v[j].x, v[j].y, 0, false); w = __builtin_amdgcn_cvt_pk_fp8_f32(v[j].z, v[j].w, w, true); pg8::st4(o4 + 64 * j, w); } }
            if (out) { f32x4* o4 = (f32x4*)(out + (size_t)t * D) + F.lane;
#pragma unroll
                for (int j = 0; j < 4; ++j) pg8::st16(o4 + 64 * j, __builtin_bit_cast(pg8::u32x4, v[j])); }
        }
    }
}

__device__ __forceinline__ void ph_attn_slow(Frame& F, const bf16* Q, const bf16* K, const bf16* V, const float* relb  , float* O12) {
    LAS float* Ks = (LAS float*)(F.lds + RING_OFF);
    LAS float* Vs = Ks + 32 * 64;
    LAS float* bt = Vs + 32 * 128;
    const int r = F.tid & 255, vh = F.tid >> 8;
    for (int U = F.bid; U < 1024; U += F.G) {
        const int rnd = U >> 8, v = U & 255, bch = v >> 3, s = v & 7;
        const int qt = rnd == 0 ? s : rnd == 1 ? 15 - s : rnd == 2 ? 16 + s : 31 - s;
        const int b = bch >> 4, comp = (bch >> 3) & 1, h = bch & 7;
        __syncthreads();
        if (F.tid < 128) bt[F.tid] = relb[(int)c_bucket[F.tid] * NH + h];
        const float bfar = relb[31 * NH + h];
        const int i = qt * 256 + r; const size_t row = (size_t)b * SEQ + i;
        float q[64];
        { const v4u* qp = (const v4u*)(Q + row * 1024 + comp * 512 + h * 64);
#pragma unroll
          for (int d8 = 0; d8 < 8; ++d8) { const v4u w = qp[d8]; q[8 * d8 + 0] = bflo(w.x) * 0.125f; q[8 * d8 + 1] = bfhi(w.x) * 0.125f; q[8 * d8 + 2] = bflo(w.y) * 0.125f; q[8 * d8 + 3] = bfhi(w.y) * 0.125f;
              q[8 * d8 + 4] = bflo(w.z) * 0.125f; q[8 * d8 + 5] = bfhi(w.z) * 0.125f; q[8 * d8 + 6] = bflo(w.w) * 0.125f; q[8 * d8 + 7] = bfhi(w.w) * 0.125f; } }
        float o[64];
#pragma unroll
        for (int d = 0; d < 64; ++d) o[d] = 0.f;
        float m = -INFINITY, l = 0.f;
        const int nkt = (qt * 256 + 256) / 32;
        for (int kt = 0; kt < nkt; ++kt) {
            __syncthreads();
            { const int kk = F.tid >> 4, c = F.tid & 15; const size_t krow = (size_t)b * SEQ + kt * 32 + kk;
              const unsigned long long kw = *(const unsigned long long*)(K + krow * 1024 + comp * 512 + h * 64 + c * 4);
              LAS float* kd = Ks + kk * 64 + c * 4; kd[0] = bflo((unsigned)kw); kd[1] = bfhi((unsigned)kw); kd[2] = bflo((unsigned)(kw >> 32)); kd[3] = bfhi((unsigned)(kw >> 32));
              const v4u vw = *(const v4u*)(V + krow * 1024 + h * 128 + c * 8);
              LAS float* vd = Vs + kk * 128 + c * 8; vd[0] = bflo(vw.x); vd[1] = bfhi(vw.x); vd[2] = bflo(vw.y); vd[3] = bfhi(vw.y); vd[4] = bflo(vw.z); vd[5] = bfhi(vw.z); vd[6] = bflo(vw.w); vd[7] = bfhi(vw.w); }
            __syncthreads();
            if (kt * 32 <= i) {
                for (int jj = 0; jj < 32; ++jj) {
                    const int j = kt * 32 + jj;
                    if (j <= i) {
                        const LAS f32x4* kp = (const LAS f32x4*)(Ks + jj * 64);
                        float sc = 0.f;
#pragma unroll
                        for (int d4 = 0; d4 < 16; ++d4) { const f32x4 kv = kp[d4]; sc += (q[4 * d4] * kv.x + q[4 * d4 + 1] * kv.y) + (q[4 * d4 + 2] * kv.z + q[4 * d4 + 3] * kv.w); }
                        const int n = i - j; sc += (n < 128) ? bt[n] : bfar;
                        if (sc > m) { const float f = __expf(m - sc); l *= f;
#pragma unroll
                            for (int d = 0; d < 64; ++d) o[d] *= f;
                            m = sc; }
                        const float p = __expf(sc - m); l += p;
                        const LAS f32x4* vp = (const LAS f32x4*)(Vs + jj * 128 + vh * 64);
#pragma unroll
                        for (int d4 = 0; d4 < 16; ++d4) { const f32x4 vv = vp[d4]; o[4 * d4] += p * vv.x; o[4 * d4 + 1] += p * vv.y; o[4 * d4 + 2] += p * vv.z; o[4 * d4 + 3] += p * vv.w; }
                    }
                }
            }
        }
        const float il = 1.0f / l;
        f32x4* op = (f32x4*)(O12 + (size_t)comp * T * 1024 + row * 1024 + h * 128 + vh * 64);
#pragma unroll
        for (int d4 = 0; d4 < 16; ++d4) op[d4] = (f32x4){o[4 * d4] * il, o[4 * d4 + 1] * il, o[4 * d4 + 2] * il, o[4 * d4 + 3] * il};
    }
    __syncthreads();
}

__device__ __forceinline__ void ph_subln(Frame& F, const void* O12, const float* lamp  , const float* sg  , int layer, bf16* U) {
    const float linit = 0.8f - 0.6f * expf(-0.3f * (float)layer);
    const float a = wave_sum(lamp[F.lane] * lamp[64 + F.lane]), b = wave_sum(lamp[128 + F.lane] * lamp[192 + F.lane]);
    const float lam = expf(a) - expf(b) + linit;
    const f32x4 g4 = *((const f32x4*)sg + (F.lane & 31));
    const int gw = F.vcu * NWAVES + F.wave, NGW = F.G * NWAVES;
    for (int t = gw; t < T; t += NGW) {
        unsigned long long* o8 = (unsigned long long*)(U + (size_t)t * D) + F.lane;
#pragma unroll
        for (int j = 0; j < 4; ++j) {
#if ATTN_SLOW
            const f32x4* p1 = (const f32x4*)((const float*)O12 + (size_t)t * 1024) + F.lane; const f32x4* p2 = (const f32x4*)((const float*)O12 + (size_t)T * 1024 + (size_t)t * 1024) + F.lane;
            f32x4 v = p1[64 * j] - p2[64 * j] * lam;
#else
            const unsigned long long q1 = *((const unsigned long long*)((const bf16*)O12 + (size_t)t * 1024) + F.lane + 64 * j), q2 = *((const unsigned long long*)((const bf16*)O12 + (size_t)T * 1024 + (size_t)t * 1024) + F.lane + 64 * j);
            const f32x4 x1 = (f32x4){bflo((unsigned)q1), bfhi((unsigned)q1), bflo((unsigned)(q1 >> 32)), bfhi((unsigned)(q1 >> 32))}, x2 = (f32x4){bflo((unsigned)q2), bfhi((unsigned)q2), bflo((unsigned)(q2 >> 32)), bfhi((unsigned)(q2 >> 32))};
            f32x4 v = x1 - x2 * lam;
#endif
            float ss = (v.x * v.x + v.y * v.y) + (v.z * v.z + v.w * v.w);
#pragma unroll
            for (int o = 1; o < 32; o <<= 1) ss += __shfl_xor(ss, o);
            const float rs = (1.0f / sqrtf(ss * (1.f / VD) + LN_EPS)) * (1.0f - linit);
            v = v * rs * g4; pg8::st8(o8 + 64 * j, (pg8::u32x2w){pk2(v.x, v.y), pk2(v.z, v.w)}); }
    }
}

namespace pg8 {
struct EpiLnMix {
    static constexpr bool PERM = false, AFTER_DRAIN = true;
    bf16_t* XS; int ldc; const float* bias; const float* g; const float* b; float alpha; PanelStats st; unsigned poison;
    __device__ __forceinline__ void fused(f32x4 (&acc)[2][2][4][2], const Unit& u, int wr, int wc, int fr, int fq, PG8_LAS unsigned char* lds, int wid, int lane) const {
        typedef float f32x2v __attribute__((ext_vector_type(2))); typedef unsigned u32x2v __attribute__((ext_vector_type(2)));
        const PG8_LAS f32x2v* S = (const PG8_LAS f32x2v*)(lds + 8192);
        const int col0 = u.pn * BM + wc * 32 + 4 * fq;
#pragma unroll
        for (int bj = 0; bj < 2; ++bj)
#pragma unroll
            for (int n = 0; n < 2; ++n) { const f32x4 bv = bias ? *(const f32x4*)(bias + col0 + bj * HALF + n * 16) : (f32x4){0.f, 0.f, 0.f, 0.f};
#pragma unroll
                for (int ai = 0; ai < 2; ++ai)
#pragma unroll
                    for (int m = 0; m < 4; ++m) acc[ai][bj][m][n] += bv; }
#pragma unroll
        for (int ai = 0; ai < 2; ++ai)
#pragma unroll
            for (int m = 0; m < 4; ++m) { const size_t off = (size_t)(u.pm * BM + ai * HALF + wr * 64 + m * 16 + fr) * ldc + col0;
#pragma unroll
                for (int bj = 0; bj < 2; ++bj)
#pragma unroll
                    for (int n = 0; n < 2; ++n) { const u32x2v w = *(const u32x2v*)(XS + off + bj * HALF + n * 16);
                        const f32x4 xv = (f32x4){__builtin_bit_cast(float, w.x << 16), __builtin_bit_cast(float, w.x & 0xffff0000u), __builtin_bit_cast(float, w.y << 16), __builtin_bit_cast(float, w.y & 0xffff0000u)};
                        acc[ai][bj][m][n] += xv * alpha; }
                asm volatile("" : "+v"(acc[ai][0][m][0]), "+v"(acc[ai][0][m][1]), "+v"(acc[ai][1][m][0]), "+v"(acc[ai][1][m][1]));
                if (m & 1) asm volatile("" ::: "memory"); }
        const bool bad = st.run(acc, u, wr, wc, fr, fq, lds, wid, lane) || poison != 0u;
        f32x4 gv[2][2], bv2[2][2];
#pragma unroll
        for (int bj = 0; bj < 2; ++bj)
#pragma unroll
            for (int n = 0; n < 2; ++n) { gv[bj][n] = *(const f32x4*)(g + col0 + bj * HALF + n * 16); bv2[bj][n] = *(const f32x4*)(b + col0 + bj * HALF + n * 16); }
#pragma unroll
        for (int ai = 0; ai < 2; ++ai)
#pragma unroll
            for (int m = 0; m < 4; ++m) { const int r = ai * HALF + wr * 64 + m * 16 + fr; const f32x2v sr = S[r]; const size_t off = (size_t)(u.pm * BM + r) * ldc + col0;
#pragma unroll
                for (int bj = 0; bj < 2; ++bj)
#pragma unroll
                    for (int n = 0; n < 2; ++n) { const f32x4 o = (acc[ai][bj][m][n] - sr.x) * sr.y * gv[bj][n] + bv2[bj][n]; u32x2v w; w.x = cvt_pk_bf16(o[0], o[1]); w.y = cvt_pk_bf16(o[2], o[3]);
                        if (bad) { w.x = 0x7fc07fc0u; w.y = 0x7fc07fc0u; } *(u32x2v*)(XS + off + bj * HALF + n * 16) = w; } }
    }
};
}
namespace pg8 {
struct EpiF8B {
    static constexpr bool PERM = true, AFTER_DRAIN = false;
    unsigned char* O; int ldc; const float* bias; float in_scale, out_scale;
    __device__ __forceinline__ void operator()(const f32x4 (&acc)[2][2][4][2], const Unit& u, int wr, int wc, int fr, int fq) const {
        const int row0 = u.pm * BM + wr * 64 + fr, col0 = u.pn * BM + wc * 32 + 8 * fq;
        f32x4 bv[2][2];
#pragma unroll
        for (int bj = 0; bj < 2; ++bj)
#pragma unroll
            for (int n = 0; n < 2; ++n) bv[bj][n] = bias ? *(const f32x4*)(bias + col0 + bj * HALF + 4 * n) : (f32x4){0.f, 0.f, 0.f, 0.f};
#pragma unroll
        for (int ai = 0; ai < 2; ++ai)
#pragma unroll
            for (int m = 0; m < 4; ++m) { unsigned char* rowp = O + (size_t)(row0 + ai * HALF + m * 16) * ldc + col0;
#pragma unroll
                for (int bj = 0; bj < 2; ++bj) { const f32x4 v0 = (acc[ai][bj][m][0] * in_scale + bv[bj][0]) * out_scale, v1 = (acc[ai][bj][m][1] * in_scale + bv[bj][1]) * out_scale;
                    u32x2w w; w.x = __builtin_amdgcn_cvt_pk_fp8_f32(v0[0], v0[1], 0, false); w.x = __builtin_amdgcn_cvt_pk_fp8_f32(v0[2], v0[3], w.x, true);
                    w.y = __builtin_amdgcn_cvt_pk_fp8_f32(v1[0], v1[1], 0, false); w.y = __builtin_amdgcn_cvt_pk_fp8_f32(v1[2], v1[3], w.y, true);
                    st8(rowp + bj * HALF, w); } }
    }
};
struct EpiF8QK {
    static constexpr bool PERM = true, AFTER_DRAIN = false;
    unsigned char* O; long koff; float qscale, kscale;
    __device__ __forceinline__ void operator()(const f32x4 (&acc)[2][2][4][2], const Unit& u, int wr, int wc, int fr, int fq) const {
        const int row0 = u.pm * BM + wr * 64 + fr; int colt = u.pn * BM; const int t = colt >> 10; unsigned char* base = O + (long)(t > 0) * koff; colt -= t << 10;
        const int col0 = colt + wc * 32 + 8 * fq; const float sc = t == 0 ? qscale : kscale;
#pragma unroll
        for (int ai = 0; ai < 2; ++ai)
#pragma unroll
            for (int m = 0; m < 4; ++m) { unsigned char* rowp = base + (size_t)(row0 + ai * HALF + m * 16) * 1024 + col0;
#pragma unroll
                for (int bj = 0; bj < 2; ++bj) { const f32x4 v0 = acc[ai][bj][m][0] * sc, v1 = acc[ai][bj][m][1] * sc;
                    u32x2w w; w.x = __builtin_amdgcn_cvt_pk_fp8_f32(v0[0], v0[1], 0, false); w.x = __builtin_amdgcn_cvt_pk_fp8_f32(v0[2], v0[3], w.x, true);
                    w.y = __builtin_amdgcn_cvt_pk_fp8_f32(v1[0], v1[1], 0, false); w.y = __builtin_amdgcn_cvt_pk_fp8_f32(v1[2], v1[3], w.y, true);
                    st8(rowp + bj * HALF, w); } }
    }
};
struct EpiVT8 {
    static constexpr bool PERM = true, AFTER_DRAIN = false;
    unsigned char* O; int ldc; float scale;
    __device__ __forceinline__ void operator()(const f32x4 (&acc)[2][2][4][2], const Unit& u, int wr, int wc, int fr, int fq) const {
        const int row0 = u.pm * BM + wr * 64 + fr;
        const int cbase = u.pn * BM + 64 * (wc >> 1), pos0 = 16 * (wc & 1) + 4 * fq;
#pragma unroll
        for (int ai = 0; ai < 2; ++ai)
#pragma unroll
            for (int m = 0; m < 4; ++m) { unsigned char* rowp = O + (size_t)(row0 + ai * HALF + m * 16) * ldc + cbase + pos0;
#pragma unroll
                for (int bj = 0; bj < 2; ++bj) { const f32x4 v0 = acc[ai][bj][m][0] * scale, v1 = acc[ai][bj][m][1] * scale;
                    unsigned w0 = __builtin_amdgcn_cvt_pk_fp8_f32(v0[0], v0[1], 0, false); w0 = __builtin_amdgcn_cvt_pk_fp8_f32(v0[2], v0[3], w0, true);
                    unsigned w1 = __builtin_amdgcn_cvt_pk_fp8_f32(v1[0], v1[1], 0, false); w1 = __builtin_amdgcn_cvt_pk_fp8_f32(v1[2], v1[3], w1, true);
                    st4(rowp + bj * HALF, w0); st4(rowp + bj * HALF + 32, w1); } }
    }
};
struct EpiBf16SB {
    static constexpr bool PERM = true, AFTER_DRAIN = false;
    bf16_t* O; int ldc; const float* bias; float scale;
    __device__ __forceinline__ void operator()(const f32x4 (&acc)[2][2][4][2], const Unit& u, int wr, int wc, int fr, int fq) const {
        const int row0 = u.pm * BM + wr * 64 + fr, col0 = u.pn * BM + wc * 32 + 8 * fq;
        f32x4 bv[2][2];
#pragma unroll
        for (int bj = 0; bj < 2; ++bj)
#pragma unroll
            for (int n = 0; n < 2; ++n) bv[bj][n] = bias ? *(const f32x4*)(bias + col0 + bj * HALF + 4 * n) : (f32x4){0.f, 0.f, 0.f, 0.f};
#pragma unroll
        for (int ai = 0; ai < 2; ++ai)
#pragma unroll
            for (int m = 0; m < 4; ++m) { bf16_t* rowp = O + (size_t)(row0 + ai * HALF + m * 16) * ldc + col0;
#pragma unroll
                for (int bj = 0; bj < 2; ++bj) { const f32x4 v0 = acc[ai][bj][m][0] * scale + bv[bj][0], v1 = acc[ai][bj][m][1] * scale + bv[bj][1];
                    u32x4 w; w.x = cvt_pk_bf16(v0[0], v0[1]); w.y = cvt_pk_bf16(v0[2], v0[3]); w.z = cvt_pk_bf16(v1[0], v1[1]); w.w = cvt_pk_bf16(v1[2], v1[3]);
                    st16(rowp + bj * HALF, w); } }
    }
};
struct EpiBf16S {
    static constexpr bool PERM = true, AFTER_DRAIN = false;
    bf16_t* O; int ldc; float scale;
    __device__ __forceinline__ void operator()(const f32x4 (&acc)[2][2][4][2], const Unit& u, int wr, int wc, int fr, int fq) const {
        const int row0 = u.pm * BM + wr * 64 + fr, col0 = u.pn * BM + wc * 32 + 8 * fq;
#pragma unroll
        for (int ai = 0; ai < 2; ++ai)
#pragma unroll
            for (int m = 0; m < 4; ++m) { bf16_t* rowp = O + (size_t)(row0 + ai * HALF + m * 16) * ldc + col0;
#pragma unroll
                for (int bj = 0; bj < 2; ++bj) { const f32x4 v0 = acc[ai][bj][m][0] * scale, v1 = acc[ai][bj][m][1] * scale;
                    u32x4 w; w.x = cvt_pk_bf16(v0[0], v0[1]); w.y = cvt_pk_bf16(v0[2], v0[3]); w.z = cvt_pk_bf16(v1[0], v1[1]); w.w = cvt_pk_bf16(v1[2], v1[3]);
                    st16(rowp + bj * HALF, w); } }
    }
};
struct EpiGated8 {
    static constexpr bool PERM = true, AFTER_DRAIN = false;
    unsigned char* O; int ldc; float in_scale, out_scale;
    __device__ __forceinline__ void operator()(const f32x4 (&acc)[2][2][4][2], const Unit& u, int wr, int wc, int fr, int fq) const {
        typedef unsigned u32x2v __attribute__((ext_vector_type(2)));
        const int row0 = u.pm * BM + wr * 64 + fr, col0 = u.pn * HALF + wc * 32 + 8 * fq;
#pragma unroll
        for (int ai = 0; ai < 2; ++ai)
#pragma unroll
            for (int m = 0; m < 4; ++m) { unsigned char* rowp = O + (size_t)(row0 + ai * HALF + m * 16) * ldc + col0; f32x4 r[2];
#pragma unroll
                for (int n = 0; n < 2; ++n) { const f32x4 x = acc[ai][0][m][n] * in_scale, y = acc[ai][1][m][n] * in_scale;
                    f32x4 sg; sg.x = __builtin_amdgcn_rcpf(1.0f + __builtin_amdgcn_exp2f(x.x * -1.4426950408889634f)); sg.y = __builtin_amdgcn_rcpf(1.0f + __builtin_amdgcn_exp2f(x.y * -1.4426950408889634f));
                    sg.z = __builtin_amdgcn_rcpf(1.0f + __builtin_amdgcn_exp2f(x.z * -1.4426950408889634f)); sg.w = __builtin_amdgcn_rcpf(1.0f + __builtin_amdgcn_exp2f(x.w * -1.4426950408889634f));
                    r[n] = x * sg * y * out_scale; }
                u32x2v w; w.x = __builtin_amdgcn_cvt_pk_fp8_f32(r[0][0], r[0][1], 0, false); w.x = __builtin_amdgcn_cvt_pk_fp8_f32(r[0][2], r[0][3], w.x, true);
                w.y = __builtin_amdgcn_cvt_pk_fp8_f32(r[1][0], r[1][1], 0, false); w.y = __builtin_amdgcn_cvt_pk_fp8_f32(r[1][2], r[1][3], w.y, true);
                st8(rowp, (u32x2w){w.x, w.y}); }
    }
};
template <int MODE> struct EpiGated {
    static constexpr bool PERM = true, AFTER_DRAIN = false;
    bf16_t* O; int ldc; const float* bias; int second_off; float in_scale;
    __device__ __forceinline__ void operator()(const f32x4 (&acc)[2][2][4][2], const Unit& u, int wr, int wc, int fr, int fq) const {
        const int row0 = u.pm * BM + wr * 64 + fr, col0 = u.pn * HALF + wc * 32 + 8 * fq;
        f32x4 b0[2], b1[2];
#pragma unroll
        for (int n = 0; n < 2; ++n) { b0[n] = (MODE == 0) ? *(const f32x4*)(bias + col0 + 4 * n) : (f32x4){0.f, 0.f, 0.f, 0.f}; b1[n] = (MODE == 0) ? *(const f32x4*)(bias + second_off + col0 + 4 * n) : (f32x4){0.f, 0.f, 0.f, 0.f}; }
#pragma unroll
        for (int ai = 0; ai < 2; ++ai)
#pragma unroll
            for (int m = 0; m < 4; ++m) { bf16_t* rowp = O + (size_t)(row0 + ai * HALF + m * 16) * ldc + col0; f32x4 r[2];
#pragma unroll
                for (int n = 0; n < 2; ++n) { const f32x4 x = acc[ai][0][m][n] * in_scale + b0[n], y = acc[ai][1][m][n] * in_scale + b1[n]; const f32x4 z = (MODE == 0) ? y : x;
                    f32x4 sg; sg.x = __builtin_amdgcn_rcpf(1.0f + __builtin_amdgcn_exp2f(z.x * -1.4426950408889634f)); sg.y = __builtin_amdgcn_rcpf(1.0f + __builtin_amdgcn_exp2f(z.y * -1.4426950408889634f));
                    sg.z = __builtin_amdgcn_rcpf(1.0f + __builtin_amdgcn_exp2f(z.z * -1.4426950408889634f)); sg.w = __builtin_amdgcn_rcpf(1.0f + __builtin_amdgcn_exp2f(z.w * -1.4426950408889634f));
                    r[n] = (MODE == 0) ? x * sg : x * sg * y; }
                u32x4 w; w.x = cvt_pk_bf16(r[0][0], r[0][1]); w.y = cvt_pk_bf16(r[0][2], r[0][3]); w.z = cvt_pk_bf16(r[1][0], r[1][1]); w.w = cvt_pk_bf16(r[1][2], r[1][3]);
                st16(rowp, w); }
    }
};
struct EpiBf16Split {
    static constexpr bool PERM = true, AFTER_DRAIN = false;
    bf16_t* O0; long d1, d2; float scale0, in_scale;
    __device__ __forceinline__ void operator()(const f32x4 (&acc)[2][2][4][2], const Unit& u, int wr, int wc, int fr, int fq) const {
        const int row0 = u.pm * BM + wr * 64 + fr; int colt = u.pn * BM; const int t = colt >> 10; bf16_t* base = O0 + (long)(t > 0) * d1 + (long)(t > 1) * d2; colt -= t << 10;
        const int col0 = colt + wc * 32 + 8 * fq; const float sc = (t == 0 ? scale0 : 1.f) * in_scale;
#pragma unroll
        for (int ai = 0; ai < 2; ++ai)
#pragma unroll
            for (int m = 0; m < 4; ++m) { bf16_t* rowp = base + (size_t)(row0 + ai * HALF + m * 16) * 1024 + col0;
#pragma unroll
                for (int bj = 0; bj < 2; ++bj) { const f32x4 v0 = acc[ai][bj][m][0] * sc, v1 = acc[ai][bj][m][1] * sc;
                    u32x4 w; w.x = cvt_pk_bf16(v0[0], v0[1]); w.y = cvt_pk_bf16(v0[2], v0[3]); w.z = cvt_pk_bf16(v1[0], v1[1]); w.w = cvt_pk_bf16(v1[2], v1[3]);
                    st16(rowp + bj * HALF, w); } }
    }
};
}

constexpr int PH_PER_LAYER = 16, N_PHASES = 1 + NLAYER * PH_PER_LAYER;

#ifndef PROBE_DUP
#define PROBE_DUP 0
#endif
#if PROBE_DUP == 20
#define PROBE_EXTRA_BAR(b) do { xcd_barrier(b); xcd_barrier(b); } while (0)
#elif PROBE_DUP == 21 || PROBE_DUP == 22 || PROBE_DUP == 23
#define PROBE_EXTRA_BAR(b) do { xcd_barrier_nofence(b); xcd_barrier_nofence(b); } while (0)
#else
#define PROBE_EXTRA_BAR(b) do {} while (0)
#endif
#define NREP(c) ((PROBE_DUP == (c)) ? 2 : 1)
#define IN(k) (lo <= (k) && (k) < hi)
#define SEAM(k) do { if ((k) + 1 < hi) { XcdBarrier b_; b_.bar = (unsigned*)(kargs()->ws + WS_CTL) + CW_BAR; b_.x = xb_xcc_id(); b_.st = (volatile LAS unsigned*)(F.lds + LDSCTL_OFF) + 8; xcd_barrier(b_); PROBE_EXTRA_BAR(b_); } } while (0)
#define FRESH() do { int t_ = threadIdx.x; asm volatile("" : "+v"(t_)); F.tid = t_; F.lane = t_ & 63; F.wave = __builtin_amdgcn_readfirstlane(t_ >> 6); int b_ = blockIdx.x, g_ = gridDim.x; asm volatile("" : "+s"(b_), "+s"(g_)); F.bid = b_; F.G = g_; F.vcu = (g_ % 8 == 0) ? (b_ % 8) * (g_ / 8) + b_ / 8 : b_; } while (0)

#define WSP (kargs()->ws)
#define XBF ((bf16*)(WSP + WS_XBF))
#define MIX ((float*)(WSP + WS_MIX))
#define KB ((bf16*)(WSP + WS_KB))
#define VB ((bf16*)(WSP + WS_VB))
#define tok_e ((int2*)(WSP + WS_ROUT))
#define tok_pos (((int2*)(WSP + WS_ROUT)) + T)
#define tok_w ((float2*)(((int2*)(WSP + WS_ROUT)) + 2 * T))
#define OUTP (kargs()->out)
#define elist_ ((int*)(WSP + WS_ROUT + 512 * 1024))
template <int l> __device__ __forceinline__ void run_layer(Frame& F, const int lo, const int hi, unsigned char* lds) {
        const int pb = 1 + l * PH_PER_LAYER;
        #define cnt ((unsigned*)(WSP + WS_CTL) + CW_CNT + l * NE * 64)
        if (l < NSELF) {
            if (IN(pb + 1)) for (int rep_ = 0; rep_ < NREP(2); ++rep_) { FRESH();
#if DENSE_FP8_S1
                pg8::Gemm g{(const bf16*)(WSP + WS_XS8), (const bf16*)(WSP + WS_PW1T + (size_t)l * 2 * D * D), T, 2 * D, D / 2}; pg8::StaticOrder S; S.init(T, 2 * D, F.G, F.bid);
                pg8::EpiGated<0> E{(bf16*)(WSP + WS_H1), D, INP(2) + (size_t)l * 2 * D, D, 1.0f / WX_SCALE};
                pg8::gemm_phase<pg8::EpiGated<0>, pg8::StaticOrder, true, true, false, true>(F.lds + RING_OFF, g, S, E);
#else
                pg8::Gemm g{XBF, (const bf16*)(WSP + WS_PW1T) + (size_t)l * 2 * D * D, T, 2 * D, D}; pg8::StaticOrder S; S.init(T, 2 * D, F.G, F.bid);
                pg8::EpiGated<0> E{(bf16*)(WSP + WS_H1), D, INP(2) + (size_t)l * 2 * D, D, 1.f};
                pg8::gemm_phase<pg8::EpiGated<0>, pg8::StaticOrder, true, true>(F.lds + RING_OFF, g, S, E);
#endif
                SEAM(pb + 1);
            }
            if (IN(pb + 2)) for (int rep_ = 0; rep_ < NREP(4); ++rep_) { FRESH(); ph_conv(F, (const bf16*)(WSP + WS_H1), INP(3) + (size_t)l * CONVW * D, INP(4) + (size_t)l * D, INP(5) + (size_t)l * D, INP(6) + (size_t)l * D, (bf16*)(WSP + WS_US)); SEAM(pb + 2); }
            if (IN(pb + 4)) for (int rep_ = 0; rep_ < NREP(2); ++rep_) { FRESH();
                pg8::Gemm g{(const bf16*)(WSP + WS_US), (const bf16*)(WSP + WS_PW2T) + (size_t)l * D * D, T, D, D}; pg8::StaticOrder S; S.init(T, D, F.G, F.bid);
#if LN_FUSED
                pg8::PanelStats st{(unsigned*)(WSP + WS_XCH + (size_t)l * 512 * 1024), (unsigned*)(WSP + WS_CTL) + CW_SEAM + l * 64 * 64, (unsigned*)(WSP + WS_CTL) + CW_TMO, D / 256, LN_EPS, 0x700u + 16u * l};
                pg8::EpiLnMix E{XBF, D, INP(8) + (size_t)l * D, INP(15) + (size_t)l * D, INP(16) + (size_t)l * D, ALPHA, st, 0u};
                pg8::gemm_phase<pg8::EpiLnMix, pg8::StaticOrder, false, true>(F.lds + RING_OFF, g, S, E);
#elif DENSE_FP8_S3
                { (void)g; pg8::Gemm g8{(const bf16*)(WSP + WS_US), (const bf16*)(WSP + WS_PW2T + (size_t)l * D * D), T, D, D / 2};
                  pg8::EpiBf16SB E{(bf16*)MIX, D, INP(8) + (size_t)l * D, 1.0f / (WX_SCALE * U_SCALE)};
                  pg8::gemm_phase<pg8::EpiBf16SB, pg8::StaticOrder, true, true, false, true>(F.lds + RING_OFF, g8, S, E); }
#else
#if OUT_FP8_MIX
                pg8::EpiF8B E{(unsigned char*)MIX, D, INP(8) + (size_t)l * D, 1.f, OUT_SCALE};
                pg8::gemm_phase<pg8::EpiF8B, pg8::StaticOrder, true, true>(F.lds + RING_OFF, g, S, E);
#else
                pg8::EpiBf16<0> E{(bf16*)MIX, D, INP(8) + (size_t)l * D, 0, 0, 1.f};
                pg8::gemm_phase<pg8::EpiBf16<0>, pg8::StaticOrder, true, true>(F.lds + RING_OFF, g, S, E);
#endif
#endif
                SEAM(pb + 4);
            }
        } else {
            const int j = l - NSELF;
            if (IN(pb + 1)) for (int rep_ = 0; rep_ < NREP(2); ++rep_) { FRESH();
                const int N = (j == 0) ? 3 * D : D;
#if ATTN_FP8
                { const int N1 = (j == 0) ? 2 * D : D;
                  pg8::Gemm g{(const bf16*)(WSP + WS_XS8), (const bf16*)(WSP + (j == 0 ? WS_WQ0T : WS_WQ1T)), T, N1, D / 2}; pg8::StaticOrder S; S.init(T, N1, F.G, F.bid);
                  pg8::EpiF8QK E{(unsigned char*)(WSP + WS_Q), (long)WS_KB - (long)WS_Q, ATTN_QSCALE * 8.f / WX_SCALE, 0.125f / WX_SCALE};
                  pg8::gemm_phase<pg8::EpiF8QK, pg8::StaticOrder, true, true, false, true>(F.lds + RING_OFF, g, S, E); }
                if (j == 0) {
                  int kq_ = D / 2; asm volatile("" : "+s"(kq_));
                  pg8::Gemm g{(const bf16*)(WSP + WS_WQ0T + 2 * (size_t)D * D), (const bf16*)(WSP + WS_XS8), D, T, kq_}; pg8::StaticOrder S; S.init(D, T, F.G, F.bid);
                  pg8::EpiVT8 E{(unsigned char*)(WSP + WS_VB), T, 1.f / WX_SCALE};
                  pg8::gemm_phase<pg8::EpiVT8, pg8::StaticOrder, true, true, false, true>(F.lds + RING_OFF, g, S, E); }
#elif DENSE_FP8_C1
                pg8::Gemm g{(const bf16*)(WSP + WS_XS8), (const bf16*)(WSP + (j == 0 ? WS_WQ0T : WS_WQ1T)), T, N, D / 2}; pg8::StaticOrder S; S.init(T, N, F.G, F.bid);
                pg8::EpiBf16Split E3{(bf16*)(WSP + WS_Q), ((long)WS_KB - (long)WS_Q) / 2, ((long)WS_VB - (long)WS_KB) / 2, ATTN_QSCALE, 1.0f / WX_SCALE};
                pg8::gemm_phase<pg8::EpiBf16Split, pg8::StaticOrder, true, true, false, true>(F.lds + RING_OFF, g, S, E3);
#else
                pg8::Gemm g{XBF, (const bf16*)(WSP + (j == 0 ? WS_WQ0T : WS_WQ1T)), T, N, D}; pg8::StaticOrder S; S.init(T, N, F.G, F.bid);
                pg8::EpiBf16Split E3{(bf16*)(WSP + WS_Q), ((long)WS_KB - (long)WS_Q) / 2, ((long)WS_VB - (long)WS_KB) / 2, ATTN_QSCALE, 1.f};
                pg8::gemm_phase<pg8::EpiBf16Split, pg8::StaticOrder, true, true>(F.lds + RING_OFF, g, S, E3);
#endif
                SEAM(pb + 1);
            }
            if (IN(pb + 2)) for (int rep_ = 0; rep_ < NREP(3); ++rep_) { FRESH();
#if ATTN_SLOW
                ph_attn_slow(F, (const bf16*)(WSP + WS_Q), KB, VB, INP(14), (float*)(WSP + WS_O12));
#else
#if ATTN_FP8
                { const float* lamp = INP(11) + (size_t)j * 4 * HD; const float linit = 0.8f - 0.6f * expf(-0.3f * (float)l);
                  const float la = wave_sum(lamp[F.lane] * lamp[64 + F.lane]), lb = wave_sum(lamp[128 + F.lane] * lamp[192 + F.lane]); const float lam = expf(la) - expf(lb) + linit;
                  attn8::attn_phase<8>((char*)lds + RING_OFF, (const unsigned char*)(WSP + WS_Q), (const unsigned char*)KB, (const unsigned char*)VB, (attn8::bf16*)(WSP + WS_O12), (attn8::bf16*)(WSP + WS_O12 + 32 * MiB),
                                       INP(12) + (size_t)j * VD, lam, 1.0f - linit, INP(14), F.vcu, F.G); }
#elif ATTN_DV128
                { const float* lamp = INP(11) + (size_t)j * 4 * HD; const float linit = 0.8f - 0.6f * expf(-0.3f * (float)l);
                  const float la = wave_sum(lamp[F.lane] * lamp[64 + F.lane]), lb = wave_sum(lamp[128 + F.lane] * lamp[192 + F.lane]); const float lam = expf(la) - expf(lb) + linit;
                  attn128::attn_phase<8>((char*)lds + RING_OFF, (const attn128::bf16*)(WSP + WS_Q), (const attn128::bf16*)KB, (const attn128::bf16*)VB, (attn128::bf16*)(WSP + WS_O12), (attn128::bf16*)(WSP + WS_O12 + 32 * MiB),
                                         INP(12) + (size_t)j * VD, lam, 1.0f - linit, INP(14), F.vcu, F.G); }
#else
                attn_body::attn_phase<8>((char*)lds + RING_OFF, (const attn_body::bf16*)(WSP + WS_Q), (const attn_body::bf16*)KB, (const attn_body::bf16*)VB, (attn_body::bf16*)(WSP + WS_O12), INP(14), F.vcu, F.G);
#endif
#endif
                SEAM(pb + 2); }
            if (!ATTN_DV128 && IN(pb + 3)) for (int rep_ = 0; rep_ < NREP(10); ++rep_) { FRESH(); ph_subln(F, (const void*)(WSP + WS_O12), INP(11) + (size_t)j * 4 * HD, INP(12) + (size_t)j * VD, l, (bf16*)(WSP + WS_Q)); SEAM(pb + 3); }
            if (IN(pb + 4)) for (int rep_ = 0; rep_ < NREP(2); ++rep_) { FRESH();
                pg8::Gemm g{(const bf16*)(WSP + (ATTN_DV128 ? WS_O12 + 32 * MiB : WS_Q)), (const bf16*)(WSP + WS_WOT) + (size_t)j * D * D, T, D, D}; pg8::StaticOrder S; S.init(T, D, F.G, F.bid);
#if LN_FUSED
                pg8::PanelStats st{(unsigned*)(WSP + WS_XCH + (size_t)l * 512 * 1024), (unsigned*)(WSP + WS_CTL) + CW_SEAM + l * 64 * 64, (unsigned*)(WSP + WS_CTL) + CW_TMO, D / 256, LN_EPS, 0x700u + 16u * l};
                pg8::EpiLnMix E{XBF, D, nullptr, INP(15) + (size_t)l * D, INP(16) + (size_t)l * D, ALPHA, st, 0u};
                pg8::gemm_phase<pg8::EpiLnMix, pg8::StaticOrder, false, true>(F.lds + RING_OFF, g, S, E);
#elif DENSE_FP8_C4
                { (void)g; pg8::Gemm g8{(const bf16*)(WSP + WS_O12 + 32 * MiB), (const bf16*)(WSP + WS_WOT + (size_t)j * D * D), T, D, D / 2};
                  pg8::EpiBf16SB E{(bf16*)MIX, D, nullptr, 1.0f / (WX_SCALE * U_SCALE)};
                  pg8::gemm_phase<pg8::EpiBf16SB, pg8::StaticOrder, true, true, false, true>(F.lds + RING_OFF, g8, S, E); }
#else
#if OUT_FP8_MIX
                pg8::EpiF8B E{(unsigned char*)MIX, D, nullptr, 1.f, OUT_SCALE};
                pg8::gemm_phase<pg8::EpiF8B, pg8::StaticOrder, true, true>(F.lds + RING_OFF, g, S, E);
#else
                pg8::EpiBf16<0> E{(bf16*)MIX, D, nullptr, 0, 0, 1.f};
                pg8::gemm_phase<pg8::EpiBf16<0>, pg8::StaticOrder, true, true>(F.lds + RING_OFF, g, S, E);
#endif
#endif
                SEAM(pb + 4);
            }
        }
        if (IN(pb + 5)) for (int rep_ = 0; rep_ < NREP(5); ++rep_) { FRESH();
            if (PROBE_DUP == 5 && rep_ == 0) ph_router(F, XBF, (bf16*)(WSP + WS_H1), (unsigned char*)(WSP + WS_US), (const bf16*)MIX, INP(15) + (size_t)l * D, INP(16) + (size_t)l * D, INP(19), INP(20), (const bf16*)(WSP + WS_XCH), (int2*)(WSP + WS_US + 16 * MiB), (int2*)(WSP + WS_US + 16 * MiB) + T, (float2*)((int2*)(WSP + WS_US + 16 * MiB) + 2 * T), (int*)(WSP + WS_US + 20 * MiB), (unsigned*)(WSP + WS_CTL) + 200000 + l * NE * 64);
            else ph_router(F, XBF, XBF, (unsigned char*)(WSP + WS_XS8), (const bf16*)MIX, INP(15) + (size_t)l * D, INP(16) + (size_t)l * D, INP(19), INP(20), (const bf16*)(WSP + WS_XCH), tok_e, tok_pos, tok_w, elist_, cnt, WSP, (l == 0) ? 0 : l + 1, 0, (l == 0) ? MOE_CVT_SIDE0 : (l + 1 < NLAYER ? MOE_CVT_SIDEN : 0)); SEAM(pb + 5); }
        if (IN(pb + 7)) for (int rep_ = 0; rep_ < NREP(7); ++rep_) { FRESH();
            moe_offsets(F, cnt);
            const LAS int* li = (const LAS int*)(F.lds + LDSCTL_OFF);
            moe_rowsrc(F, cnt, elist_, F.vcu);
#if MOE_FP8
            pg8::Gemm g{(const bf16*)(WSP + WS_XS8), (const bf16*)(WSP + ws_wgut(l)), XG_ROWS, 2 * DE, D / 2};
#else
            pg8::Gemm g{XBF, (const bf16*)(WSP + ws_wgut(l)), XG_ROWS, 2 * DE, D};
#endif
            GroupedOrder S{li + LI_TEXP, li[LI_NT], 4, F.G, F.vcu, (size_t)2 * DE * D * (MOE_FP8 ? 1 : 2), (const LAS unsigned*)(li + LI_ROWS)};
#if MOE_FP8
            pg8::EpiGated8 E{(unsigned char*)(WSP + WS_HH), DE, 1.0f / WG_SCALE, H_SCALE};
            pg8::gemm_phase<pg8::EpiGated8, GroupedOrder, true, true, true, true>(F.lds + RING_OFF, g, S, E);
#else
            pg8::EpiGated<1> E{(bf16*)(WSP + WS_HH), DE, nullptr, 0, 1.f};
            pg8::gemm_phase<pg8::EpiGated<1>, GroupedOrder, true, true, true>(F.lds + RING_OFF, g, S, E);
#endif
            if (l + 1 < NLAYER) moe_cvt_tail(F, WSP, l + 1, 4 * li[LI_NT], (l == 0) ? 0 : MOE_CVT_SIDEN, (l == 0) ? MOE_CVT_SPLIT : MOE_CVT_SIDEN + 2900);
            SEAM(pb + 7);
        }
        if (IN(pb + 9)) for (int rep_ = 0; rep_ < NREP(8); ++rep_) { FRESH();
            if (!IN(pb + 7)) moe_offsets(F, cnt);
            const LAS int* li = (const LAS int*)(F.lds + LDSCTL_OFF);
            int kq_ = MOE_FP8 ? DE / 2 : DE; asm volatile("" : "+s"(kq_));
            pg8::Gemm g{(const bf16*)(WSP + WS_HH), (const bf16*)(WSP + ws_wdt(l)), XG_ROWS, D, kq_};
            GroupedOrder S{li + LI_TEXP, li[LI_NT], 4, F.G, F.vcu, (size_t)D * DE * (MOE_FP8 ? 1 : 2), nullptr};
#if MOE_FP8
#if OUT_FP8_Y
            pg8::EpiF8B E{(unsigned char*)(WSP + WS_Y), D, nullptr, 1.0f / (H_SCALE * WD_SCALE), OUT_SCALE};
            pg8::gemm_phase<pg8::EpiF8B, GroupedOrder, true, true, false, true>(F.lds + RING_OFF, g, S, E);
#else
            pg8::EpiBf16S E{(bf16*)(WSP + WS_Y), D, 1.0f / (H_SCALE * WD_SCALE)};
            pg8::gemm_phase<pg8::EpiBf16S, GroupedOrder, true, true, false, true>(F.lds + RING_OFF, g, S, E);
#endif
#else
            pg8::EpiBf16<0> E{(bf16*)(WSP + WS_Y), D, nullptr, 0, 0, 1.f};
            pg8::gemm_phase<pg8::EpiBf16<0>, GroupedOrder, true, true>(F.lds + RING_OFF, g, S, E);
#endif
            if (l + 1 < NLAYER) moe_cvt_tail(F, WSP, l + 1, 4 * li[LI_NT], (l == 0) ? MOE_CVT_SPLIT : MOE_CVT_SIDEN + 2900, MOE_CVT_ITEMS);
            SEAM(pb + 9);
        }
        if (IN(pb + 10)) for (int rep_ = 0; rep_ < NREP(9); ++rep_) { FRESH(); if (!IN(pb + 7)) moe_offsets(F, cnt); { const bool dry_ = (PROBE_DUP == 9 && rep_ == 0);
            ph_combine(F, XBF, dry_ ? (bf16*)(WSP + WS_H1) : XBF, (const bf16*)(WSP + WS_Y), tok_e, tok_pos, tok_w, INP(17) + (size_t)l * D, INP(18) + (size_t)l * D, (l == NLAYER - 1) ? (dry_ ? (float*)(WSP + WS_H1) : OUTP) : (float*)nullptr, ((l + 1 < NSELF ? DENSE_FP8_S1 : DENSE_FP8_C1) && l + 1 < NLAYER) ? (unsigned char*)(WSP + (dry_ ? WS_US : WS_XS8)) : (unsigned char*)nullptr); } if (l + 1 < NLAYER) SEAM(pb + 10); }
    }

__global__ void __launch_bounds__(NTHR, 2) yoco_fwd(Args args) {
    extern __shared__ __attribute__((aligned(16))) unsigned char lds[];
    Frame F;
    F.lds = (LAS unsigned char*)lds;
    F.MISC = (volatile LAS unsigned*)(F.lds + LDSCTL_OFF);
    F.tid = threadIdx.x; F.lane = F.tid & 63; F.wave = __builtin_amdgcn_readfirstlane(F.tid >> 6);
    F.G = gridDim.x; F.bid = blockIdx.x; { const int bx = blockIdx.x; F.vcu = (F.G % 8 == 0) ? (bx % 8) * (F.G / 8) + bx / 8 : bx; }
    F.ctl = (gu32*)(args.ws + WS_CTL);
    for (int u = F.tid; u < (LDS_BYTES - LDSCTL_OFF) / 4; u += NTHR) ((LAS unsigned*)(F.lds + LDSCTL_OFF))[u] = 0u;
    __syncthreads();
    const int lo = args.ph_lo, hi = args.ph_hi;
    if (hi - lo > 1) (void)xcd_barrier_post((unsigned*)(F.ctl + CW_BAR), F.MISC + 8);
    if (IN(0)) for (int rep_ = 0; rep_ < NREP(1); ++rep_) { FRESH(); ph_prologue(F, WSP); ph_moe_cvt(F, WSP, 0, MOE_CVT_SIDE0);
        if (ROUTER_MFMA) { const float* rw_ = INP(19); bf16* rwb_ = (bf16*)(WSP + WS_XCH); for (int i = F.bid * NTHR + F.tid; i < 16 * 1024; i += F.G * NTHR) rwb_[i] = (bf16)f2bf(rw_[(i & 1023) * 16 + (i >> 10)]); }
        SEAM(0); }

    run_layer<0>(F, lo, hi, lds); run_layer<1>(F, lo, hi, lds); run_layer<2>(F, lo, hi, lds); run_layer<3>(F, lo, hi, lds);
#undef IN
#undef SEAM
#undef WSP
#undef XBF
#undef MIX
#undef KB
#undef VB
#undef tok_e
#undef tok_pos
#undef tok_w
#undef OUTP
#undef cnt
}

extern "C" void kernel_launch(void* const* d_in, const int* in_sizes, int n_in, void* d_out, int out_size, void* d_ws, size_t ws_size, hipStream_t stream) {
    static int grid = 0;
    if (grid == 0) {
        if (n_in != 24 || in_sizes[0] != T * D || out_size != T * D || ws_size < WS_END) { fprintf(stderr, "kernel_launch: unexpected shapes / workspace (n_in %d, ws %zu); nothing launched\n", n_in, ws_size); grid = -1; return; }
        int dev = 0, cus = 0, per_cu = 0;
        if (hipGetDevice(&dev) != hipSuccess || hipDeviceGetAttribute(&cus, hipDeviceAttributeMultiprocessorCount, dev) != hipSuccess) { grid = -1; return; }
        if (hipFuncSetAttribute((const void*)yoco_fwd, hipFuncAttributeMaxDynamicSharedMemorySize, LDS_BYTES) != hipSuccess) { grid = -1; return; }
        if (hipOccupancyMaxActiveBlocksPerMultiprocessor(&per_cu, (const void*)yoco_fwd, NTHR, LDS_BYTES) != hipSuccess || per_cu < 1) { fprintf(stderr, "kernel_launch: occupancy query says %d\n", per_cu); }
        (void)hipGetLastError();
        if (cus != 256) { fprintf(stderr, "kernel_launch: built for a 256-CU device (one 256x256 unit per workgroup in the fused-LayerNorm GEMM phases, three unit slots per workgroup in the MoE GEMMs); got %d CUs; nothing launched\n", cus); grid = -1; return; }
        grid = cus;
    }
    if (grid < 0) return;
    (void)hipMemsetAsync((char*)d_ws + WS_CTL, 0, CTL_ZERO_BYTES, stream);
    Args a{};
    for (int i = 0; i < 24; ++i) a.in[i] = (const float*)d_in[i];
    a.out = (float*)d_out; a.ws = (unsigned char*)d_ws;
#if MK_ONE_LAUNCH
    a.ph_lo = 0; a.ph_hi = N_PHASES;
    hipLaunchKernelGGL(yoco_fwd, dim3(grid), dim3(NTHR), LDS_BYTES, stream, a);
#else
    for (int ph = 0; ph < N_PHASES; ++ph) {
        const int k = (ph - 1) % PH_PER_LAYER, l = (ph - 1) / PH_PER_LAYER;
        if (ph > 0) { if (k > 10) continue; if (k == 3 && l < NSELF) continue; }
        a.ph_lo = ph; a.ph_hi = ph + 1;
        hipLaunchKernelGGL(yoco_fwd, dim3(grid), dim3(NTHR), LDS_BYTES, stream, a);
    }
#endif
}
```

```cpp
#ifndef MK_ONE_LAUNCH
#define MK_ONE_LAUNCH 1
#endif
#include <hip/hip_runtime.h>
#include <cstdio>
#include <cstdint>
#include <cmath>
namespace pg8 {
#define PG8_LAS __attribute__((address_space(3)))
typedef unsigned short bf16_t;
typedef short bf16x8 __attribute__((ext_vector_type(8)));
typedef float f32x4 __attribute__((ext_vector_type(4)));
typedef unsigned u32x4 __attribute__((ext_vector_type(4)));
constexpr int BM = 256, BK = 64, HALF = 128, HTB = HALF * BK * 2  , STAGE_BYTES = 8 * HTB, NXCD = 8, WGM = 8;

__host__ __device__ __forceinline__ int lds_byte(int r, int c) { const int st = (r >> 4) * 2 + (c >> 5), rr = r & 15, cc = c & 31, ob = rr * 64 + cc * 2; return st * 1024 + (ob ^ (((ob >> 9) & 1) << 5)); }
__host__ __device__ __forceinline__ void stage_rc(int b, int& R, int& C) { const int st = b / 1024, sb = b % 1024, swz = sb ^ (((sb >> 9) & 1) << 5); R = (st >> 1) * 16 + swz / 64; C = (st & 1) * 32 + (swz % 64) / 2; }
__host__ __device__ __forceinline__ int perm32(int rho) { const int n = rho >> 4, i = rho & 15; return 8 * (i >> 2) + 4 * n + (i & 3); }

typedef int v8i32 __attribute__((ext_vector_type(8)));
__device__ __forceinline__ v8i32 cat8(bf16x8 a, bf16x8 b) { typedef int v4i32 __attribute__((ext_vector_type(4))); const v4i32 x = __builtin_bit_cast(v4i32, a), y = __builtin_bit_cast(v4i32, b); return (v8i32){x[0], x[1], x[2], x[3], y[0], y[1], y[2], y[3]}; }
#ifndef WT_STORES
#define WT_STORES 1
#endif
__device__ __forceinline__ void st16(void* p, u32x4 v) {
#if WT_STORES
    asm volatile("global_store_dwordx4 %0, %1, off sc1\n\ts_nop 1" :: "v"(p), "v"(v) : "memory");
#else
    *(u32x4*)p = v;
#endif
}
typedef unsigned u32x2w __attribute__((ext_vector_type(2)));
__device__ __forceinline__ void st8(void* p, u32x2w v) {
#if WT_STORES
    asm volatile("global_store_dwordx2 %0, %1, off sc1\n\ts_nop 1" :: "v"(p), "v"(v) : "memory");
#else
    *(u32x2w*)p = v;
#endif
}
__device__ __forceinline__ void st4(void* p, unsigned v) {
#if WT_STORES
    asm volatile("global_store_dword %0, %1, off sc1\n\ts_nop 0" :: "v"(p), "v"(v) : "memory");
#else
    *(unsigned*)p = v;
#endif
}
struct Unit { int pm, pn; size_t boff; int slot; };
struct Gemm { const bf16_t* A; const bf16_t* Bt; int M, N, K; };

struct StaticOrder {
    int nM, nN, nwg, G, c;
    __host__ __device__ void init(int M, int N, int G_, int c_) { nM = M / BM; nN = N / BM; nwg = nM * nN; G = G_; c = c_; }
    __host__ __device__ bool next(int i, Unit& u) const {
        const long L = (long)i * G + c; if (L >= nwg) return false;
        int wgid = (int)L; { const int q = nwg / NXCD, r = nwg % NXCD, xcd = wgid % NXCD, off = wgid / NXCD; wgid = (xcd < r ? xcd * (q + 1) : r * (q + 1) + (xcd - r) * q) + off; }
        const int nig = WGM * nN, gid = wgid / nig, fm = gid * WGM, gsz = (nM - fm) < WGM ? (nM - fm) : WGM;
        u.pm = fm + ((wgid % nig) % gsz); u.pn = (wgid % nig) / gsz; u.boff = 0; u.slot = 0; return true;
    }
    __device__ __forceinline__ void a_ready(const Unit&) const {}
    __device__ __forceinline__ void done(const Unit&) const {}
};

__device__ __forceinline__ unsigned cvt_pk_bf16(float lo, float hi) { unsigned r; asm volatile("v_cvt_pk_bf16_f32 %0, %1, %2" : "=v"(r) : "v"(lo), "v"(hi)); return r; }
typedef float f32x2 __attribute__((ext_vector_type(2)));
__device__ __forceinline__ f32x2 gelu_pk(f32x2 v) {
    const f32x2 av = __builtin_elementwise_abs(v), d = av * 0.2316418882f + 1.0f;
    f32x2 t; t.x = __builtin_amdgcn_rcpf(d.x); t.y = __builtin_amdgcn_rcpf(d.y);
    f32x2 q = t * 0.5307027145f + (-0.7265760135f); q = q * t + 0.7107068705f; q = q * t + (-0.142248368f); q = q * t + 0.127414796f; q = q * t;
    const f32x2 s = (v * v) * (-0.72134752044f);
    f32x2 e; e.x = __builtin_amdgcn_exp2f(s.x); e.y = __builtin_amdgcn_exp2f(s.y);
    const f32x2 m = v * (q * e), r = v - m;
    f32x2 o; o.x = v.x < 0.f ? m.x : r.x; o.y = v.y < 0.f ? m.y : r.y; return o;
}

template <int ACT  > struct EpiBf16 {
    static constexpr bool PERM = true, AFTER_DRAIN = false; static_assert(ACT == 0 || ACT == 1, "EpiBf16: ACT is 0 (none) or 1 (gelu_pk)");
    bf16_t* O; int ldc; const float* bias; int split_cols; size_t split_stride; float scale0;
    __device__ __forceinline__ void operator()(const f32x4 (&acc)[2][2][4][2], const Unit& u, int wr, int wc, int fr, int fq) const {
        const int row0 = u.pm * BM + wr * 64 + fr; int colt = u.pn * BM; bf16_t* base = O;
        float sc = 1.f; if (split_cols) { const int t = colt / split_cols; base += (size_t)t * split_stride; colt -= t * split_cols; if (t == 0) sc = scale0; }
        const int col0 = colt + wc * 32 + 8 * fq, bcol0 = u.pn * BM + wc * 32 + 8 * fq;
        f32x4 bv[2][2];
#pragma unroll
        for (int bj = 0; bj < 2; ++bj)
#pragma unroll
            for (int n = 0; n < 2; ++n) bv[bj][n] = bias ? *(const f32x4*)(bias + bcol0 + bj * HALF + 4 * n) : (f32x4){0.f, 0.f, 0.f, 0.f};
#pragma unroll
        for (int ai = 0; ai < 2; ++ai)
#pragma unroll
            for (int m = 0; m < 4; ++m) { bf16_t* rowp = base + (size_t)(row0 + ai * HALF + m * 16) * ldc + col0;
#pragma unroll
                for (int bj = 0; bj < 2; ++bj) { f32x4 v0 = acc[ai][bj][m][0] + bv[bj][0], v1 = acc[ai][bj][m][1] + bv[bj][1];
                    if (ACT == 1) { f32x2 a = gelu_pk((f32x2){v0[0], v0[1]}), b = gelu_pk((f32x2){v0[2], v0[3]}), c = gelu_pk((f32x2){v1[0], v1[1]}), d = gelu_pk((f32x2){v1[2], v1[3]});
                        v0 = (f32x4){a.x, a.y, b.x, b.y}; v1 = (f32x4){c.x, c.y, d.x, d.y}; }
                    v0 = v0 * sc; v1 = v1 * sc; u32x4 w; w.x = cvt_pk_bf16(v0[0], v0[1]); w.y = cvt_pk_bf16(v0[2], v0[3]); w.z = cvt_pk_bf16(v1[0], v1[1]); w.w = cvt_pk_bf16(v1[2], v1[3]);
                    st16(rowp + bj * HALF, w); } }
    }
};

struct EpiF32 {
    static constexpr bool PERM = false, AFTER_DRAIN = false;
    float* C; int ldc; const float* bias;
    __device__ __forceinline__ void operator()(const f32x4 (&acc)[2][2][4][2], const Unit& u, int wr, int wc, int fr, int fq) const {
        const int row0 = u.pm * BM + wr * 64 + fr, col0 = u.pn * BM + wc * 32 + 4 * fq;
        f32x4 bv[2][2];
#pragma unroll
        for (int bj = 0; bj < 2; ++bj)
#pragma unroll
            for (int n = 0; n < 2; ++n) bv[bj][n] = bias ? *(const f32x4*)(bias + col0 + bj * HALF + n * 16) : (f32x4){0.f, 0.f, 0.f, 0.f};
#pragma unroll
        for (int ai = 0; ai < 2; ++ai)
#pragma unroll
            for (int m = 0; m < 4; ++m) { float* rowp = C + (size_t)(row0 + ai * HALF + m * 16) * ldc + col0;
#pragma unroll
                for (int bj = 0; bj < 2; ++bj)
#pragma unroll
                    for (int n = 0; n < 2; ++n) *(f32x4*)(rowp + bj * HALF + n * 16) = acc[ai][bj][m][n] + bv[bj][n]; }
    }
};
struct PanelStats {
    unsigned* xbuf;
    unsigned* cnt;
    unsigned* tmo;
    int ntn; float eps;
    unsigned code;
    __device__ __forceinline__ bool run(const f32x4 (&v)[2][2][4][2], const Unit& u, int wr, int wc, int fr, int fq, PG8_LAS unsigned char* lds, int wid, int lane) const {
        typedef float f32x2v __attribute__((ext_vector_type(2)));
        PG8_LAS f32x2v* P = (PG8_LAS f32x2v*)lds;
        PG8_LAS f32x2v* S = (PG8_LAS f32x2v*)(lds + 8192);
        PG8_LAS unsigned* flag = (PG8_LAS unsigned*)(lds + 8192 + 2048);
#pragma unroll
        for (int ai = 0; ai < 2; ++ai)
#pragma unroll
            for (int m = 0; m < 4; ++m) {
                float s = 0.f;
#pragma unroll
                for (int bj = 0; bj < 2; ++bj)
#pragma unroll
                    for (int n = 0; n < 2; ++n) { const f32x4 x = v[ai][bj][m][n]; s += (x[0] + x[1]) + (x[2] + x[3]); }
                s += __shfl_xor(s, 16); s += __shfl_xor(s, 32);
                const float mw = s * (1.0f / 64.0f); float q = 0.f;
#pragma unroll
                for (int bj = 0; bj < 2; ++bj)
#pragma unroll
                    for (int n = 0; n < 2; ++n) { const f32x4 d = v[ai][bj][m][n] - mw; q += (d[0] * d[0] + d[1] * d[1]) + (d[2] * d[2] + d[3] * d[3]); }
                q += __shfl_xor(q, 16); q += __shfl_xor(q, 32);
                if (fq == 0) P[(ai * HALF + wr * 64 + m * 16 + fr) * 4 + wc] = (f32x2v){mw, q};
            }
        asm volatile("s_waitcnt lgkmcnt(0)" ::: "memory"); __builtin_amdgcn_s_barrier(); asm volatile("" ::: "memory");
#if defined(BROKEN_EXCHANGE_NO_WAIT)
#warning BROKEN CONTROL BUILD: the row-statistics exchange does not wait; results are wrong by design
        if (blockIdx.x >= 64) { const long long t0_ = clock64(); while (clock64() - t0_ < 60000) __builtin_amdgcn_s_sleep(8); }
#endif
        const int row = wid * 32 + (lane & 31);
        if (lane < 32) {
            const f32x2v a = P[row * 4 + 0], b = P[row * 4 + 1], c = P[row * 4 + 2], d = P[row * 4 + 3];
            const float mt = (a.x + b.x + c.x + d.x) * 0.25f;
            const float da = a.x - mt, db = b.x - mt, dc = c.x - mt, dd = d.x - mt;
            const float m2 = (a.y + b.y) + (c.y + d.y) + 64.0f * ((da * da + db * db) + (dc * dc + dd * dd));
            unsigned long long* slot = (unsigned long long*)xbuf + ((size_t)(u.pm * BM + row) * 4 + u.pn);
            __hip_atomic_store(slot, ((unsigned long long)__float_as_uint(m2) << 32) | __float_as_uint(mt), __ATOMIC_RELAXED, __HIP_MEMORY_SCOPE_AGENT);
        }
        asm volatile("s_waitcnt vmcnt(0)" ::: "memory");
        if (lane == 0) __hip_atomic_fetch_add(cnt + 64 * u.pm, 1u, __ATOMIC_RELAXED, __HIP_MEMORY_SCOPE_AGENT);
        if (wid == 0) {
            bool dead = false; const unsigned long long t0 = __builtin_amdgcn_s_memrealtime(); const unsigned want = 8u * (unsigned)ntn;
            for (;;) {
#if defined(BROKEN_EXCHANGE_NO_WAIT)
                break;
#endif
                if ((unsigned)__builtin_amdgcn_readfirstlane(__hip_atomic_load(cnt + 64 * u.pm, __ATOMIC_RELAXED, __HIP_MEMORY_SCOPE_AGENT)) >= want) break;
                if (__builtin_amdgcn_s_memrealtime() - t0 > 2000000ull) {
                    if (lane == 0) { unsigned expect = 0u; __hip_atomic_compare_exchange_strong(tmo + 1, &expect, code | (unsigned)(u.pm & 0xff), __ATOMIC_RELAXED, __ATOMIC_RELAXED, __HIP_MEMORY_SCOPE_AGENT);
                                     __hip_atomic_store(tmo, 1u, __ATOMIC_RELAXED, __HIP_MEMORY_SCOPE_AGENT); }
                    dead = true; break; }
                __builtin_amdgcn_s_sleep(2);
            }
            __builtin_amdgcn_fence(__ATOMIC_ACQUIRE, "agent");
            if (lane == 0) flag[0] = dead ? 1u : 0u;
        }
        asm volatile("s_waitcnt vmcnt(0) lgkmcnt(0)" ::: "memory"); __builtin_amdgcn_s_barrier(); asm volatile("" ::: "memory");
        const bool bad = flag[0] != 0u;
        if (lane < 32) {
            const unsigned long long* slot = (const unsigned long long*)xbuf + (size_t)(u.pm * BM + row) * 4; float mt[4], m2[4]; float ms = 0.f;
#pragma unroll
            for (int t = 0; t < 4; ++t) { if (t < ntn) { const unsigned long long w = __hip_atomic_load(slot + t, __ATOMIC_RELAXED, __HIP_MEMORY_SCOPE_AGENT); mt[t] = __uint_as_float((unsigned)w); m2[t] = __uint_as_float((unsigned)(w >> 32)); } else { mt[t] = 0.f; m2[t] = 0.f; } ms += mt[t]; }
            const float mean = ms / (float)ntn; float q = 0.f;
#pragma unroll
            for (int t = 0; t < 4; ++t) if (t < ntn) { const float dm = mt[t] - mean; q += m2[t] + 256.0f * dm * dm; }
            S[row] = (f32x2v){mean, 1.0f / sqrtf(q / (256.0f * (float)ntn) + eps)};
        }
        asm volatile("s_waitcnt lgkmcnt(0)" ::: "memory"); __builtin_amdgcn_s_barrier(); asm volatile("" ::: "memory");
        return bad;
    }
};
struct EpiLnRes {
    static constexpr bool PERM = false, AFTER_DRAIN = true;
    const float* base; float* out; int ldc; const float* bias; PanelStats st; unsigned poison;
    __device__ __forceinline__ void fused(f32x4 (&acc)[2][2][4][2], const Unit& u, int wr, int wc, int fr, int fq, PG8_LAS unsigned char* lds, int wid, int lane) const {
        typedef float f32x2v __attribute__((ext_vector_type(2)));
        const PG8_LAS f32x2v* S = (const PG8_LAS f32x2v*)(lds + 8192);
        const int col0 = u.pn * BM + wc * 32 + 4 * fq;
#pragma unroll
        for (int bj = 0; bj < 2; ++bj)
#pragma unroll
            for (int n = 0; n < 2; ++n) { const f32x4 bv = bias ? *(const f32x4*)(bias + col0 + bj * HALF + n * 16) : (f32x4){0.f, 0.f, 0.f, 0.f};
#pragma unroll
                for (int ai = 0; ai < 2; ++ai)
#pragma unroll
                    for (int m = 0; m < 4; ++m) acc[ai][bj][m][n] += bv; }
        f32x4 pre[4][2][2];
#pragma unroll
        for (int m = 0; m < 4; ++m) { const size_t off = (size_t)(u.pm * BM + wr * 64 + m * 16 + fr) * ldc + col0;
#pragma unroll
            for (int bj = 0; bj < 2; ++bj)
#pragma unroll
                for (int n = 0; n < 2; ++n) pre[m][bj][n] = *(const f32x4*)(base + off + bj * HALF + n * 16); }
        const bool bad = st.run(acc, u, wr, wc, fr, fq, lds, wid, lane) || poison != 0u;
        const float qnan = __builtin_nanf("");
#pragma unroll
        for (int ai = 0; ai < 2; ++ai)
#pragma unroll
            for (int m = 0; m < 4; ++m) { const int r = ai * HALF + wr * 64 + m * 16 + fr; const f32x2v sr = S[r]; const size_t off = (size_t)(u.pm * BM + r) * ldc + col0;
#pragma unroll
                for (int bj = 0; bj < 2; ++bj)
#pragma unroll
                    for (int n = 0; n < 2; ++n) { const f32x4 bs = ai == 0 ? pre[m][bj][n] : *(const f32x4*)(base + off + bj * HALF + n * 16); f32x4 o = bs + (acc[ai][bj][m][n] - sr.x) * sr.y;
                        if (bad) o = (f32x4){qnan, qnan, qnan, qnan}; *(f32x4*)(out + off + bj * HALF + n * 16) = o; }
                if (m & 1) asm volatile("" ::: "memory"); }
    }
};
struct EpiLnResLn {
    static constexpr bool PERM = false, AFTER_DRAIN = true;
    const float* base; float* out; bf16_t* xn; int ldc; const float* bias; PanelStats st1, st2; unsigned poison;
    __device__ __forceinline__ void fused(f32x4 (&acc)[2][2][4][2], const Unit& u, int wr, int wc, int fr, int fq, PG8_LAS unsigned char* lds, int wid, int lane) const {
        typedef float f32x2v __attribute__((ext_vector_type(2))); typedef unsigned u32x2v __attribute__((ext_vector_type(2)));
        const PG8_LAS f32x2v* S = (const PG8_LAS f32x2v*)(lds + 8192);
        const int col0 = u.pn * BM + wc * 32 + 4 * fq;
#pragma unroll
        for (int bj = 0; bj < 2; ++bj)
#pragma unroll
            for (int n = 0; n < 2; ++n) { const f32x4 bv = bias ? *(const f32x4*)(bias + col0 + bj * HALF + n * 16) : (f32x4){0.f, 0.f, 0.f, 0.f};
#pragma unroll
                for (int ai = 0; ai < 2; ++ai)
#pragma unroll
                    for (int m = 0; m < 4; ++m) acc[ai][bj][m][n] += bv; }
        bool bad = st1.run(acc, u, wr, wc, fr, fq, lds, wid, lane) || poison != 0u;
        const float qnan = __builtin_nanf("");
#pragma unroll
        for (int ai = 0; ai < 2; ++ai)
#pragma unroll
            for (int m = 0; m < 4; ++m) { const int r = ai * HALF + wr * 64 + m * 16 + fr; const f32x2v sr = S[r]; const size_t off = (size_t)(u.pm * BM + r) * ldc + col0;
#pragma unroll
                for (int bj = 0; bj < 2; ++bj)
#pragma unroll
                    for (int n = 0; n < 2; ++n) { const f32x4 bs = *(const f32x4*)(base + off + bj * HALF + n * 16); acc[ai][bj][m][n] = bs + (acc[ai][bj][m][n] - sr.x) * sr.y; }
                asm volatile("" : "+v"(acc[ai][0][m][0]), "+v"(acc[ai][0][m][1]), "+v"(acc[ai][1][m][0]), "+v"(acc[ai][1][m][1]));
                if (m & 1) asm volatile("" ::: "memory"); }
        const bool bad1 = bad;
        bad = st2.run(acc, u, wr, wc, fr, fq, lds, wid, lane) || bad;
#pragma unroll
        for (int ai = 0; ai < 2; ++ai)
#pragma unroll
            for (int m = 0; m < 4; ++m) { const int r = ai * HALF + wr * 64 + m * 16 + fr; const f32x2v sr = S[r]; const size_t off = (size_t)(u.pm * BM + r) * ldc + col0;
#pragma unroll
                for (int bj = 0; bj < 2; ++bj)
#pragma unroll
                    for (int n = 0; n < 2; ++n) { const f32x4 x1 = acc[ai][bj][m][n]; *(f32x4*)(out + off + bj * HALF + n * 16) = bad1 ? (f32x4){qnan, qnan, qnan, qnan} : x1;
                        const f32x4 o = (x1 - sr.x) * sr.y; u32x2v w; w.x = cvt_pk_bf16(o[0], o[1]); w.y = cvt_pk_bf16(o[2], o[3]);
                        if (bad) { w.x = 0x7fc07fc0u; w.y = 0x7fc07fc0u; } *(u32x2v*)(xn + off + bj * HALF + n * 16) = w; }
                asm volatile("" ::: "memory"); }
    }
};

template <class Epi, class Sched, bool ALIGN_EPI = false, bool SP2 = false, bool GATHER = false, bool FP8 = false>
__device__ __forceinline__ void gemm_phase(PG8_LAS unsigned char* lds, const Gemm g, const Sched& S, const Epi& E) {
    int tid_ = threadIdx.x; asm volatile("" : "+v"(tid_));
    const int tid = tid_, wid = __builtin_amdgcn_readfirstlane(tid >> 6), lane = tid & 63, wr = wid >> 2, wc = wid & 3, fr = lane & 15, fq = lane >> 4;
    const int K = g.K, nt = K / BK;
    unsigned voffA[2], voffB[2]; int RA[2]; unsigned CA2[2];
#pragma unroll
    for (int i = 0; i < 2; ++i) { int R, C; stage_rc(tid * 16 + i * 8192, R, C); const int Rb = Epi::PERM ? ((R & ~31) + perm32(R & 31)) : R;
        voffA[i] = (unsigned)(R * K + C) * 2u; voffB[i] = (unsigned)(Rb * K + C) * 2u; RA[i] = R; CA2[i] = (unsigned)C * 2u; }
    static_assert(!GATHER || SP2, "GATHER is wired into the SP2 loop only");
    unsigned vA0[2], vA1[2], nA0[2], nA1[2];
    _Pragma("unroll") for (int i = 0; i < 2; ++i) { vA0[i] = voffA[i]; vA1[i] = voffA[i]; nA0[i] = voffA[i]; nA1[i] = voffA[i]; }
    const size_t kstep = (size_t)(BK * 2);
    const size_t hstep = (size_t)HALF * K * 2;
    const size_t tstep = 2 * hstep;
    const size_t hstepA = GATHER ? 0 : hstep;
    const unsigned ldsw = (unsigned)wid * 1024u;
    const int aoff = lds_byte(wr * 64 + fr, fq * 8), boff = lds_byte(wc * 32 + fr, fq * 8);
#define PG8_SA(b, h) (((b) * 2 + (h)) * HTB)
#define PG8_SB(b, h) ((4 + (b) * 2 + (h)) * HTB)
#define PG8_STAGE(bufoff, gbase, voff) do { _Pragma("unroll") for (int _i = 0; _i < 2; ++_i) \
        __builtin_amdgcn_global_load_lds((const unsigned*)((const char*)(gbase) + (voff)[_i]), (PG8_LAS unsigned*)(lds + (bufoff) + ldsw + _i * 8192), 16, 0, 0); } while (0)
#define PG8_LDA(dst, b, h) do { if constexpr (FP8) { __builtin_amdgcn_sched_barrier(0); _Pragma("unroll") for (int m = 0; m < 4; ++m) dst##8[m] = cat8(*(const PG8_LAS bf16x8*)(lds + PG8_SA(b, h) + aoff + m * 2048), *(const PG8_LAS bf16x8*)(lds + PG8_SA(b, h) + aoff + m * 2048 + 1024)); } \
    else { _Pragma("unroll") for (int m = 0; m < 4; ++m) _Pragma("unroll") for (int k = 0; k < 2; ++k) dst[m][k] = *(const PG8_LAS bf16x8*)(lds + PG8_SA(b, h) + aoff + m * 2048 + k * 1024); } } while (0)
#define PG8_LDB(dst, b, h) do { if constexpr (FP8) { _Pragma("unroll") for (int n = 0; n < 2; ++n) dst##8[n] = cat8(*(const PG8_LAS bf16x8*)(lds + PG8_SB(b, h) + boff + n * 2048), *(const PG8_LAS bf16x8*)(lds + PG8_SB(b, h) + boff + n * 2048 + 1024)); } \
    else { _Pragma("unroll") for (int n = 0; n < 2; ++n) _Pragma("unroll") for (int k = 0; k < 2; ++k) dst[n][k] = *(const PG8_LAS bf16x8*)(lds + PG8_SB(b, h) + boff + n * 2048 + k * 1024); } } while (0)
#define PG8_MMA(ai, bj, At, Bt) do { __builtin_amdgcn_s_setprio(1); \
        if constexpr (FP8) { _Pragma("unroll") for (int m = 0; m < 4; ++m) _Pragma("unroll") for (int n = 0; n < 2; ++n) \
            acc[ai][bj][m][n] = __builtin_amdgcn_mfma_scale_f32_16x16x128_f8f6f4(Bt##8[n], At##8[m], acc[ai][bj][m][n], 0, 0, 0, 0, 0, 0); \
            _Pragma("unroll") for (int m = 0; m < 4; ++m) asm volatile("" : "+v"(acc[ai][bj][m][0]), "+v"(acc[ai][bj][m][1]));     \
            __builtin_amdgcn_sched_barrier(0); } \
        else { _Pragma("unroll") for (int m = 0; m < 4; ++m) _Pragma("unroll") for (int n = 0; n < 2; ++n) _Pragma("unroll") for (int k = 0; k < 2; ++k) \
            acc[ai][bj][m][n] = __builtin_amdgcn_mfma_f32_16x16x32_bf16(Bt[n][k], At[m][k], acc[ai][bj][m][n], 0, 0, 0); } \
        __builtin_amdgcn_s_setprio(0); } while (0)
#define PG8_WAIT_V(n) asm volatile("s_waitcnt vmcnt(" #n ")" ::: "memory")
#define PG8_WAIT_L(n) asm volatile("s_waitcnt lgkmcnt(" #n ")" ::: "memory")
#define PG8_BAR __builtin_amdgcn_s_barrier()
#define PG8_SCHED __builtin_amdgcn_sched_barrier(0)
    Unit cur, nxt; int ui = 0;
    if (!S.next(0, cur)) return;
    f32x4 acc[2][2][4][2];
#pragma unroll
    for (int a = 0; a < 2; ++a)
#pragma unroll
        for (int b = 0; b < 2; ++b)
#pragma unroll
            for (int m = 0; m < 4; ++m)
#pragma unroll
                for (int n = 0; n < 2; ++n) acc[a][b][m][n] = (f32x4){0.f, 0.f, 0.f, 0.f};
    bf16x8 At[4][2], B0[2][2], B1[2][2];
    v8i32 At8[4], B08[2], B18[2];
    const char* cA = GATHER ? (const char*)g.A : (const char*)g.A + (size_t)cur.pm * tstep;
    if constexpr (GATHER) { _Pragma("unroll") for (int i = 0; i < 2; ++i) { vA0[i] = S.rowoff(cur, RA[i]) + CA2[i]; vA1[i] = S.rowoff(cur, HALF + RA[i]) + CA2[i]; } }
    const char* cB = (const char*)g.Bt + cur.boff + (size_t)cur.pn * tstep;
    S.a_ready(cur);
    if constexpr (SP2) {
        PG8_STAGE(PG8_SB(0, 0), cB, voffB); PG8_STAGE(PG8_SB(0, 1), cB + hstep, voffB); PG8_STAGE(PG8_SA(0, 0), cA, vA0); PG8_STAGE(PG8_SA(0, 1), cA + hstepA, vA1);
        if (wr == 1) PG8_BAR;
        PG8_WAIT_V(2); PG8_BAR;
        PG8_STAGE(PG8_SB(1, 0), cB + kstep, voffB); PG8_STAGE(PG8_SA(1, 0), cA + kstep, vA0); PG8_STAGE(PG8_SB(1, 1), cB + hstep + kstep, voffB);
        PG8_WAIT_V(6); PG8_BAR;
    } else {
        PG8_STAGE(PG8_SB(0, 0), cB, voffB); PG8_STAGE(PG8_SA(0, 0), cA, voffA); PG8_STAGE(PG8_SB(0, 1), cB + hstep, voffB); PG8_STAGE(PG8_SA(0, 1), cA + hstep, voffA);
        if (wr == 1) PG8_BAR;
        PG8_WAIT_V(4); PG8_BAR;
        PG8_STAGE(PG8_SB(1, 0), cB + kstep, voffB); PG8_STAGE(PG8_SA(1, 0), cA + kstep, voffA); PG8_STAGE(PG8_SB(1, 1), cB + hstep + kstep, voffB);
        PG8_WAIT_V(6); PG8_BAR;
    }
    for (;;) {
        const bool has_next = S.next(ui + 1, nxt);
        const char* nA = GATHER ? cA : (has_next ? (const char*)g.A + (size_t)nxt.pm * tstep : cA);
        if constexpr (GATHER) { _Pragma("unroll") for (int i = 0; i < 2; ++i) { nA0[i] = has_next ? S.rowoff(nxt, RA[i]) + CA2[i] : vA0[i]; nA1[i] = has_next ? S.rowoff(nxt, HALF + RA[i]) + CA2[i] : vA1[i]; } }
        const char* nB = has_next ? (const char*)g.Bt + nxt.boff + (size_t)nxt.pn * tstep : cB;
        for (int t = 0; t < nt; t += 2) {
            const bool last = (t == nt - 2);
            const char* a1 = cA + (size_t)(t + 1) * kstep;
            const char* a2 = last ? nA : cA + (size_t)(t + 2) * kstep; const char* b2 = last ? nB : cB + (size_t)(t + 2) * kstep;
            const char* a3 = a2 + kstep; const char* b3 = b2 + kstep;
            if (last && has_next) S.a_ready(nxt);
            unsigned sA0[2], sA1[2]; _Pragma("unroll") for (int i = 0; i < 2; ++i) { sA0[i] = last ? nA0[i] : vA0[i]; sA1[i] = last ? nA1[i] : vA1[i]; }
            if constexpr (SP2) {
            PG8_LDB(B0, 0, 0); PG8_LDB(B1, 0, 1); PG8_SCHED; PG8_LDA(At, 0, 0); PG8_STAGE(PG8_SA(1, 1), a1 + hstepA, vA1);
            PG8_WAIT_V(8); PG8_WAIT_L(0); PG8_BAR; PG8_MMA(0, 0, At, B0); PG8_MMA(0, 1, At, B1); PG8_BAR; PG8_SCHED;
            PG8_LDA(At, 0, 1); PG8_STAGE(PG8_SB(0, 0), b2, voffB); PG8_STAGE(PG8_SB(0, 1), b2 + hstep, voffB); PG8_STAGE(PG8_SA(0, 0), a2, sA0);
            PG8_WAIT_V(8); PG8_WAIT_L(0); PG8_BAR; PG8_MMA(1, 0, At, B0); PG8_MMA(1, 1, At, B1); PG8_BAR; PG8_SCHED;
            PG8_LDB(B0, 1, 0); PG8_LDB(B1, 1, 1); PG8_SCHED; PG8_LDA(At, 1, 0); PG8_STAGE(PG8_SA(0, 1), a2 + hstepA, sA1);
            PG8_WAIT_V(8); PG8_WAIT_L(0); PG8_BAR; PG8_MMA(0, 0, At, B0); PG8_MMA(0, 1, At, B1); PG8_BAR; PG8_SCHED;
            PG8_LDA(At, 1, 1); PG8_STAGE(PG8_SB(1, 0), b3, voffB); PG8_STAGE(PG8_SB(1, 1), b3 + hstep, voffB); PG8_STAGE(PG8_SA(1, 0), a3, sA0);
            PG8_WAIT_V(8); PG8_WAIT_L(0); PG8_BAR; PG8_MMA(1, 0, At, B0); PG8_MMA(1, 1, At, B1); PG8_BAR; PG8_SCHED;
            } else {
            PG8_LDB(B0, 0, 0); PG8_SCHED; PG8_LDA(At, 0, 0); PG8_STAGE(PG8_SA(1, 1), a1 + hstep, voffA);
            PG8_WAIT_L(8); PG8_BAR; PG8_WAIT_L(0); PG8_MMA(0, 0, At, B0); PG8_BAR; PG8_SCHED;
            PG8_LDB(B1, 0, 1); PG8_STAGE(PG8_SB(0, 0), b2, voffB);
            PG8_BAR; PG8_WAIT_L(0); PG8_MMA(0, 1, At, B1); PG8_BAR;
            PG8_LDA(At, 0, 1); PG8_STAGE(PG8_SA(0, 0), a2, voffA);
            PG8_BAR; PG8_WAIT_L(0); PG8_MMA(1, 0, At, B0); PG8_BAR; PG8_SCHED;
            PG8_STAGE(PG8_SB(0, 1), b2 + hstep, voffB);
            PG8_WAIT_V(6); PG8_BAR; PG8_MMA(1, 1, At, B1); PG8_BAR;
            PG8_LDB(B0, 1, 0); PG8_SCHED; PG8_LDA(At, 1, 0); PG8_STAGE(PG8_SA(0, 1), a2 + hstep, voffA);
            PG8_WAIT_L(8); PG8_BAR; PG8_WAIT_L(0); PG8_MMA(0, 0, At, B0); PG8_BAR; PG8_SCHED;
            PG8_LDB(B1, 1, 1); PG8_STAGE(PG8_SB(1, 0), b3, voffB);
            PG8_BAR; PG8_WAIT_L(0); PG8_MMA(0, 1, At, B1); PG8_BAR;
            PG8_LDA(At, 1, 1); PG8_STAGE(PG8_SA(1, 0), a3, voffA);
            PG8_BAR; PG8_WAIT_L(0); PG8_MMA(1, 0, At, B0); PG8_BAR; PG8_SCHED;
            PG8_STAGE(PG8_SB(1, 1), b3 + hstep, voffB);
            PG8_WAIT_V(6); PG8_BAR; PG8_MMA(1, 1, At, B1); PG8_BAR;
            }
        }
        if constexpr (ALIGN_EPI) { if (wr == 0) PG8_BAR; }
        if constexpr (!Epi::AFTER_DRAIN) { E(acc, cur, wr, wc, fr, fq); S.done(cur); }
        if (!has_next) break;
#pragma unroll
        for (int a = 0; a < 2; ++a)
#pragma unroll
            for (int b = 0; b < 2; ++b)
#pragma unroll
                for (int m = 0; m < 4; ++m)
#pragma unroll
                    for (int n = 0; n < 2; ++n) acc[a][b][m][n] = (f32x4){0.f, 0.f, 0.f, 0.f};
        cur = nxt; cA = nA; cB = nB; ++ui;
        _Pragma("unroll") for (int i = 0; i < 2; ++i) { vA0[i] = nA0[i]; vA1[i] = nA1[i]; }
        if constexpr (ALIGN_EPI) { if (wr == 1) PG8_BAR; }
    }
    PG8_WAIT_V(0);
    if constexpr (!ALIGN_EPI) { if (wr == 0) PG8_BAR; }
    PG8_BAR;
    if constexpr (Epi::AFTER_DRAIN) { E.fused(acc, cur, wr, wc, fr, fq, lds, wid, lane); S.done(cur); }
#undef PG8_SA
#undef PG8_SB
#undef PG8_STAGE
#undef PG8_LDA
#undef PG8_LDB
#undef PG8_MMA
#undef PG8_WAIT_V
#undef PG8_WAIT_L
#undef PG8_BAR
#undef PG8_SCHED
}
}
#define GAS __attribute__((address_space(1)))
#define LAS __attribute__((address_space(3)))
typedef unsigned short bf16;
typedef unsigned v4u __attribute__((ext_vector_type(4)));
typedef float f32x4 __attribute__((ext_vector_type(4)));
typedef short bf16x8 __attribute__((ext_vector_type(8)));
typedef GAS unsigned gu32;
typedef GAS unsigned long long gu64;
#define RLX_AGENT __ATOMIC_RELAXED, __HIP_MEMORY_SCOPE_AGENT
#define LDS_WAIT() asm volatile("s_waitcnt lgkmcnt(0)" ::: "memory")
#define VM_WAIT() asm volatile("s_waitcnt vmcnt(0)" ::: "memory")
__device__ __forceinline__ unsigned long long rt() { return __builtin_amdgcn_s_memrealtime(); }
__device__ __forceinline__ unsigned f2bf(float f) { unsigned u = __builtin_bit_cast(unsigned, f); return (u + 0x7fffu + ((u >> 16) & 1u)) >> 16; }
typedef float pk2_f32x2 __attribute__((ext_vector_type(2))); typedef __bf16 pk2_bf16x2 __attribute__((ext_vector_type(2)));
__device__ __forceinline__ unsigned pk2(float lo, float hi) { const pk2_f32x2 v = {lo, hi}; return __builtin_bit_cast(unsigned, __builtin_convertvector(v, pk2_bf16x2)); }

#define XB_TMO      128
#define XB_XCNT(j)  (256  + 64 * (j))
#define XB_XSUB(j)  (1280 + 64 * (j))
#define XB_XGEN(j)  (2304 + 64 * (j))
#define XB_TOP      3328
#define XB_TOPGEN   3392
#define XCD_BAR_WORDS 3456
#define XB_SPIN_CAP (1u << 18)

__device__ __forceinline__ unsigned xb_ld(unsigned* p)              { return __hip_atomic_load(p, __ATOMIC_RELAXED, __HIP_MEMORY_SCOPE_AGENT); }
__device__ __forceinline__ unsigned xb_add(unsigned* p, unsigned v) { return __hip_atomic_fetch_add(p, v, __ATOMIC_RELAXED, __HIP_MEMORY_SCOPE_AGENT); }
__device__ __forceinline__ unsigned xb_xcc_id() { return (unsigned)__builtin_amdgcn_s_getreg((3 << 11) | 20) & 0xFu; }
#define XB_SPIN(cond, bar) do { unsigned _sp = 0; while (cond) { __builtin_amdgcn_s_sleep(8);     \
    if ((++_sp & 255u) == 0u) { if (xb_ld(&(bar)[XB_TMO])) break; if (_sp > XB_SPIN_CAP) { atomicAdd(&(bar)[XB_TMO], 1u); break; } } } } while (0)

struct XcdBarrier {
    unsigned* bar; unsigned x;
    volatile LAS unsigned* st;
};

__device__ __forceinline__ XcdBarrier xcd_barrier_post(unsigned* bar, volatile LAS unsigned* st) {
    XcdBarrier b; b.bar = bar; b.x = xb_xcc_id(); b.st = st;
    if (threadIdx.x == 0) (void)xb_add(&bar[XB_XCNT(b.x)], 1u);
    return b;
}
__device__ __forceinline__ void xcd_barrier_complete(unsigned* bar, unsigned x, unsigned& nloc, unsigned& nx) {
    const unsigned G = gridDim.x * gridDim.y * gridDim.z;
    unsigned sum, cnt, mine, sp = 0u;
    for (;;) {
        sum = 0u; cnt = 0u; mine = 0u;
#pragma unroll
        for (unsigned j = 0; j < 16; ++j) { const unsigned c = xb_ld(&bar[XB_XCNT(j)]); sum += c; cnt += (c > 0u) ? 1u : 0u; mine = (j == x) ? c : mine; }
        if (sum == G) break;
        __builtin_amdgcn_s_sleep(1);
        if ((++sp & 255u) == 0u) { if (xb_ld(&bar[XB_TMO])) break; if (sp > XB_SPIN_CAP) { atomicAdd(&bar[XB_TMO], 1u); break; } }
    }
    nloc = mine > 0u ? mine : 1u; nx = cnt > 0u ? cnt : 1u;
}

__device__ __forceinline__ void xcd_barrier(const XcdBarrier& b) {
    asm volatile("s_waitcnt vmcnt(0)" ::: "memory");
    __syncthreads();
    if (threadIdx.x == 0) {
        unsigned* bar = b.bar;
        __builtin_amdgcn_s_waitcnt(0);
        unsigned nloc = b.st[0], nx = b.st[1];
        if (nloc == 0u) { xcd_barrier_complete(bar, b.x, nloc, nx); b.st[0] = nloc; b.st[1] = nx; }
        const unsigned old = xb_add(&bar[XB_XSUB(b.x)], 1u);
        const unsigned gen = old / nloc;
        if (old + 1u == (gen + 1u) * nloc) {
            __builtin_amdgcn_fence(__ATOMIC_RELEASE, "agent");
            asm volatile("s_waitcnt vmcnt(0)" ::: "memory");
            unsigned og; { const unsigned z_ = 0u, o_ = 1u; unsigned* tp_ = &bar[XB_TOP];
              asm volatile("global_atomic_add %0, %1, %2, %3 sc0\n\tbuffer_inv sc1\n\ts_waitcnt vmcnt(0)" : "=&v"(og) : "v"(z_), "v"(o_), "s"(tp_) : "memory"); }
            const unsigned tg = og / nx;
            if (og + 1u != (tg + 1u) * nx) XB_SPIN(xb_ld(&bar[XB_TOP]) < (tg + 1u) * nx, bar);
            asm volatile("s_waitcnt vmcnt(0)" ::: "memory");
            xb_add(&bar[XB_XGEN(b.x)], 1u);
            asm volatile("s_waitcnt vmcnt(0)" ::: "memory");
        } else {
            asm volatile("buffer_inv sc1" ::: "memory");
            XB_SPIN(xb_ld(&bar[XB_XGEN(b.x)]) == gen, bar);
            asm volatile("s_waitcnt vmcnt(0)" ::: "memory");
        }
    }
    __syncthreads();
}

constexpr int NWAVES = 8, NTHR = 512;
constexpr int T = 16384, D = 1024, SEQ = 8192, NE = 16, DE = 512, NLAYER = 4, NSELF = 2, CONVW = 31;
constexpr int NH = 8, HD = 64, VD = 128;
constexpr float LN_EPS = 1e-5f;
#ifndef MOE_FP8
#define MOE_FP8 1
#endif
#ifndef DENSE_FP8_S1
#define DENSE_FP8_S1 1
#endif
#ifndef DENSE_FP8_C1
#define DENSE_FP8_C1 1
#endif
#ifndef DENSE_FP8_S3
#define DENSE_FP8_S3 1
#endif
#ifndef DENSE_FP8_C4
#define DENSE_FP8_C4 1
#endif
#ifndef ATTN_FP8
#define ATTN_FP8 1
#endif
#ifndef OUT_FP8_MIX
#define OUT_FP8_MIX 0
#endif
#ifndef OUT_FP8_Y
#define OUT_FP8_Y 0
#endif
#ifndef LN_FUSED
#define LN_FUSED 0
#endif
#ifndef ATTN_DV128
#define ATTN_DV128 1
#endif
#ifndef ATTN_SLOW
#define ATTN_SLOW 0
#endif
constexpr float ATTN_QSCALE = ATTN_SLOW ? 1.0f : 0.125f * 1.4426950408889634f;
constexpr float ALPHA = 1.6817928305074290f;
constexpr int XG_ROWS = 36864;
constexpr int MAXTILES = XG_ROWS / 256;

constexpr size_t MiB = 1u << 20;
constexpr size_t WS_CTL = 0, CTL_ZERO_BYTES = 1 * MiB;
constexpr size_t WS_PW1T = 2 * MiB;
constexpr size_t WS_PW2T = 10 * MiB;
constexpr size_t WS_WQ0T = 14 * MiB;
constexpr size_t WS_WKVT = 16 * MiB;
constexpr size_t WS_WQ1T = 20 * MiB;
constexpr size_t WS_WOT  = 22 * MiB;
constexpr size_t WS_XCH  = 28 * MiB;
constexpr size_t WS_ROUT = 26 * MiB;
__host__ __device__ constexpr size_t ws_wgut(int l) { return (l & 1) ? 80 * MiB : 32 * MiB; }
__host__ __device__ constexpr size_t ws_wdt(int l) { return (l & 1) ? 112 * MiB : 64 * MiB; }
constexpr size_t WS_XS8  = 128 * MiB;
constexpr float OUT_SCALE = 8.f;
constexpr float U_SCALE = 8.f;
constexpr float WX_SCALE = 16.f;
constexpr float WG_SCALE = 16.f, WD_SCALE = 32.f, H_SCALE = 4.f;
constexpr size_t WS_XBF  = 144 * MiB;
constexpr size_t WS_KB   = 176 * MiB;
constexpr size_t WS_VB   = 208 * MiB;
constexpr size_t WS_SCR  = 240 * MiB;
constexpr size_t WS_H1   = WS_SCR;
constexpr size_t WS_US   = WS_SCR + 64 * MiB;
constexpr size_t WS_Q    = WS_SCR;
constexpr size_t WS_O12  = WS_SCR + 32 * MiB;
constexpr size_t WS_MIX  = WS_SCR + 160 * MiB;
constexpr size_t WS_XG   = WS_SCR;
constexpr size_t WS_HU   = WS_SCR + 72 * MiB;
constexpr size_t WS_HH   = WS_SCR + 144 * MiB;
constexpr size_t WS_Y    = WS_SCR + 180 * MiB;
constexpr size_t WS_END  = WS_SCR + 252 * MiB;
constexpr int CW_TMO = 0, CW_CODE = 1;
constexpr int CW_BAR = 4096;
constexpr int CW_CNT = 16384;
constexpr int CW_SEAM = 32768;
constexpr int CW_CVT = 16384 + 4 * 16 * 64;

constexpr int RING_OFF = 0, RING_BYTES = 131072;
constexpr int LDSCTL_OFF = RING_BYTES;
constexpr int LDS_BYTES = 147456;
constexpr int LI_OFF = 32, LI_NT = 49, LI_TEXP = 64, LI_CNT = 224, LI_ROWS = 256;

__constant__ unsigned char c_bucket[128] = {0, 1, 2, 3, 4, 5, 6, 7, 8, 9, 10, 11, 12, 13, 14, 15, 16, 16, 16, 17, 17, 18, 18, 18, 19, 19, 19, 20, 20, 20, 20, 21, 21, 21, 21, 22, 22, 22, 22, 22, 23, 23, 23, 23, 23, 23, 24, 24, 24, 24, 24, 24, 25, 25, 25, 25, 25, 25, 25, 26, 26, 26, 26, 26, 26, 26, 26, 27, 27, 27, 27, 27, 27, 27, 27, 27, 27, 28, 28, 28, 28, 28, 28, 28, 28, 28, 28, 29, 29, 29, 29, 29, 29, 29, 29, 29, 29, 29, 29, 30, 30, 30, 30, 30, 30, 30, 30, 30, 30, 30, 30, 30, 30, 31, 31, 31, 31, 31, 31, 31, 31, 31, 31, 31, 31, 31, 31, 31};

#include <hip/hip_bf16.h>
#include <cmath>
namespace attn_body {
using bf16=__hip_bfloat16;
using bf16x8=__attribute__((ext_vector_type(8)))short;
using s16x4=__attribute__((ext_vector_type(4)))short;
using f32x16=__attribute__((ext_vector_type(16)))float;
using u32x4=__attribute__((ext_vector_type(4)))unsigned;
constexpr int BATCH=2,NHEAD=16,SEQ=8192,D=64,DM=NHEAD*D;
constexpr int NW=8,QBLK=32,QB=QBLK*NW,KVBLK=64,NQB=SEQ/QB;
constexpr int ATTN_PITCH=DM, ATTN_UNIT_ROWS=QB;
__device__ __forceinline__ int crow(int r,int hi){return (r&3)+8*(r>>2)+4*hi;}
#define SBAR() __builtin_amdgcn_sched_barrier(0)
__device__ __forceinline__ void cmask(f32x16&p0,f32x16&p1,int jb,int qrel,int hi){
  const float NEG=-INFINITY; int kb=64*jb+4*hi;
  #pragma unroll
  for(int r=0;r<16;++r){int kv=kb+(r&3)+8*(r>>2); if(kv>qrel)p0[r]=NEG; if(kv+32>qrel)p1[r]=NEG;}
}

__device__ __forceinline__ void cbm(f32x16&p0,f32x16&p1,int jb,int qrel,int hi,const __attribute__((address_space(3))) float*dt){
  const float NEG=-INFINITY; const int nb=qrel-64*jb-4*hi;
  #pragma unroll
  for(int r=0;r<16;++r){const int n0=nb-((r&3)+8*(r>>2)),n1=n0-32; const float d0=dt[n0<0?0:n0],d1=dt[n1<0?0:n1];
    p0[r]=n0<0?NEG:p0[r]+d0; p1[r]=n1<0?NEG:p1[r]+d1;}
}

constexpr int NSLOT=3, SLOTB=8192;
constexpr int LDS_K=0, LDS_V=NSLOT*SLOTB, LDS_WS=2*NSLOT*SLOTB, LDS_OST=LDS_WS+NW*64*4, LDS_DT=LDS_OST+NW*4096, LDS_BYTES=LDS_DT+512*4;
constexpr float C2=0.125f*1.4426950408889634f;
__device__ __forceinline__ void glds16(const void*gsrc,unsigned lds_dst){unsigned keep;
  asm volatile("s_mov_b32 %0, m0\n\ts_mov_b32 m0, %2\n\ts_nop 0\n\tglobal_load_lds_dwordx4 %1, off\n\ts_mov_b32 m0, %0":"=&s"(keep):"v"(gsrc),"s"(lds_dst):"memory");}
__device__ __forceinline__ float max3f(float a,float b,float c){float r;asm("v_max3_f32 %0, %1, %2, %3":"=v"(r):"v"(a),"v"(b),"v"(c));return r;}
__device__ __forceinline__ float max2f(float a,float b){float r;asm("v_max_f32_e32 %0, %1, %2":"=v"(r):"v"(a),"v"(b));return r;}
__device__ __forceinline__ float fadd_s(float a,float b){float r;asm("v_add_f32_e32 %0, %1, %2":"=v"(r):"v"(a),"v"(b));return r;}
__device__ __forceinline__ float fsub_s(float a,float b){float r;asm("v_sub_f32_e32 %0, %1, %2":"=v"(r):"v"(a),"v"(b));return r;}
typedef float f32x2_t __attribute__((ext_vector_type(2))); typedef __bf16 bf16x2_t __attribute__((ext_vector_type(2)));
__device__ __forceinline__ unsigned cvtpk_s(float lo,float hi){f32x2_t v={lo,hi};bf16x2_t b=__builtin_convertvector(v,bf16x2_t);return __builtin_bit_cast(unsigned,b);}
#define WAIT_BAR(N) asm volatile("s_waitcnt vmcnt(" #N ") lgkmcnt(0)\n\ts_barrier":::"memory")

__device__ __forceinline__ void qkt(f32x16&p0,f32x16&p1,const char*Kslot,const bf16x8*qr,const f32x16&negm,int r32,int hi){
  const char*kb=Kslot+hi*1024+r32*16;
  #pragma unroll
  for(int d0=0;d0<4;++d0){
    const bf16x8 b0=*reinterpret_cast<const bf16x8*>(kb+d0*2048);
    const bf16x8 b1=*reinterpret_cast<const bf16x8*>(kb+d0*2048+512);
    if(d0==0){p0=__builtin_amdgcn_mfma_f32_32x32x16_bf16(b0,qr[0],negm,0,0,0);p1=__builtin_amdgcn_mfma_f32_32x32x16_bf16(b1,qr[0],negm,0,0,0);}
    else{p0=__builtin_amdgcn_mfma_f32_32x32x16_bf16(b0,qr[d0],p0,0,0,0);p1=__builtin_amdgcn_mfma_f32_32x32x16_bf16(b1,qr[d0],p1,0,0,0);}}
}
typedef __attribute__((address_space(3))) const char* lds_cptr;
typedef short v4i16_t __attribute__((ext_vector_type(4)));
__device__ __forceinline__ void kload8(bf16x8*kf,lds_cptr kp){
  kf[0]=*(const __attribute__((address_space(3))) bf16x8*)(kp);      kf[1]=*(const __attribute__((address_space(3))) bf16x8*)(kp+512);
  kf[2]=*(const __attribute__((address_space(3))) bf16x8*)(kp+2048); kf[3]=*(const __attribute__((address_space(3))) bf16x8*)(kp+2560);
  kf[4]=*(const __attribute__((address_space(3))) bf16x8*)(kp+4096); kf[5]=*(const __attribute__((address_space(3))) bf16x8*)(kp+4608);
  kf[6]=*(const __attribute__((address_space(3))) bf16x8*)(kp+6144); kf[7]=*(const __attribute__((address_space(3))) bf16x8*)(kp+6656);
}
__device__ __forceinline__ void kload2(bf16x8*kf,lds_cptr kp,int j){ kf[2*j]=*(const __attribute__((address_space(3))) bf16x8*)(kp+j*2048); kf[2*j+1]=*(const __attribute__((address_space(3))) bf16x8*)(kp+j*2048+512); }
__device__ __forceinline__ s16x4 vtr(lds_cptr p){ return __builtin_bit_cast(s16x4,__builtin_amdgcn_ds_read_tr16_b64_v4i16((__attribute__((address_space(3))) v4i16_t*)p)); }
__device__ __forceinline__ float rowmax(const f32x16&p0,const f32x16&p1){
  float a=max3f(p0[0],p0[1],p1[0]),b=max3f(p0[2],p0[3],p1[1]);a=max3f(a,p1[2],p1[3]);
  #pragma unroll
  for(int r=4;r<16;r+=4){a=max3f(a,p0[r],p0[r+1]);b=max3f(b,p0[r+2],p0[r+3]);a=max3f(a,p1[r],p1[r+1]);b=max3f(b,p1[r+2],p1[r+3]);}
  const float m=max2f(a,b);
  auto rr=__builtin_amdgcn_permlane32_swap(__float_as_uint(m),__float_as_uint(m),false,false);
  return max2f(__uint_as_float(rr[0]),__uint_as_float(rr[1]));
}
__device__ __forceinline__ void pv(f32x16*o,int vb,bf16x8 pa0,bf16x8 pa1,bf16x8 pa2,bf16x8 pa3){
  #pragma unroll
  for(int d0=0;d0<2;++d0){s16x4 lo[4],hi[4];
    #pragma unroll
    for(int ks=0;ks<4;++ks){
      asm volatile("ds_read_b64_tr_b16 %0,%1 offset:%c2":"=&v"(lo[ks]):"v"(vb),"i"(d0*4096+ks*1024):"memory");
      asm volatile("ds_read_b64_tr_b16 %0,%1 offset:%c2":"=&v"(hi[ks]):"v"(vb),"i"(d0*4096+ks*1024+512):"memory");}
    asm volatile("s_waitcnt lgkmcnt(0)":::"memory");SBAR();
    #define PK(k) (bf16x8){lo[k][0],lo[k][1],lo[k][2],lo[k][3],hi[k][0],hi[k][1],hi[k][2],hi[k][3]}
    o[d0]=__builtin_amdgcn_mfma_f32_32x32x16_bf16(pa0,PK(0),o[d0],0,0,0);
    o[d0]=__builtin_amdgcn_mfma_f32_32x32x16_bf16(pa1,PK(1),o[d0],0,0,0);
    o[d0]=__builtin_amdgcn_mfma_f32_32x32x16_bf16(pa2,PK(2),o[d0],0,0,0);
    o[d0]=__builtin_amdgcn_mfma_f32_32x32x16_bf16(pa3,PK(3),o[d0],0,0,0);
    #undef PK
  }
}

#ifndef ATTN_STORE16
#define ATTN_STORE16(p,v) (*(u32x4*)(p)=(v))
#endif
template<int THRL> __device__ __forceinline__ void attn_unit(int b,int hq,int hv,int qb,const bf16*Q,const bf16*__restrict__ K,const bf16*__restrict__ V,bf16*O,const float*__restrict__ relb,char*shm){
  int tid_=threadIdx.x; asm volatile("":"+v"(tid_));
  const int tid=tid_,lane=tid&63,r32=lane&31,hi=lane>>5; const int wid=__builtin_amdgcn_readfirstlane(tid>>6);
  const long rowbase=(long)b*SEQ; const int q0=qb*QB;
  const bf16*Qw=Q+(rowbase+q0+wid*QBLK)*DM+hq*D;
  const bf16*Kh=K+rowbase*DM+hq*D,*Vh=V+rowbase*DM+hv*D;
  const lds_cptr shm3=(lds_cptr)shm;
  const unsigned lds0=(unsigned)(uintptr_t)shm;
  float*wsf=(float*)(shm+LDS_WS)+wid*64;
  const bf16*ksrc=Kh+(long)lane*DM+wid*8;
  const bf16*vsrc=Vh+(long)(16*(wid&3)+(lane>>2))*DM+(wid>>2)*32+(lane&3)*8;
  const unsigned kdst=lds0+LDS_K+wid*1024, vdst=lds0+LDS_V+wid*1024;
  #define DMA_K(t,slot) glds16(ksrc+(long)(t)*KVBLK*DM,(unsigned)__builtin_amdgcn_readfirstlane(kdst+(slot)))
  #define DMA_V(t,slot) glds16(vsrc+(long)(t)*KVBLK*DM,(unsigned)__builtin_amdgcn_readfirstlane(vdst+(slot)))
  const int vb0=(int)(lds0+LDS_V)+((lane>>4)&1)*32+(lane&3)*8+(4*hi+((lane&15)>>2))*64;
  const char*Kbase=shm+LDS_K; bf16x8 kf[8];
  const lds_cptr kp0=shm3+LDS_K+hi*1024+r32*16; const lds_cptr vp0=shm3+LDS_V+((lane>>4)&1)*32+(lane&3)*8+(4*hi+((lane&15)>>2))*64;
  const int NT=(q0+QB)/KVBLK;
  const __attribute__((address_space(3))) float*dtab=(const __attribute__((address_space(3))) float*)(shm3+LDS_DT);
  { const int h8=hq&7; const float bfar=relb[31*8+h8]; const float dv=(tid<113)?(relb[(int)c_bucket[tid<128?tid:0]*8+h8]-bfar)*1.4426950408889634f:0.f;
    ((__attribute__((address_space(3))) float*)(shm3+LDS_DT))[tid]=dv; }
  DMA_K(0,0);DMA_V(0,0);DMA_K(1,SLOTB);
  bf16x8 qr[4];
  #pragma unroll
  for(int d0=0;d0<4;++d0)qr[d0]=*reinterpret_cast<const bf16x8*>(&Qw[(long)r32*DM+d0*16+hi*8]);
  float mhat=0.f,l_reg=0.f;f32x16 o[2];o[0]=f32x16{};o[1]=f32x16{};f32x16 negm=f32x16{};asm volatile("":"+v"(negm));
  const int qrel=wid*QBLK+r32;
  #define CMASK(P0,P1,t) do{int jb_=(t)-(NT-4); if(jb_>=-2)cbm(P0,P1,jb_,qrel,hi,dtab);}while(0)
  bool resc=false;
  #define START(P0,P1) do{ const float rm=rowmax(P0,P1); resc=false; \
    { const float dl=rm; mhat=fadd_s(mhat,dl); \
      _Pragma("unroll") for(int r=0;r<16;++r){P0[r]=fsub_s(P0[r],dl);P1[r]=fsub_s(P1[r],dl);} \
      _Pragma("unroll") for(int r=0;r<16;++r)negm[r]=-mhat; asm volatile("":"+v"(negm)); } \
    _Pragma("unroll") for(int r=0;r<16;++r)P0[r]=__builtin_amdgcn_exp2f(P0[r]); }while(0)
  #define RESC() do{ if(resc){ asm volatile("s_waitcnt lgkmcnt(0)":::"memory"); \
      _Pragma("unroll") for(int d_=0;d_<2;++d_) _Pragma("unroll") for(int r=0;r<16;++r)o[d_][r]*=wsf[crow(r,hi)]; } }while(0)
  f32x16 pA0,pA1,pB0,pB1;
  int sl_prev=0,sl_cur=0,sl_next=SLOTB;
  #define ROT() do{sl_prev=sl_cur;sl_cur=sl_next;sl_next=(sl_next==(NSLOT-1)*SLOTB)?0:sl_next+SLOTB;}while(0)
  DMA_K(2,2*SLOTB);
  WAIT_BAR(3);
  qkt(pA0,pA1,Kbase,qr,negm,r32,hi);asm volatile("s_nop 15\n\ts_nop 7":"+v"(pA0),"+v"(pA1));CMASK(pA0,pA1,0);
  START(pA0,pA1);
  _Pragma("unroll") for(int r=0;r<16;++r)pA1[r]=__builtin_amdgcn_exp2f(pA1[r]);
  WAIT_BAR(0);
  DMA_K(3,0);DMA_V(1,SLOTB);
  ROT();
  kload8(kf,kp0+sl_cur);
  WAIT_BAR(2);
  s16x4 vlo[8],vhi[8]; u32x4 pw0,pw1,pw2,pw3;
  #define PKW(P,B) cvtpk_s(P[B],P[B+1])
  #define PAF(k) __builtin_bit_cast(bf16x8,pw##k)
  #define VFR(i) (bf16x8){vlo[i][0],vlo[i][1],vlo[i][2],vlo[i][3],vhi[i][0],vhi[i][1],vhi[i][2],vhi[i][3]}
  #define PIN(x) asm volatile("":"+v"(x))
  #define MX3(a,b,c) __builtin_fmaxf(__builtin_fmaxf((a),(b)),(c))
  #define GAPA(MF,A0,A1,A2,A3,W0,W1,PW) do{ MF; sacc+=A0; sacc+=A1; sacc+=A2; sacc+=A3; PIN(sacc); W0; W1; PIN(PW); SBAR(); }while(0)
  #define EX(v) __builtin_amdgcn_exp2f(v)
  #define GAPB(MF,X,B) do{ MF; X[B]=EX(X[B]); X[B+1]=EX(X[B+1]); X[B+2]=EX(X[B+2]); X[B+3]=EX(X[B+3]); PIN(X); SBAR(); }while(0)
  #define VRD(i) do{ vlo[i]=vtr(vp_+(((i)>>2)*4096+((i)&3)*1024)); vhi[i]=vtr(vp_+(((i)>>2)*4096+((i)&3)*1024+512)); }while(0)
  #define KRD(G,j) do{ if(G){ kload2(kf,kp0+sl_next,j); SBAR(); } }while(0)
  #define STEP(C0,C1,P0,P1,t,GK,GV,GL) do{ SBAR(); \
    const lds_cptr vp_=vp0+sl_prev; \
    VRD(0); SBAR(); float sacc=(P0[0]+P0[1]); \
    GAPA(C0=__builtin_amdgcn_mfma_f32_32x32x16_bf16(kf[0],qr[0],negm,0,0,0), P0[2],P0[3],P0[4],P0[5],     pw0[0]=PKW(P0,0), pw0[1]=PKW(P0,2), pw0); \
    VRD(4); SBAR(); GAPA(C1=__builtin_amdgcn_mfma_f32_32x32x16_bf16(kf[1],qr[0],negm,0,0,0), P0[6],P0[7],P0[8],P0[9],     pw0[2]=PKW(P0,4), pw0[3]=PKW(P0,6), pw0); \
    VRD(1); SBAR(); GAPA(C0=__builtin_amdgcn_mfma_f32_32x32x16_bf16(kf[2],qr[1],C0,0,0,0),   P0[10],P0[11],P0[12],P0[13], pw1[0]=PKW(P0,8), pw1[1]=PKW(P0,10), pw1); \
    VRD(5); SBAR(); GAPA(C1=__builtin_amdgcn_mfma_f32_32x32x16_bf16(kf[3],qr[1],C1,0,0,0),   P0[14],P0[15],P1[0],P1[1],   pw1[2]=PKW(P0,12),pw1[3]=PKW(P0,14), pw1); \
    VRD(2); SBAR(); GAPA(C0=__builtin_amdgcn_mfma_f32_32x32x16_bf16(kf[4],qr[2],C0,0,0,0),   P1[2],P1[3],P1[4],P1[5],     pw2[0]=PKW(P1,0), pw2[1]=PKW(P1,2), pw2); \
    VRD(6); SBAR(); GAPA(C1=__builtin_amdgcn_mfma_f32_32x32x16_bf16(kf[5],qr[2],C1,0,0,0),   P1[6],P1[7],P1[8],P1[9],     pw2[2]=PKW(P1,4), pw2[3]=PKW(P1,6), pw2); \
    VRD(3); SBAR(); GAPA(C0=__builtin_amdgcn_mfma_f32_32x32x16_bf16(kf[6],qr[3],C0,0,0,0),   P1[10],P1[11],P1[12],P1[13], pw3[0]=PKW(P1,8), pw3[1]=PKW(P1,10), pw3); \
    VRD(7); SBAR(); GAPA(C1=__builtin_amdgcn_mfma_f32_32x32x16_bf16(kf[7],qr[3],C1,0,0,0),   P1[14],P1[15],0.f,0.f,       pw3[2]=PKW(P1,12),pw3[3]=PKW(P1,14), pw3); \
    l_reg+=sacc; \
    if(GK){DMA_K((t)+3,sl_cur);} if(GV){DMA_V((t)+1,sl_next);} \
    CMASK(C0,C1,t); \
    { float a=MX3(C0[0],C0[1],C1[0]),b=MX3(C0[2],C0[3],C1[1]); a=MX3(a,C1[2],C1[3]); \
      _Pragma("unroll") for(int r=4;r<16;r+=4){a=MX3(a,C0[r],C0[r+1]);b=MX3(b,C0[r+2],C0[r+3]);a=MX3(a,C1[r],C1[r+1]);b=MX3(b,C1[r+2],C1[r+3]);} \
      float rm=__builtin_fmaxf(a,b); { auto rr=__builtin_amdgcn_permlane32_swap(__float_as_uint(rm),__float_as_uint(rm),false,false); rm=__builtin_fmaxf(__uint_as_float(rr[0]),__uint_as_float(rr[1])); } \
      resc=false; \
      if(__builtin_expect(__any(rm>(float)THRL),0)){ const float dl=__builtin_fmaxf(rm,0.f); mhat+=dl; \
        _Pragma("unroll") for(int r=0;r<16;++r){C0[r]-=dl;C1[r]-=dl;} \
        _Pragma("unroll") for(int r=0;r<16;++r)negm[r]=-mhat; asm volatile("":"+v"(negm)); \
        const float f=__builtin_amdgcn_exp2f(-dl); l_reg*=f; if(hi==0)wsf[r32]=f; resc=true; } } \
    SBAR(); \
    GAPB(o[0]=__builtin_amdgcn_mfma_f32_32x32x16_bf16(PAF(0),VFR(0),o[0],0,0,0), C0,0); \
    GAPB(o[1]=__builtin_amdgcn_mfma_f32_32x32x16_bf16(PAF(0),VFR(4),o[1],0,0,0), C0,4); \
    KRD(GL,0); GAPB(o[0]=__builtin_amdgcn_mfma_f32_32x32x16_bf16(PAF(1),VFR(1),o[0],0,0,0), C0,8); \
    KRD(GL,1); GAPB(o[1]=__builtin_amdgcn_mfma_f32_32x32x16_bf16(PAF(1),VFR(5),o[1],0,0,0), C0,12); \
    KRD(GL,2); GAPB(o[0]=__builtin_amdgcn_mfma_f32_32x32x16_bf16(PAF(2),VFR(2),o[0],0,0,0), C1,0); \
    KRD(GL,3); GAPB(o[1]=__builtin_amdgcn_mfma_f32_32x32x16_bf16(PAF(2),VFR(6),o[1],0,0,0), C1,4); \
    GAPB(o[0]=__builtin_amdgcn_mfma_f32_32x32x16_bf16(PAF(3),VFR(3),o[0],0,0,0), C1,8); \
    GAPB(o[1]=__builtin_amdgcn_mfma_f32_32x32x16_bf16(PAF(3),VFR(7),o[1],0,0,0), C1,12); \
    }while(0)
  int t=1;
  #undef CMASK
  #define CMASK(P0,P1,t) do{}while(0)
  for(;t+7<NT;t+=2){
    STEP(pB0,pB1,pA0,pA1,t,true,true,true);     WAIT_BAR(2); RESC(); ROT();
    STEP(pA0,pA1,pB0,pB1,t+1,true,true,true);   WAIT_BAR(2); RESC(); ROT();
  }
  #undef CMASK
  #define CMASK(P0,P1,t) do{int jb_=(t)-(NT-4); if(jb_>=-2)cbm(P0,P1,jb_,qrel,hi,dtab);}while(0)
  #define ENDW(tt) do{ if((tt)+3<NT){WAIT_BAR(2);} else if((tt)+2<NT){WAIT_BAR(1);} else {WAIT_BAR(0);} }while(0)
  for(;t+1<NT;t+=2){
    STEP(pB0,pB1,pA0,pA1,t,(t+3<NT),(t+1<NT),(t+1<NT));       ENDW(t);   RESC(); ROT();
    STEP(pA0,pA1,pB0,pB1,t+1,(t+4<NT),(t+2<NT),(t+2<NT));     ENDW(t+1); RESC(); ROT();
  }
  STEP(pB0,pB1,pA0,pA1,NT-1,false,false,false); RESC();
  { float sacc=pB0[0]+pB0[1]; _Pragma("unroll") for(int r=2;r<16;++r)sacc+=pB0[r]; _Pragma("unroll") for(int r=0;r<16;++r)sacc+=pB1[r]; l_reg+=sacc;
    pw0=(u32x4){PKW(pB0,0),PKW(pB0,2),PKW(pB0,4),PKW(pB0,6)};pw1=(u32x4){PKW(pB0,8),PKW(pB0,10),PKW(pB0,12),PKW(pB0,14)};pw2=(u32x4){PKW(pB1,0),PKW(pB1,2),PKW(pB1,4),PKW(pB1,6)};pw3=(u32x4){PKW(pB1,8),PKW(pB1,10),PKW(pB1,12),PKW(pB1,14)};
    SBAR(); pv(o,vb0+sl_cur,PAF(0),PAF(1),PAF(2),PAF(3)); }
  #undef PKW
  #undef PAF
  #undef VFR
  #undef PIN
  #undef MX3
  #undef GAPA
  #undef GAPB
  #undef EX
  #undef VRD
  #undef KRD
  #undef STEP
  #undef ENDW
  {auto rr=__builtin_amdgcn_permlane32_swap(__float_as_uint(l_reg),__float_as_uint(l_reg),false,false);l_reg=__uint_as_float(rr[0])+__uint_as_float(rr[1]);}
  if(hi==0)wsf[32+r32]=l_reg;asm volatile("s_waitcnt lgkmcnt(0)":::"memory");
  float rli[16];
  #pragma unroll
  for(int r=0;r<16;++r)rli[r]=__builtin_amdgcn_rcpf(wsf[32+crow(r,hi)]);
  bf16*Ow=O+(rowbase+q0+wid*QBLK)*DM+hv*D;
  { bf16*stg=(bf16*)(shm+LDS_OST)+wid*2048;
    #pragma unroll
    for(int r=0;r<16;++r){const int orow=crow(r,hi);
      #pragma unroll
      for(int d0=0;d0<2;++d0)stg[orow*64+d0*32+r32]=__float2bfloat16(o[d0][r]*rli[r]);}
    asm volatile("s_waitcnt lgkmcnt(0)":::"memory");
    #pragma unroll
    for(int i=0;i<4;++i){const int row=i*8+(lane>>3),ch=lane&7; const u32x4 v=*(const u32x4*)(stg+row*64+ch*8); ATTN_STORE16(Ow+(long)row*DM+ch*8,v);} }
  asm volatile("s_waitcnt lgkmcnt(0)\n\ts_barrier":::"memory");
  #undef DMA_K
  #undef DMA_V
  #undef CMASK
  #undef START
  #undef RESC
  #undef ROT
}
constexpr int ATTN_LDS_BYTES=LDS_BYTES;
template<int THRL=8> __device__ __forceinline__ void attn_phase(char*lds,const bf16*Q,const bf16*K,const bf16*V,bf16*O12,const float*relb,int vcu,int G){
  for(int U=vcu;U<2048;U+=G){ const int i=U>>8,v=U&255,c6=(v>>3)+32*(i>>2),s=v&7,k=i&3; const int qb=(k==0)?s:(k==1)?15-s:(k==2)?16+s:31-s;
    const int b=c6>>5,comp=(c6>>4)&1,h=(c6>>1)&7,vh=c6&1;
    attn_unit<THRL>(b,comp*8+h,2*h+vh,qb,Q,K,V,O12+(long)comp*BATCH*SEQ*DM,relb,lds); }
}
#undef SBAR
#undef WAIT_BAR
}
#include <hip/hip_bf16.h>
#include <cmath>
#ifndef ATTN_PRIO
#define ATTN_PRIO 1
#endif
#if ATTN_PRIO == 1
#define APRIO(n) __builtin_amdgcn_s_setprio(n)
#else
#define APRIO(n) do{}while(0)
#endif
namespace attn128 {
using bf16=__hip_bfloat16;
using bf16x8=__attribute__((ext_vector_type(8)))short;
using s16x4=__attribute__((ext_vector_type(4)))short;
using f32x16=__attribute__((ext_vector_type(16)))float;
using u32x4=__attribute__((ext_vector_type(4)))unsigned;
constexpr int BATCH=2,NHEAD=16,SEQ=8192,D=64,DM=NHEAD*D;
constexpr int NW=8,QBLK=32,QB=QBLK*NW,KVBLK=64,NQB=SEQ/QB;
constexpr int ATTN_PITCH=DM, ATTN_UNIT_ROWS=QB;
__device__ __forceinline__ int crow(int r,int hi){return (r&3)+8*(r>>2)+4*hi;}
#define SBAR() __builtin_amdgcn_sched_barrier(0)
__device__ __forceinline__ void cmask(f32x16&p0,f32x16&p1,int jb,int qrel,int hi){
  const float NEG=-INFINITY; int kb=64*jb+4*hi;
  #pragma unroll
  for(int r=0;r<16;++r){int kv=kb+(r&3)+8*(r>>2); if(kv>qrel)p0[r]=NEG; if(kv+32>qrel)p1[r]=NEG;}
}

__device__ __forceinline__ void cbm(f32x16&p0,f32x16&p1,int jb,int qrel,int hi,const __attribute__((address_space(3))) float*dt){
  const float NEG=-INFINITY; const int nb=qrel-64*jb-4*hi;
  #pragma unroll
  for(int r=0;r<16;++r){const int n0=nb-((r&3)+8*(r>>2)),n1=n0-32; const float d0=dt[n0<0?0:n0],d1=dt[n1<0?0:n1];
    p0[r]=n0<0?NEG:p0[r]+d0; p1[r]=n1<0?NEG:p1[r]+d1;}
}

constexpr int NSLOT=3, SLOTB=8192, VSLOTB=16384;
constexpr int LDS_K=0, LDS_V=NSLOT*SLOTB, LDS_WS=LDS_V+NSLOT*VSLOTB, LDS_OST=LDS_WS+NW*64*4, LDS_DT=LDS_OST+NW*4096, LDS_BYTES=LDS_DT+512*4;
constexpr float C2=0.125f*1.4426950408889634f;
__device__ __forceinline__ void glds16(const void*gsrc,unsigned lds_dst){unsigned keep;
  asm volatile("s_mov_b32 %0, m0\n\ts_mov_b32 m0, %2\n\ts_nop 0\n\tglobal_load_lds_dwordx4 %1, off\n\ts_mov_b32 m0, %0":"=&s"(keep):"v"(gsrc),"s"(lds_dst):"memory");}
__device__ __forceinline__ float max3f(float a,float b,float c){float r;asm("v_max3_f32 %0, %1, %2, %3":"=v"(r):"v"(a),"v"(b),"v"(c));return r;}
__device__ __forceinline__ float max2f(float a,float b){float r;asm("v_max_f32_e32 %0, %1, %2":"=v"(r):"v"(a),"v"(b));return r;}
__device__ __forceinline__ float fadd_s(float a,float b){float r;asm("v_add_f32_e32 %0, %1, %2":"=v"(r):"v"(a),"v"(b));return r;}
__device__ __forceinline__ float fsub_s(float a,float b){float r;asm("v_sub_f32_e32 %0, %1, %2":"=v"(r):"v"(a),"v"(b));return r;}
typedef float f32x2_t __attribute__((ext_vector_type(2))); typedef float f32x4_t __attribute__((ext_vector_type(4))); typedef __bf16 bf16x2_t __attribute__((ext_vector_type(2)));
__device__ __forceinline__ unsigned cvtpk_s(float lo,float hi){f32x2_t v={lo,hi};bf16x2_t b=__builtin_convertvector(v,bf16x2_t);return __builtin_bit_cast(unsigned,b);}
#define WAIT_BAR(N) asm volatile("s_waitcnt vmcnt(" #N ") lgkmcnt(0)\n\ts_barrier":::"memory")

__device__ __forceinline__ void qkt(f32x16&p0,f32x16&p1,const char*Kslot,const bf16x8*qr,const f32x16&negm,int r32,int hi){
  const char*kb=Kslot+hi*1024+r32*16;
  #pragma unroll
  for(int d0=0;d0<4;++d0){
    const bf16x8 b0=*reinterpret_cast<const bf16x8*>(kb+d0*2048);
    const bf16x8 b1=*reinterpret_cast<const bf16x8*>(kb+d0*2048+512);
    if(d0==0){p0=__builtin_amdgcn_mfma_f32_32x32x16_bf16(b0,qr[0],negm,0,0,0);p1=__builtin_amdgcn_mfma_f32_32x32x16_bf16(b1,qr[0],negm,0,0,0);}
    else{p0=__builtin_amdgcn_mfma_f32_32x32x16_bf16(b0,qr[d0],p0,0,0,0);p1=__builtin_amdgcn_mfma_f32_32x32x16_bf16(b1,qr[d0],p1,0,0,0);}}
}
typedef __attribute__((address_space(3))) const char* lds_cptr;
typedef short v4i16_t __attribute__((ext_vector_type(4)));
__device__ __forceinline__ void kload8(bf16x8*kf,lds_cptr kp){
  kf[0]=*(const __attribute__((address_space(3))) bf16x8*)(kp);      kf[1]=*(const __attribute__((address_space(3))) bf16x8*)(kp+512);
  kf[2]=*(const __attribute__((address_space(3))) bf16x8*)(kp+2048); kf[3]=*(const __attribute__((address_space(3))) bf16x8*)(kp+2560);
  kf[4]=*(const __attribute__((address_space(3))) bf16x8*)(kp+4096); kf[5]=*(const __attribute__((address_space(3))) bf16x8*)(kp+4608);
  kf[6]=*(const __attribute__((address_space(3))) bf16x8*)(kp+6144); kf[7]=*(const __attribute__((address_space(3))) bf16x8*)(kp+6656);
}
__device__ __forceinline__ void kload2(bf16x8*kf,lds_cptr kp,int j){ kf[2*j]=*(const __attribute__((address_space(3))) bf16x8*)(kp+j*2048); kf[2*j+1]=*(const __attribute__((address_space(3))) bf16x8*)(kp+j*2048+512); }
__device__ __forceinline__ s16x4 vtr(lds_cptr p){ return __builtin_bit_cast(s16x4,__builtin_amdgcn_ds_read_tr16_b64_v4i16((__attribute__((address_space(3))) v4i16_t*)p)); }
__device__ __forceinline__ float rowmax(const f32x16&p0,const f32x16&p1){
  float a=max3f(p0[0],p0[1],p1[0]),b=max3f(p0[2],p0[3],p1[1]);a=max3f(a,p1[2],p1[3]);
  #pragma unroll
  for(int r=4;r<16;r+=4){a=max3f(a,p0[r],p0[r+1]);b=max3f(b,p0[r+2],p0[r+3]);a=max3f(a,p1[r],p1[r+1]);b=max3f(b,p1[r+2],p1[r+3]);}
  const float m=max2f(a,b);
  auto rr=__builtin_amdgcn_permlane32_swap(__float_as_uint(m),__float_as_uint(m),false,false);
  return max2f(__uint_as_float(rr[0]),__uint_as_float(rr[1]));
}
__device__ __forceinline__ void pv(f32x16*o,int vb,bf16x8 pa0,bf16x8 pa1,bf16x8 pa2,bf16x8 pa3){
  #pragma unroll
  for(int d0=0;d0<4;++d0){s16x4 lo[4],hi[4];
    #pragma unroll
    for(int ks=0;ks<4;++ks){
      asm volatile("ds_read_b64_tr_b16 %0,%1 offset:%c2":"=&v"(lo[ks]):"v"(vb),"i"(d0*4096+ks*1024):"memory");
      asm volatile("ds_read_b64_tr_b16 %0,%1 offset:%c2":"=&v"(hi[ks]):"v"(vb),"i"(d0*4096+ks*1024+512):"memory");}
    asm volatile("s_waitcnt lgkmcnt(0)":::"memory");SBAR();
    #define PK(k) (bf16x8){lo[k][0],lo[k][1],lo[k][2],lo[k][3],hi[k][0],hi[k][1],hi[k][2],hi[k][3]}
    o[d0]=__builtin_amdgcn_mfma_f32_32x32x16_bf16(pa0,PK(0),o[d0],0,0,0);
    o[d0]=__builtin_amdgcn_mfma_f32_32x32x16_bf16(pa1,PK(1),o[d0],0,0,0);
    o[d0]=__builtin_amdgcn_mfma_f32_32x32x16_bf16(pa2,PK(2),o[d0],0,0,0);
    o[d0]=__builtin_amdgcn_mfma_f32_32x32x16_bf16(pa3,PK(3),o[d0],0,0,0);
    #undef PK
  }
}

#ifndef ATTN_STORE16
#define ATTN_STORE16(p,v) pg8::st16((void*)(p),(v))
#endif
template<int THRL,int MODE> __device__ __forceinline__ void attn_unit(int b,int hq,int vcol,int qb,const bf16*Q,const bf16*__restrict__ K,const bf16*__restrict__ V,bf16*O,bf16*Uo,const float*__restrict__ sg,float lam,float oscale,const float*__restrict__ relb,char*shm){
  int tid_=threadIdx.x; asm volatile("":"+v"(tid_));
  const int tid=tid_,lane=tid&63,r32=lane&31,hi=lane>>5; const int wid=__builtin_amdgcn_readfirstlane(tid>>6);
  const long rowbase=(long)b*SEQ; const int q0=qb*QB;
  const bf16*Qw=Q+(rowbase+q0+wid*QBLK)*DM+hq*D;
  const bf16*Kh=K+rowbase*DM+hq*D,*Vh=V+rowbase*DM+vcol;
  const lds_cptr shm3=(lds_cptr)shm;
  const unsigned lds0=(unsigned)(uintptr_t)shm;
  float*wsf=(float*)(shm+LDS_WS)+wid*64;
  const bf16*ksrc=Kh+(long)lane*DM+wid*8;
  const bf16*vsrc=Vh+(long)(16*(wid&3)+(lane>>2))*DM+(wid>>2)*32+(lane&3)*8;
  const unsigned kdst=lds0+LDS_K+wid*1024, vdst=lds0+LDS_V+wid*1024;
  #define DMA_K(t,slot) glds16(ksrc+(long)(t)*KVBLK*DM,(unsigned)__builtin_amdgcn_readfirstlane(kdst+(slot)))
  #define DMA_V(t,slot) do{ glds16(vsrc+(long)(t)*KVBLK*DM,(unsigned)__builtin_amdgcn_readfirstlane(vdst+2*(slot))); glds16(vsrc+(long)(t)*KVBLK*DM+64,(unsigned)__builtin_amdgcn_readfirstlane(vdst+2*(slot)+8192)); }while(0)
  const int vb0=(int)(lds0+LDS_V)+((lane>>4)&1)*32+(lane&3)*8+(4*hi+((lane&15)>>2))*64;
  const char*Kbase=shm+LDS_K; bf16x8 kf[8];
  const lds_cptr kp0=shm3+LDS_K+hi*1024+r32*16; const lds_cptr vp0=shm3+LDS_V+((lane>>4)&1)*32+(lane&3)*8+(4*hi+((lane&15)>>2))*64;
  const int NT=(q0+QB)/KVBLK;
  const __attribute__((address_space(3))) float*dtab=(const __attribute__((address_space(3))) float*)(shm3+LDS_DT);
  { const int h8=hq&7; const float bfar=relb[31*8+h8]; const float dv=(tid<113)?(relb[(int)c_bucket[tid<128?tid:0]*8+h8]-bfar)*1.4426950408889634f:0.f;
    ((__attribute__((address_space(3))) float*)(shm3+LDS_DT))[tid]=dv; }
  if(ATTN_PRIO==2){ if(wid>=4)__builtin_amdgcn_s_setprio(1); }
  DMA_K(0,0);DMA_V(0,0);DMA_K(1,SLOTB);
  bf16x8 qr[4];
  #pragma unroll
  for(int d0=0;d0<4;++d0)qr[d0]=*reinterpret_cast<const bf16x8*>(&Qw[(long)r32*DM+d0*16+hi*8]);
  { __attribute__((address_space(3))) bf16x8*qst=(__attribute__((address_space(3))) bf16x8*)(shm3+LDS_OST+wid*4096)+lane;
    _Pragma("unroll") for(int d0=0;d0<4;++d0)qst[d0*64]=qr[d0]; }
  const __attribute__((address_space(3))) bf16x8*qlp=(const __attribute__((address_space(3))) bf16x8*)(shm3+LDS_OST+wid*4096)+lane;
  #define QLD(d0) (qlp[(d0)*64])
  float mhat=0.f,l_reg=0.f;f32x16 o[4];o[0]=f32x16{};o[1]=f32x16{};o[2]=f32x16{};o[3]=f32x16{};const f32x16 zero16=f32x16{};
  const int qrel=wid*QBLK+r32;
  #define CMASK(P0,P1,t) do{int jb_=(t)-(NT-4); if(jb_>=-2)cbm(P0,P1,jb_,qrel,hi,dtab);}while(0)
  bool resc=false;
  #define START(P0,P1) do{ const float rm=rowmax(P0,P1); resc=false; \
    { const float dl=rm; mhat=fadd_s(mhat,dl); \
      _Pragma("unroll") for(int r=0;r<16;++r){P0[r]=fsub_s(P0[r],dl);P1[r]=fsub_s(P1[r],dl);} \
      } \
    _Pragma("unroll") for(int r=0;r<16;++r)P0[r]=__builtin_amdgcn_exp2f(P0[r]); }while(0)
  #define RESC() do{ if(resc){ asm volatile("s_waitcnt lgkmcnt(0)":::"memory"); \
      _Pragma("unroll") for(int d_=0;d_<4;++d_) _Pragma("unroll") for(int r=0;r<16;++r)o[d_][r]*=wsf[crow(r,hi)]; } }while(0)
  f32x16 pA0,pA1,pB0,pB1;
  int sl_prev=0,sl_cur=0,sl_next=SLOTB;
  #define ROT() do{sl_prev=sl_cur;sl_cur=sl_next;sl_next=(sl_next==(NSLOT-1)*SLOTB)?0:sl_next+SLOTB;}while(0)
  DMA_K(2,2*SLOTB);
  WAIT_BAR(3);
  qkt(pA0,pA1,Kbase,qr,zero16,r32,hi);asm volatile("s_nop 15\n\ts_nop 7":"+v"(pA0),"+v"(pA1));CMASK(pA0,pA1,0);
  START(pA0,pA1);
  _Pragma("unroll") for(int r=0;r<16;++r)pA1[r]=__builtin_amdgcn_exp2f(pA1[r]);
  WAIT_BAR(0);
  DMA_K(3,0);DMA_V(1,SLOTB);
  ROT();
  kload8(kf,kp0+sl_cur);
  WAIT_BAR(3);
  s16x4 vlo[8],vhi[8]; u32x4 pw0,pw1,pw2,pw3;
  #define PKW(P,B) cvtpk_s(P[B],P[B+1])
  #define PAF(k) __builtin_bit_cast(bf16x8,pw##k)
  #define VFR(i) (bf16x8){vlo[i][0],vlo[i][1],vlo[i][2],vlo[i][3],vhi[i][0],vhi[i][1],vhi[i][2],vhi[i][3]}
  #define PIN(x) asm volatile("":"+v"(x))
  #define MX3(a,b,c) __builtin_fmaxf(__builtin_fmaxf((a),(b)),(c))
  #define GAPA(MF,A0,A1,A2,A3,W0,W1,PW) do{ MF; sacc+=A0; sacc+=A1; sacc+=A2; sacc+=A3; PIN(sacc); W0; W1; PIN(PW); SBAR(); }while(0)
  #define EX(v) __builtin_amdgcn_exp2f(v)
  #define GAPM(MF,...) do{ MF; __VA_ARGS__; PIN(mxa); PIN(mxb); SBAR(); }while(0)
  #define EXE(X0,X1,i) do{ if((i)<16) X0[(i)&15]=EX(X0[(i)&15]); else X1[(i)&15]=EX(X1[(i)&15]); }while(0)
  #define GAPX(MFX,OD,X0,X1,i0,i1,i2) do{ OD=MFX; EXE(X0,X1,i0); EXE(X0,X1,i1); if((i2)!=(i1)) EXE(X0,X1,i2); PIN(X0); PIN(X1); SBAR(); }while(0)
  #define VRL(j,i) do{ vlo[j]=vtr(vp_+(((i)>>2)*4096+((i)&3)*1024)); vhi[j]=vtr(vp_+(((i)>>2)*4096+((i)&3)*1024+512)); SBAR(); }while(0)
  #define VRD(i) do{ vlo[i]=vtr(vp_+(((i)>>2)*4096+((i)&3)*1024)); vhi[i]=vtr(vp_+(((i)>>2)*4096+((i)&3)*1024+512)); }while(0)
  #define KRD(G,j) do{ if(G){ kload2(kf,kp0+sl_next,j); SBAR(); } }while(0)
  #define STEP(C0,C1,P0,P1,t,GK,GV,GL) do{ SBAR(); APRIO(1); \
    const lds_cptr vp_=vp0+2*sl_prev; \
    { const float nm_=-mhat; _Pragma("unroll") for(int r=0;r<16;++r){C0[r]=nm_;C1[r]=nm_;} } \
    VRD(0); SBAR(); float sacc=(P0[0]+P0[1]); \
    GAPA(C0=__builtin_amdgcn_mfma_f32_32x32x16_bf16(kf[0],qfa,C0,0,0,0), P0[2],P0[3],P0[4],P0[5],     pw0[0]=PKW(P0,0), pw0[1]=PKW(P0,2), pw0); \
    VRD(4); SBAR(); GAPA(C1=__builtin_amdgcn_mfma_f32_32x32x16_bf16(kf[1],qfa,C1,0,0,0), P0[6],P0[7],P0[8],P0[9],     pw0[2]=PKW(P0,4), pw0[3]=PKW(P0,6), pw0); \
    qfa=QLD(2); VRD(1); SBAR(); GAPA(C0=__builtin_amdgcn_mfma_f32_32x32x16_bf16(kf[2],qfb,C0,0,0,0),   P0[10],P0[11],P0[12],P0[13], pw1[0]=PKW(P0,8), pw1[1]=PKW(P0,10), pw1); \
    VRD(5); SBAR(); GAPA(C1=__builtin_amdgcn_mfma_f32_32x32x16_bf16(kf[3],qfb,C1,0,0,0),   P0[14],P0[15],P1[0],P1[1],   pw1[2]=PKW(P0,12),pw1[3]=PKW(P0,14), pw1); \
    qfb=QLD(3); VRD(2); SBAR(); GAPA(C0=__builtin_amdgcn_mfma_f32_32x32x16_bf16(kf[4],qfa,C0,0,0,0),   P1[2],P1[3],P1[4],P1[5],     pw2[0]=PKW(P1,0), pw2[1]=PKW(P1,2), pw2); \
    VRD(6); SBAR(); GAPA(C1=__builtin_amdgcn_mfma_f32_32x32x16_bf16(kf[5],qfa,C1,0,0,0),   P1[6],P1[7],P1[8],P1[9],     pw2[2]=PKW(P1,4), pw2[3]=PKW(P1,6), pw2); \
    qfa=QLD(0); VRD(3); SBAR(); GAPA(C0=__builtin_amdgcn_mfma_f32_32x32x16_bf16(kf[6],qfb,C0,0,0,0),   P1[10],P1[11],P1[12],P1[13], pw3[0]=PKW(P1,8), pw3[1]=PKW(P1,10), pw3); \
    VRD(7); SBAR(); GAPA(C1=__builtin_amdgcn_mfma_f32_32x32x16_bf16(kf[7],qfb,C1,0,0,0),   P1[14],P1[15],0.f,0.f,       pw3[2]=PKW(P1,12),pw3[3]=PKW(P1,14), pw3); \
    qfb=QLD(1); l_reg+=sacc; \
    if(GK){DMA_K((t)+3,sl_cur);} if(GV){DMA_V((t)+1,sl_next);} \
    CMASK(C0,C1,t); \
    SBAR(); float mxa,mxb; \
    GAPM(o[0]=__builtin_amdgcn_mfma_f32_32x32x16_bf16(PAF(0),VFR(0),o[0],0,0,0), mxa=MX3(C0[0],C0[1],C1[0]); mxb=MX3(C0[2],C0[3],C1[1]); mxa=MX3(mxa,C1[2],C1[3]); mxa=MX3(mxa,C0[4],C0[5]));  VRL(0,8); \
    GAPM(o[1]=__builtin_amdgcn_mfma_f32_32x32x16_bf16(PAF(0),VFR(4),o[1],0,0,0), mxb=MX3(mxb,C0[6],C0[7]); mxa=MX3(mxa,C1[4],C1[5]); mxb=MX3(mxb,C1[6],C1[7]); mxa=MX3(mxa,C0[8],C0[9]));  VRL(4,12); \
    KRD(GL,0); GAPM(o[0]=__builtin_amdgcn_mfma_f32_32x32x16_bf16(PAF(1),VFR(1),o[0],0,0,0), mxb=MX3(mxb,C0[10],C0[11]); mxa=MX3(mxa,C1[8],C1[9]); mxb=MX3(mxb,C1[10],C1[11]); mxa=MX3(mxa,C0[12],C0[13]));  VRL(1,9); \
    KRD(GL,1); GAPM(o[1]=__builtin_amdgcn_mfma_f32_32x32x16_bf16(PAF(1),VFR(5),o[1],0,0,0), mxb=MX3(mxb,C0[14],C0[15]); mxa=MX3(mxa,C1[12],C1[13]); mxb=MX3(mxb,C1[14],C1[15]));  VRL(5,13); \
    { float rm=__builtin_fmaxf(mxa,mxb); { auto rr=__builtin_amdgcn_permlane32_swap(__float_as_uint(rm),__float_as_uint(rm),false,false); rm=__builtin_fmaxf(__uint_as_float(rr[0]),__uint_as_float(rr[1])); } \
      resc=false; \
      if(__builtin_expect(__any(rm>(float)THRL),0)){ const float dl=__builtin_fmaxf(rm,0.f); mhat+=dl; \
        _Pragma("unroll") for(int r=0;r<16;++r){C0[r]-=dl;C1[r]-=dl;} \
        const float f=__builtin_amdgcn_exp2f(-dl); l_reg*=f; if(hi==0)wsf[r32]=f; resc=true; } } \
    SBAR(); \
    KRD(GL,2); GAPX(__builtin_amdgcn_mfma_f32_32x32x16_bf16(PAF(2),VFR(2),o[0],0,0,0),o[0],C0,C1, 0,1,2);     VRL(2,10); \
    KRD(GL,3); GAPX(__builtin_amdgcn_mfma_f32_32x32x16_bf16(PAF(2),VFR(6),o[1],0,0,0),o[1],C0,C1, 3,4,5);     VRL(6,14); \
    GAPX(__builtin_amdgcn_mfma_f32_32x32x16_bf16(PAF(3),VFR(3),o[0],0,0,0),o[0],C0,C1, 6,7,8);     VRL(3,11); \
    GAPX(__builtin_amdgcn_mfma_f32_32x32x16_bf16(PAF(3),VFR(7),o[1],0,0,0),o[1],C0,C1, 9,10,11);   VRL(7,15); \
    GAPX(__builtin_amdgcn_mfma_f32_32x32x16_bf16(PAF(0),VFR(0),o[2],0,0,0),o[2],C0,C1, 12,13,14); \
    GAPX(__builtin_amdgcn_mfma_f32_32x32x16_bf16(PAF(0),VFR(4),o[3],0,0,0),o[3],C0,C1, 15,16,17); \
    GAPX(__builtin_amdgcn_mfma_f32_32x32x16_bf16(PAF(1),VFR(1),o[2],0,0,0),o[2],C0,C1, 18,19,20); \
    GAPX(__builtin_amdgcn_mfma_f32_32x32x16_bf16(PAF(1),VFR(5),o[3],0,0,0),o[3],C0,C1, 21,22,23); \
    GAPX(__builtin_amdgcn_mfma_f32_32x32x16_bf16(PAF(2),VFR(2),o[2],0,0,0),o[2],C0,C1, 24,25,25); \
    GAPX(__builtin_amdgcn_mfma_f32_32x32x16_bf16(PAF(2),VFR(6),o[3],0,0,0),o[3],C0,C1, 26,27,27); \
    GAPX(__builtin_amdgcn_mfma_f32_32x32x16_bf16(PAF(3),VFR(3),o[2],0,0,0),o[2],C0,C1, 28,29,29); \
    GAPX(__builtin_amdgcn_mfma_f32_32x32x16_bf16(PAF(3),VFR(7),o[3],0,0,0),o[3],C0,C1, 30,31,31); APRIO(0); \
    }while(0)
  bf16x8 qfa=QLD(0),qfb=QLD(1);
  int t=1;
  #undef CMASK
  #define CMASK(P0,P1,t) do{}while(0)
  for(;t+7<NT;t+=2){
    STEP(pB0,pB1,pA0,pA1,t,true,true,true);     WAIT_BAR(3); RESC(); ROT();
    STEP(pA0,pA1,pB0,pB1,t+1,true,true,true);   WAIT_BAR(3); RESC(); ROT();
  }
  #undef CMASK
  #define CMASK(P0,P1,t) do{int jb_=(t)-(NT-4); if(jb_>=-2)cbm(P0,P1,jb_,qrel,hi,dtab);}while(0)
  #define ENDW(tt) do{ if((tt)+3<NT){WAIT_BAR(3);} else if((tt)+2<NT){WAIT_BAR(2);} else {WAIT_BAR(0);} }while(0)
  for(;t+1<NT;t+=2){
    STEP(pB0,pB1,pA0,pA1,t,(t+3<NT),(t+1<NT),(t+1<NT));       ENDW(t);   RESC(); ROT();
    STEP(pA0,pA1,pB0,pB1,t+1,(t+4<NT),(t+2<NT),(t+2<NT));     ENDW(t+1); RESC(); ROT();
  }
  STEP(pB0,pB1,pA0,pA1,NT-1,false,false,false); RESC();
  { float sacc=pB0[0]+pB0[1]; _Pragma("unroll") for(int r=2;r<16;++r)sacc+=pB0[r]; _Pragma("unroll") for(int r=0;r<16;++r)sacc+=pB1[r]; l_reg+=sacc;
    pw0=(u32x4){PKW(pB0,0),PKW(pB0,2),PKW(pB0,4),PKW(pB0,6)};pw1=(u32x4){PKW(pB0,8),PKW(pB0,10),PKW(pB0,12),PKW(pB0,14)};pw2=(u32x4){PKW(pB1,0),PKW(pB1,2),PKW(pB1,4),PKW(pB1,6)};pw3=(u32x4){PKW(pB1,8),PKW(pB1,10),PKW(pB1,12),PKW(pB1,14)};
    SBAR(); pv(o,vb0+2*sl_cur,PAF(0),PAF(1),PAF(2),PAF(3)); }
  #undef PKW
  #undef PAF
  #undef VFR
  #undef PIN
  #undef MX3
  #undef GAPA
  #undef GAPM
  #undef GAPX
  #undef EXE
  #undef VRL
  #undef EX
  #undef VRD
  #undef KRD
  #undef STEP
  #undef ENDW
  if(ATTN_PRIO==2)__builtin_amdgcn_s_setprio(0);
  {auto rr=__builtin_amdgcn_permlane32_swap(__float_as_uint(l_reg),__float_as_uint(l_reg),false,false);l_reg=__uint_as_float(rr[0])+__uint_as_float(rr[1]);}
  if(hi==0)wsf[32+r32]=l_reg;asm volatile("s_waitcnt lgkmcnt(0)":::"memory");
  float rli[16];
  #pragma unroll
  for(int r=0;r<16;++r)rli[r]=__builtin_amdgcn_rcpf(wsf[32+crow(r,hi)]);
  bf16*Ow=O+(rowbase+q0+wid*QBLK)*DM+vcol;
  { bf16*stg=(bf16*)(shm+LDS_OST)+wid*2048;
    float dd[2][4][8]; float ss[4]={0.f,0.f,0.f,0.f};
    #pragma unroll
    for(int hf=0;hf<2;++hf){
      #pragma unroll
      for(int r=0;r<16;++r){const int orow=crow(r,hi);
        #pragma unroll
        for(int d0=0;d0<2;++d0)stg[orow*64+d0*32+r32]=__float2bfloat16(o[2*hf+d0][r]*rli[r]);}
      asm volatile("s_waitcnt lgkmcnt(0)":::"memory");
      #pragma unroll
      for(int i=0;i<4;++i){const int row=i*8+(lane>>3),ch=lane&7; const u32x4 v=*(const u32x4*)(stg+row*64+ch*8);
        if constexpr(MODE==0){ ATTN_STORE16(Ow+(long)row*DM+hf*64+ch*8,v); }
        else { const u32x4 v1=*(const u32x4*)(Ow+(long)row*DM+hf*64+ch*8);
          #pragma unroll
          for(int k=0;k<4;++k){ const float a0=__uint_as_float(v1[k]<<16),a1=__uint_as_float(v1[k]&0xffff0000u),b0=__uint_as_float(v[k]<<16),b1=__uint_as_float(v[k]&0xffff0000u);
            const float e0=a0-lam*b0,e1=a1-lam*b1; dd[hf][i][2*k]=e0; dd[hf][i][2*k+1]=e1; ss[i]+=e0*e0+e1*e1; } } }
      asm volatile("s_waitcnt lgkmcnt(0)":::"memory"); }
    if constexpr(MODE==1){
      bf16*Uw=Uo+(rowbase+q0+wid*QBLK)*DM+vcol;
      #pragma unroll
      for(int i=0;i<4;++i){ float t=ss[i]; t+=__shfl_xor(t,1); t+=__shfl_xor(t,2); t+=__shfl_xor(t,4); ss[i]=oscale/sqrtf(t*(1.0f/128.0f)+1e-5f); }
      #pragma unroll
      for(int hf=0;hf<2;++hf){ const int ch=lane&7; const f32x4_t g0=*(const f32x4_t*)(sg+hf*64+ch*8),g1=*(const f32x4_t*)(sg+hf*64+ch*8+4);
        #pragma unroll
        for(int i=0;i<4;++i){ const int row=i*8+(lane>>3); const float rs=ss[i]; u32x4 w;
          w[0]=cvtpk_s(dd[hf][i][0]*rs*g0[0],dd[hf][i][1]*rs*g0[1]); w[1]=cvtpk_s(dd[hf][i][2]*rs*g0[2],dd[hf][i][3]*rs*g0[3]);
          w[2]=cvtpk_s(dd[hf][i][4]*rs*g1[0],dd[hf][i][5]*rs*g1[1]); w[3]=cvtpk_s(dd[hf][i][6]*rs*g1[2],dd[hf][i][7]*rs*g1[3]);
          ATTN_STORE16(Uw+(long)row*DM+hf*64+ch*8,w); } } } }
  asm volatile("s_waitcnt lgkmcnt(0)\n\ts_barrier":::"memory");
  #undef DMA_K
  #undef DMA_V
  #undef CMASK
  #undef START
  #undef RESC
  #undef ROT
  #undef QLD
}
constexpr int ATTN_LDS_BYTES=LDS_BYTES;
template<int THRL=8> __device__ __forceinline__ void attn_phase(char*lds,const bf16*Q,const bf16*K,const bf16*V,bf16*O1buf,bf16*U,const float*sg,float lam,float oscale,const float*relb,int vcu,int G){
  for(int X=vcu;X<512;X+=G){ const int i=X>>8,v=X&255,bh=v>>4,s=v&15; const int qb=(i==0)?s:31-s; const int b=bh>>3,h=bh&7;
    attn_unit<THRL,0>(b,h,h*128,qb,Q,K,V,O1buf,U,sg,lam,oscale,relb,lds);
    attn_unit<THRL,1>(b,8+h,h*128,qb,Q,K,V,O1buf,U,sg,lam,oscale,relb,lds); }
}
#undef SBAR
#undef WAIT_BAR
}
#include <hip/hip_bf16.h>
#include <cmath>
#ifndef ATTN_PRIO
#define ATTN_PRIO 1
#endif
#if ATTN_PRIO == 1
#define APRIO(n) __builtin_amdgcn_s_setprio(n)
#else
#define APRIO(n) do{}while(0)
#endif
namespace attn8 {
using bf16=__hip_bfloat16;
using bf16x8=__attribute__((ext_vector_type(8)))short;
using s16x4=__attribute__((ext_vector_type(4)))short;
using f32x16=__attribute__((ext_vector_type(16)))float;
using u32x4=__attribute__((ext_vector_type(4)))unsigned;
constexpr int BATCH=2,NHEAD=16,SEQ=8192,D=64,DM=NHEAD*D;
constexpr int NW=8,QBLK=32,QB=QBLK*NW,KVBLK=64,NQB=SEQ/QB;
constexpr int ATTN_PITCH=DM, ATTN_UNIT_ROWS=QB;
__device__ __forceinline__ int crow(int r,int hi){return (r&3)+8*(r>>2)+4*hi;}
#define SBAR() __builtin_amdgcn_sched_barrier(0)
__device__ __forceinline__ void cmask(f32x16&p0,f32x16&p1,int jb,int qrel,int hi){
  const float NEG=-INFINITY; int kb=64*jb+4*hi;
  #pragma unroll
  for(int r=0;r<16;++r){int kv=kb+(r&3)+8*(r>>2); if(kv>qrel)p0[r]=NEG; if(kv+32>qrel)p1[r]=NEG;}
}

__device__ __forceinline__ void cbm(f32x16&p0,f32x16&p1,int jb,int qrel,int hi,const __attribute__((address_space(3))) float*dt){
  const float NEG=-INFINITY; const int nb=qrel-64*jb-4*hi;
  #pragma unroll
  for(int r=0;r<16;++r){const int n0=nb-((r&3)+8*(r>>2)),n1=n0-32; const float d0=dt[n0<0?0:n0],d1=dt[n1<0?0:n1];
    p0[r]=n0<0?NEG:p0[r]+d0; p1[r]=n1<0?NEG:p1[r]+d1;}
}

constexpr int NSLOT=3, SLOTB=4096, VSLOTB=8192;
constexpr int LDS_K=0, LDS_V=NSLOT*SLOTB, LDS_WS=LDS_V+NSLOT*VSLOTB, LDS_OST=LDS_WS+NW*64*4, LDS_DT=LDS_OST+NW*4096, LDS_BYTES=LDS_DT+512*4;
constexpr float C2=0.125f*1.4426950408889634f;
__device__ __forceinline__ void glds16(const void*gsrc,unsigned lds_dst){unsigned keep;
  asm volatile("s_mov_b32 %0, m0\n\ts_mov_b32 m0, %2\n\ts_nop 0\n\tglobal_load_lds_dwordx4 %1, off\n\ts_mov_b32 m0, %0":"=&s"(keep):"v"(gsrc),"s"(lds_dst):"memory");}
__device__ __forceinline__ float max3f(float a,float b,float c){float r;asm("v_max3_f32 %0, %1, %2, %3":"=v"(r):"v"(a),"v"(b),"v"(c));return r;}
__device__ __forceinline__ float max2f(float a,float b){float r;asm("v_max_f32_e32 %0, %1, %2":"=v"(r):"v"(a),"v"(b));return r;}
__device__ __forceinline__ float fadd_s(float a,float b){float r;asm("v_add_f32_e32 %0, %1, %2":"=v"(r):"v"(a),"v"(b));return r;}
__device__ __forceinline__ float fsub_s(float a,float b){float r;asm("v_sub_f32_e32 %0, %1, %2":"=v"(r):"v"(a),"v"(b));return r;}
typedef float f32x2_t __attribute__((ext_vector_type(2))); typedef float f32x4_t __attribute__((ext_vector_type(4))); typedef __bf16 bf16x2_t __attribute__((ext_vector_type(2)));
__device__ __forceinline__ unsigned cvtpk_s(float lo,float hi){f32x2_t v={lo,hi};bf16x2_t b=__builtin_convertvector(v,bf16x2_t);return __builtin_bit_cast(unsigned,b);}
#define WAIT_BAR(N) asm volatile("s_waitcnt vmcnt(" #N ") lgkmcnt(0)\n\ts_barrier":::"memory")

typedef int v8i32 __attribute__((ext_vector_type(8))); typedef int v4i32 __attribute__((ext_vector_type(4)));
typedef __attribute__((address_space(3))) const char* lds_cptr;
#ifndef ATTN8_PRIO
#define ATTN8_PRIO 1
#endif
#if ATTN8_PRIO
#define A8PRIO(n) __builtin_amdgcn_s_setprio(n)
#else
#define A8PRIO(n) do{}while(0)
#endif
#define SC1 0
#define SC8 0
__device__ __forceinline__ v8i32 ld32(lds_cptr p,int step){ const v4i32 a=*(const __attribute__((address_space(3))) v4i32*)p, b=*(const __attribute__((address_space(3))) v4i32*)(p+step); return (v8i32){a[0],a[1],a[2],a[3],b[0],b[1],b[2],b[3]}; }
__device__ __forceinline__ void cbm4(f32x16&p0,f32x16&p1,int jb,int qrel,int hi,const __attribute__((address_space(3))) float*dt){
  const float NEG=-INFINITY; const int nb=qrel-64*jb-4*hi;
  #pragma unroll
  for(int g=0;g<4;++g){
    #pragma unroll
    for(int r=4*g;r<4*g+4;++r){const int n0=nb-((r&3)+8*(r>>2)),n1=n0-32; const float d0=dt[n0<0?0:n0],d1=dt[n1<0?0:n1];
      p0[r]=n0<0?NEG:p0[r]+d0; p1[r]=n1<0?NEG:p1[r]+d1;}
    asm volatile("":::"memory"); }
}
__device__ __forceinline__ unsigned pk8(float a,float b,float c,float d){ unsigned w=__builtin_amdgcn_cvt_pk_fp8_f32(a,b,0,false); return __builtin_amdgcn_cvt_pk_fp8_f32(c,d,w,true); }
__device__ __forceinline__ int pk8o(int old,float a,float b,float c,float d){ int w=__builtin_amdgcn_cvt_pk_fp8_f32(a,b,old,false); return __builtin_amdgcn_cvt_pk_fp8_f32(c,d,w,true); }
typedef float f32x2v __attribute__((ext_vector_type(2)));
#define PAIR2(X,i) ((f32x2v){X[2*(i)],X[2*(i)+1]})
__device__ __forceinline__ float rowmax(const f32x16&p0,const f32x16&p1){
  float a=max3f(p0[0],p0[1],p1[0]),b=max3f(p0[2],p0[3],p1[1]);a=max3f(a,p1[2],p1[3]);
  #pragma unroll
  for(int r=4;r<16;r+=4){a=max3f(a,p0[r],p0[r+1]);b=max3f(b,p0[r+2],p0[r+3]);a=max3f(a,p1[r],p1[r+1]);b=max3f(b,p1[r+2],p1[r+3]);}
  const float m=max2f(a,b);
  auto rr=__builtin_amdgcn_permlane32_swap(__float_as_uint(m),__float_as_uint(m),false,false);
  return max2f(__uint_as_float(rr[0]),__uint_as_float(rr[1]));
}
#ifndef ATTN_STORE16
#define ATTN_STORE16(p,v) pg8::st16((void*)(p),(v))
#endif
template<int THRL,int MODE> __device__ __forceinline__ void attn_unit(int b,int hq,int vcol,int qb,const unsigned char*Q8,const unsigned char*__restrict__ K8,const unsigned char*__restrict__ VT8,bf16*O,bf16*Uo,const float*__restrict__ sg,float lam,float oscale,const float*__restrict__ relb,char*shm){
  int tid_=threadIdx.x; asm volatile("":"+v"(tid_));
  const int tid=tid_,lane=tid&63,r32=lane&31,hi=lane>>5; const int wid=__builtin_amdgcn_readfirstlane(tid>>6);
  const long rowbase=(long)b*SEQ; const int q0=qb*QB;
  const lds_cptr shm3=(lds_cptr)shm;
  const unsigned lds0=(unsigned)(uintptr_t)shm;
  float*wsf=(float*)(shm+LDS_WS)+wid*64;
  const unsigned char*ksrc=K8+(rowbase+lane)*(long)DM+hq*64+(wid&3)*16;
  const unsigned char*vsrc=VT8+(long)(vcol+64*(wid&1)+lane)*(BATCH*SEQ)+rowbase+(wid>>1)*16;
  const unsigned kdst=lds0+LDS_K+(wid&3)*1024, vdst=lds0+LDS_V+wid*1024;
  #define DMA_K(t,slot) glds16(ksrc+(long)(t)*KVBLK*DM,(unsigned)__builtin_amdgcn_readfirstlane(kdst+(slot)))
  #define DMA_V(t,slot) glds16(vsrc+(long)(t)*KVBLK,(unsigned)__builtin_amdgcn_readfirstlane(vdst+2*(slot)))
  #define WAIT_KV(NK,NV) WAIT_BAR(NK)
  const lds_cptr kp0=shm3+LDS_K+(2*hi)*1024+r32*16;
  const lds_cptr vp0=shm3+LDS_V+(2*hi)*2048+r32*16;
  const int NT=(q0+QB)/KVBLK;
  const __attribute__((address_space(3))) float*dtab=(const __attribute__((address_space(3))) float*)(shm3+LDS_DT);
  { const int h8=hq&7; const float bfar=relb[31*8+h8]; const float dv=(tid<113)?(relb[(int)c_bucket[tid<128?tid:0]*8+h8]-bfar)*1.4426950408889634f:0.f;
    ((__attribute__((address_space(3))) float*)(shm3+LDS_DT))[tid]=dv; }
  DMA_K(0,0);DMA_V(0,0);DMA_K(1,SLOTB);
  v8i32 qf; { const unsigned char*qp=Q8+(rowbase+q0+wid*QBLK+r32)*(long)DM+hq*64+32*hi; const v4i32 a=*(const v4i32*)qp,bq=*(const v4i32*)(qp+16); qf=(v8i32){a[0],a[1],a[2],a[3],bq[0],bq[1],bq[2],bq[3]}; }
  float mhat=0.f;f32x16 o[4];
  f32x16 o4;
  int c1_=0x38383838; asm volatile("":"+v"(c1_));
  #define ones ((v8i32){c1_,c1_,c1_,c1_,c1_,c1_,c1_,c1_})
  const int qrel=wid*QBLK+r32;
  #define CMASK(P0,P1,t) do{int jb_=(t)-(NT-4); if(jb_>=-2)cbm4(P0,P1,jb_,qrel,hi,dtab);}while(0)
  bool resc=false;
  #define RESC() do{ if(resc){ asm volatile("s_waitcnt lgkmcnt(0)":::"memory"); \
      _Pragma("unroll") for(int r=0;r<16;++r){ const float f_=wsf[crow(r,hi)]; o[0][r]*=f_;o[1][r]*=f_;o[2][r]*=f_;o[3][r]*=f_;o4[r]*=f_; } } }while(0)
  f32x16 pA0,pA1;
  v8i32 vf[4]; v8i32 pw={0,0,0,0,0,0,0,0};
  int sl_prev=0,sl_cur=0,sl_next=SLOTB;
  #define ROT() do{sl_prev=sl_cur;sl_cur=sl_next;sl_next=(sl_next==(NSLOT-1)*SLOTB)?0:sl_next+SLOTB;}while(0)
  DMA_K(2,2*SLOTB);
  WAIT_BAR(0);
  v8i32 kf[2];
  kf[0]=ld32(kp0,1024); kf[1]=ld32(kp0+512,1024);
  pA0=__builtin_amdgcn_mfma_scale_f32_32x32x64_f8f6f4(kf[0],qf,f32x16{},0,0,0,SC1,0,SC8); pA1=__builtin_amdgcn_mfma_scale_f32_32x32x64_f8f6f4(kf[1],qf,f32x16{},0,0,0,SC1,0,SC8);
  asm volatile("s_nop 15\n\ts_nop 15":"+v"(pA0),"+v"(pA1));
  #define PACKP(X0,X1) do{ pw[0]=pk8o(pw[0],X0[0],X0[1],X0[2],X0[3]); pw[1]=pk8o(pw[1],X0[4],X0[5],X0[6],X0[7]); pw[2]=pk8o(pw[2],X0[8],X0[9],X0[10],X0[11]); pw[3]=pk8o(pw[3],X0[12],X0[13],X0[14],X0[15]); \
      pw[4]=pk8o(pw[4],X1[0],X1[1],X1[2],X1[3]); pw[5]=pk8o(pw[5],X1[4],X1[5],X1[6],X1[7]); pw[6]=pk8o(pw[6],X1[8],X1[9],X1[10],X1[11]); pw[7]=pk8o(pw[7],X1[12],X1[13],X1[14],X1[15]); }while(0)
  CMASK(pA0,pA1,0);
  { const float rm=rowmax(pA0,pA1); mhat=rm;
    _Pragma("unroll") for(int r=0;r<16;++r){pA0[r]=__builtin_amdgcn_exp2f(pA0[r]-rm);pA1[r]=__builtin_amdgcn_exp2f(pA1[r]-rm);} }
  PACKP(pA0,pA1);
  WAIT_BAR(0);
  DMA_K(3,0);DMA_V(1,SLOTB);
  ROT();
  kf[0]=ld32(kp0+sl_cur,1024); kf[1]=ld32(kp0+sl_cur+512,1024);
  WAIT_KV(2,1);
  #define PIN(x) asm volatile("":"+v"(x))
  #define MX3(a,b,c) __builtin_fmaxf(__builtin_fmaxf((a),(b)),(c))
  #define EX(v) __builtin_amdgcn_exp2f(v)
  #define EXE(X0,X1,i) do{ if((i)<16) X0[(i)&15]=EX(X0[(i)&15]); else X1[(i)&15]=EX(X1[(i)&15]); }while(0)
  #define STEP(t,GK,GV,GL,BAND) do{ SBAR(); A8PRIO(1);     \
    const lds_cptr vp_=vp0+2*sl_prev; \
    vf[0]=ld32(vp_,2048); vf[1]=ld32(vp_+512,2048); vf[2]=ld32(vp_+1024,2048); vf[3]=ld32(vp_+1536,2048); \
    { const float nm_=-mhat; _Pragma("unroll") for(int r=0;r<16;++r){pA0[r]=nm_;pA1[r]=nm_;} } \
    pA0=__builtin_amdgcn_mfma_scale_f32_32x32x64_f8f6f4(kf[0],qf,pA0,0,0,0,SC1,0,SC8); \
    pA1=__builtin_amdgcn_mfma_scale_f32_32x32x64_f8f6f4(kf[1],qf,pA1,0,0,0,SC1,0,SC8); \
    if(GK){DMA_K((t)+3,sl_cur);} if(GV){DMA_V((t)+1,sl_next);} \
    o[0]=__builtin_amdgcn_mfma_scale_f32_32x32x64_f8f6f4(pw,vf[0],o[0],0,0,0,SC1,0,SC8); \
    o[1]=__builtin_amdgcn_mfma_scale_f32_32x32x64_f8f6f4(pw,vf[1],o[1],0,0,0,SC1,0,SC8); PIN(o[0]); PIN(o[1]);     \
    if(BAND){ o[2]=__builtin_amdgcn_mfma_scale_f32_32x32x64_f8f6f4(pw,vf[2],o[2],0,0,0,SC1,0,SC8); o[3]=__builtin_amdgcn_mfma_scale_f32_32x32x64_f8f6f4(pw,vf[3],o[3],0,0,0,SC1,0,SC8); o4=__builtin_amdgcn_mfma_scale_f32_32x32x64_f8f6f4(pw,ones,o4,0,0,0,SC1,0,SC8); PIN(o[0]);PIN(o[1]);PIN(o[2]);PIN(o[3]);PIN(o4); } \
    SBAR(); \
    CMASK(pA0,pA1,t); \
    float mxa,mxb; \
    mxa=MX3(pA0[0],pA0[1],pA1[0]); mxb=MX3(pA0[2],pA0[3],pA1[1]); mxa=MX3(mxa,pA1[2],pA1[3]); \
    _Pragma("unroll") for(int r=4;r<16;r+=4){mxa=MX3(mxa,pA0[r],pA0[r+1]);mxb=MX3(mxb,pA0[r+2],pA0[r+3]);mxa=MX3(mxa,pA1[r],pA1[r+1]);mxb=MX3(mxb,pA1[r+2],pA1[r+3]);} \
    { float rm=__builtin_fmaxf(mxa,mxb); { auto rr=__builtin_amdgcn_permlane32_swap(__float_as_uint(rm),__float_as_uint(rm),false,false); rm=__builtin_fmaxf(__uint_as_float(rr[0]),__uint_as_float(rr[1])); } \
      resc=false; \
      if(__builtin_expect(__any(rm>(float)THRL),0)){ const float dl=__builtin_fmaxf(rm,0.f); mhat+=dl; \
        _Pragma("unroll") for(int r=0;r<16;++r){pA0[r]-=dl;pA1[r]-=dl;} \
        const float f=__builtin_amdgcn_exp2f(-dl); if(hi==0)wsf[r32]=f; resc=true; } } \
    SBAR(); \
    if(!BAND){ o[2]=__builtin_amdgcn_mfma_scale_f32_32x32x64_f8f6f4(pw,vf[2],o[2],0,0,0,SC1,0,SC8); } \
    if(GL){ kf[0]=ld32(kp0+sl_next,1024); } \
    EXE(pA0,pA1,0);EXE(pA0,pA1,1);EXE(pA0,pA1,2);EXE(pA0,pA1,3);EXE(pA0,pA1,4);EXE(pA0,pA1,5);EXE(pA0,pA1,6);EXE(pA0,pA1,7);EXE(pA0,pA1,8);EXE(pA0,pA1,9);EXE(pA0,pA1,10); PIN(pA0); SBAR(); \
    if(!BAND){ o[3]=__builtin_amdgcn_mfma_scale_f32_32x32x64_f8f6f4(pw,vf[3],o[3],0,0,0,SC1,0,SC8); } \
    if(GL){ kf[1]=ld32(kp0+sl_next+512,1024); } \
    EXE(pA0,pA1,11);EXE(pA0,pA1,12);EXE(pA0,pA1,13);EXE(pA0,pA1,14);EXE(pA0,pA1,15);EXE(pA0,pA1,16);EXE(pA0,pA1,17);EXE(pA0,pA1,18);EXE(pA0,pA1,19);EXE(pA0,pA1,20);EXE(pA0,pA1,21); PIN(pA0); PIN(pA1); SBAR(); \
    if(!BAND){ o4=__builtin_amdgcn_mfma_scale_f32_32x32x64_f8f6f4(pw,ones,o4,0,0,0,SC1,0,SC8); } \
    EXE(pA0,pA1,22);EXE(pA0,pA1,23);EXE(pA0,pA1,24);EXE(pA0,pA1,25);EXE(pA0,pA1,26);EXE(pA0,pA1,27);EXE(pA0,pA1,28);EXE(pA0,pA1,29);EXE(pA0,pA1,30);EXE(pA0,pA1,31); PIN(pA1); SBAR(); \
    PACKP(pA0,pA1); SBAR(); A8PRIO(0); \
    }while(0)
  o[0]=f32x16{};o[1]=f32x16{};o[2]=f32x16{};o[3]=f32x16{};o4=f32x16{};
  int t=1;
  #undef CMASK
  #define CMASK(P0,P1,t) do{}while(0)
  for(;t+7<NT;t+=2){
    STEP(t,true,true,true,false);     WAIT_KV(2,1); RESC(); ROT();
    STEP(t+1,true,true,true,false);   WAIT_KV(2,1); RESC(); ROT();
  }
  #undef CMASK
  #define CMASK(P0,P1,t) do{int jb_=(t)-(NT-4); if(jb_>=-2)cbm4(P0,P1,jb_,qrel,hi,dtab);}while(0)
  #define ENDW(tt) do{ if((tt)+3<NT){WAIT_KV(2,1);} else if((tt)+2<NT){WAIT_BAR(1);} else {WAIT_BAR(0);} }while(0)
  for(;t+1<NT;t+=2){
    STEP(t,(t+3<NT),(t+1<NT),(t+1<NT),true);       ENDW(t);   RESC(); ROT();
    STEP(t+1,(t+4<NT),(t+2<NT),(t+2<NT),true);     ENDW(t+1); RESC(); ROT();
  }
  STEP(NT-1,false,false,false,true); RESC();
  { const lds_cptr vq=vp0+2*sl_cur;
    #pragma unroll
    for(int db=0;db<4;++db){ vf[db]=ld32(vq+db*512,2048); }
    #pragma unroll
    for(int db=0;db<4;++db) o[db]=__builtin_amdgcn_mfma_scale_f32_32x32x64_f8f6f4(pw,vf[db],o[db],0,0,0,SC1,0,SC8);
    o4=__builtin_amdgcn_mfma_scale_f32_32x32x64_f8f6f4(pw,ones,o4,0,0,0,SC1,0,SC8); }
  #undef PACKP
  #undef PIN
  #undef MX3
  #undef EX
  #undef EXE
  #undef STEP
  #undef ENDW
  const bf16* Qdummy=nullptr; (void)Qdummy;
  float rli[16];
  #pragma unroll
  for(int r=0;r<16;++r)rli[r]=__builtin_amdgcn_rcpf(o4[r]);
  bf16*Ow=O+(rowbase+q0+wid*QBLK)*DM+vcol;
  { bf16*stg=(bf16*)(shm+LDS_OST)+wid*2048;
    float dd[2][4][8]; float ss[4]={0.f,0.f,0.f,0.f};
    #pragma unroll
    for(int hf=0;hf<2;++hf){
      #pragma unroll
      for(int r=0;r<16;++r){const int orow=crow(r,hi);
        #pragma unroll
        for(int d0=0;d0<2;++d0)stg[orow*64+d0*32+r32]=__float2bfloat16(o[2*hf+d0][r]*rli[r]);}
      asm volatile("s_waitcnt lgkmcnt(0)":::"memory");
      #pragma unroll
      for(int i=0;i<4;++i){const int row=i*8+(lane>>3),ch=lane&7; const u32x4 v=*(const u32x4*)(stg+row*64+ch*8);
        if constexpr(MODE==0){ ATTN_STORE16(Ow+(long)row*DM+hf*64+ch*8,v); }
        else { const u32x4 v1=*(const u32x4*)(Ow+(long)row*DM+hf*64+ch*8);
          #pragma unroll
          for(int k=0;k<4;++k){ const float a0=__uint_as_float(v1[k]<<16),a1=__uint_as_float(v1[k]&0xffff0000u),b0=__uint_as_float(v[k]<<16),b1=__uint_as_float(v[k]&0xffff0000u);
            const float e0=a0-lam*b0,e1=a1-lam*b1; dd[hf][i][2*k]=e0; dd[hf][i][2*k+1]=e1; ss[i]+=e0*e0+e1*e1; } } }
      asm volatile("s_waitcnt lgkmcnt(0)":::"memory"); }
    if constexpr(MODE==1){
      bf16*Uw=Uo+(rowbase+q0+wid*QBLK)*DM+vcol;
      #pragma unroll
      for(int i=0;i<4;++i){ float t=ss[i]; t+=__shfl_xor(t,1); t+=__shfl_xor(t,2); t+=__shfl_xor(t,4); ss[i]=oscale/sqrtf(t*(1.0f/128.0f)+1e-5f); }
      #pragma unroll
      for(int hf=0;hf<2;++hf){ const int ch=lane&7; const f32x4_t g0=*(const f32x4_t*)(sg+hf*64+ch*8),g1=*(const f32x4_t*)(sg+hf*64+ch*8+4);
        #pragma unroll
        for(int i=0;i<4;++i){ const int row=i*8+(lane>>3); const float rs=ss[i]; u32x4 w;
          if(DENSE_FP8_C4){ const float r8=rs*U_SCALE; pg8::u32x2w w8;
            w8.x=pk8(dd[hf][i][0]*r8*g0[0],dd[hf][i][1]*r8*g0[1],dd[hf][i][2]*r8*g0[2],dd[hf][i][3]*r8*g0[3]); w8.y=pk8(dd[hf][i][4]*r8*g1[0],dd[hf][i][5]*r8*g1[1],dd[hf][i][6]*r8*g1[2],dd[hf][i][7]*r8*g1[3]);
            pg8::st8((unsigned char*)Uo+((rowbase+q0+wid*QBLK+row)*DM+vcol+hf*64+ch*8),w8); }
          else {
          w[0]=cvtpk_s(dd[hf][i][0]*rs*g0[0],dd[hf][i][1]*rs*g0[1]); w[1]=cvtpk_s(dd[hf][i][2]*rs*g0[2],dd[hf][i][3]*rs*g0[3]);
          w[2]=cvtpk_s(dd[hf][i][4]*rs*g1[0],dd[hf][i][5]*rs*g1[1]); w[3]=cvtpk_s(dd[hf][i][6]*rs*g1[2],dd[hf][i][7]*rs*g1[3]);
          ATTN_STORE16(Uw+(long)row*DM+hf*64+ch*8,w); } } } } }
  asm volatile("s_waitcnt lgkmcnt(0)\n\ts_barrier":::"memory");
  #undef DMA_K
  #undef DMA_V
  #undef CMASK
  #undef START
  #undef RESC
  #undef ROT
  #undef WAIT_KV
}
constexpr int ATTN_LDS_BYTES=LDS_BYTES;
template<int THRL=8> __device__ __forceinline__ void attn_phase(char*lds,const unsigned char*Q8,const unsigned char*K8,const unsigned char*VT8,bf16*O1buf,bf16*U,const float*sg,float lam,float oscale,const float*relb,int vcu,int G){
  for(int X=vcu;X<512;X+=G){ const int i=X>>8,v=X&255,bh=v>>4,s=v&15; const int qb=(i==0)?s:31-s; const int b=bh>>3,h=bh&7;
    attn_unit<THRL,0>(b,h,h*128,qb,Q8,K8,VT8,O1buf,U,sg,lam,oscale,relb,lds);
    attn_unit<THRL,1>(b,8+h,h*128,qb,Q8,K8,VT8,O1buf,U,sg,lam,oscale,relb,lds); }
}
#undef SBAR
#undef WAIT_BAR
#undef SC1
#undef SC8
}
struct Frame {
    LAS unsigned char* lds;
    volatile LAS unsigned* MISC;
    gu32* ctl;
    int tid, lane, wave;
    int vcu, G, bid;
};

struct Args { const float* in[24]; float* out; unsigned char* ws; int ph_lo, ph_hi; };
typedef const __attribute__((address_space(4))) Args* KArgs;
__device__ __forceinline__ KArgs kargs() { KArgs p = (KArgs)__builtin_amdgcn_kernarg_segment_ptr(); asm volatile("" : "+s"(p)); return p; }
#define INP(k) ((const float*)kargs()->in[k])

__device__ __forceinline__ float wave_sum(float v) {
#pragma unroll
    for (int o = 1; o < 64; o <<= 1) v += __shfl_xor(v, o);
    return v;
}
__device__ __forceinline__ float bf2f(unsigned short b) { return __builtin_bit_cast(float, (unsigned)b << 16); }
__device__ __forceinline__ float bflo(unsigned w) { return __builtin_bit_cast(float, w << 16); }
__device__ __forceinline__ float bfhi(unsigned w) { return __builtin_bit_cast(float, w & 0xffff0000u); }
__device__ __forceinline__ f32x4 fp8x4_to_f32(unsigned w) {
    const float k = __builtin_bit_cast(float, 0x7b800000u);
    f32x4 r;
    r.x = __builtin_bit_cast(float, ((w << 20) & 0x07f00000u) | ((w << 24) & 0x80000000u)) * k;
    r.y = __builtin_bit_cast(float, ((w << 12) & 0x07f00000u) | ((w << 16) & 0x80000000u)) * k;
    r.z = __builtin_bit_cast(float, ((w << 4) & 0x07f00000u) | ((w << 8) & 0x80000000u)) * k;
    r.w = __builtin_bit_cast(float, ((w >> 4) & 0x07f00000u) | (w & 0x80000000u)) * k;
    return r;
}
__device__ __forceinline__ float sigmoidf_(float x) { return __builtin_amdgcn_rcpf(1.0f + __expf(-x)); }

__device__ __forceinline__ void cvt_tile64(const float* W, int N, bf16* WT, int K, int drow, int k0, int n0, LAS unsigned* scr, int lane) {
    const int a = lane & 15, q = lane >> 4;
    f32x4 lo[8], hi[8];
#pragma unroll
    for (int p = 0; p < 8; ++p) { const float* src = W + (size_t)(k0 + 8 * p + 2 * q) * N + n0 + 4 * a; lo[p] = *(const f32x4*)src; hi[p] = *(const f32x4*)(src + N); }
#pragma unroll
    for (int p = 0; p < 8; ++p)
#pragma unroll
        for (int i = 0; i < 4; ++i) scr[32 * (4 * a + i) + 4 * (p ^ (a & 7)) + q] = pg8::cvt_pk_bf16(lo[p][i], hi[p][i]);
    LDS_WAIT(); asm volatile("" ::: "memory");
#pragma unroll
    for (int j = 0; j < 8; ++j) { const int n = 8 * j + (lane >> 3), c = lane & 7;
        const v4u v = *(const LAS v4u*)(scr + 32 * n + 4 * (c ^ ((n >> 2) & 7)));
        pg8::st16(WT + (size_t)(drow + n) * K + k0 + 8 * c, v); }
    LDS_WAIT(); asm volatile("" ::: "memory");
}
__device__ __forceinline__ void cvt_tile64_f8(const float* W, int N, unsigned char* WT, int Kb, int drow, int k0, int n0, float scale, LAS unsigned* scr, int lane) {
    const int a = lane & 15, q = lane >> 4;
    f32x4 r[4][4];
#pragma unroll
    for (int pp = 0; pp < 4; ++pp)
#pragma unroll
        for (int rr = 0; rr < 4; ++rr) r[pp][rr] = *(const f32x4*)(W + (size_t)(k0 + 16 * pp + 4 * q + rr) * N + n0 + 4 * a);
#pragma unroll
    for (int pp = 0; pp < 4; ++pp)
#pragma unroll
        for (int i = 0; i < 4; ++i) { unsigned w = __builtin_amdgcn_cvt_pk_fp8_f32(r[pp][0][i] * scale, r[pp][1][i] * scale, 0, false); w = __builtin_amdgcn_cvt_pk_fp8_f32(r[pp][2][i] * scale, r[pp][3][i] * scale, w, true);
            scr[17 * (4 * a + i) + 4 * pp + q] = w; }
    LDS_WAIT(); asm volatile("" ::: "memory");
#pragma unroll
    for (int j = 0; j < 4; ++j) { const int n = 16 * j + (lane >> 2), c = lane & 3; const LAS unsigned* sp = scr + 17 * n + 4 * c;
        const v4u v = (v4u){sp[0], sp[1], sp[2], sp[3]};
        pg8::st16(WT + (size_t)(drow + n) * Kb + k0 + 16 * c, v); }
    LDS_WAIT(); asm volatile("" ::: "memory");
}
__device__ __forceinline__ int il_row(int n, int second) { return 256 * (n >> 7) + 128 * second + (n & 127); }

__device__ __forceinline__ void ph_prologue(Frame& F, unsigned char* ws) {
    LAS unsigned* scr = (LAS unsigned*)(F.lds + RING_OFF + F.wave * 8192);
    const int gw = F.vcu * NWAVES + F.wave, NGW = F.G * NWAVES;
    constexpr int I_SQ = (D / 64) * (D / 64);
    constexpr int I_W2 = (D / 64) * (2 * D / 64);
    constexpr int NITEMS = 2 * I_W2 + 2 * I_SQ + I_W2 + 2 * I_SQ + 2 * I_SQ;
    for (int it = gw; it < NITEMS; it += NGW) {
        int r = it;
        if (r < 2 * I_W2) { const int l = r / I_W2, t = r % I_W2, k0 = (t >> 5) * 64, n0 = (t & 31) * 64;
            if (DENSE_FP8_S1) cvt_tile64_f8(INP(1) + (size_t)l * D * 2 * D, 2 * D, (unsigned char*)(ws + WS_PW1T) + (size_t)l * 2 * D * D, D, il_row(n0 & 1023, n0 >> 10), k0, n0, WX_SCALE, scr, F.lane);
            else cvt_tile64(INP(1) + (size_t)l * D * 2 * D, 2 * D, (bf16*)(ws + WS_PW1T) + (size_t)l * 2 * D * D, D, il_row(n0 & 1023, n0 >> 10), k0, n0, scr, F.lane); continue; } r -= 2 * I_W2;
        if (r < 2 * I_SQ) { const int l = r / I_SQ, t = r % I_SQ, k0 = (t >> 4) * 64, n0 = (t & 15) * 64;
            if (DENSE_FP8_S3) cvt_tile64_f8(INP(7) + (size_t)l * D * D, D, (unsigned char*)(ws + WS_PW2T) + (size_t)l * D * D, D, n0, k0, n0, WX_SCALE, scr, F.lane);
            else cvt_tile64(INP(7) + (size_t)l * D * D, D, (bf16*)(ws + WS_PW2T) + (size_t)l * D * D, D, n0, k0, n0, scr, F.lane); continue; } r -= 2 * I_SQ;
        if (r < I_W2) { const int t = r, k0 = (t >> 5) * 64, n0 = (t & 31) * 64;
            if (DENSE_FP8_C1) cvt_tile64_f8(INP(9), 2 * D, (unsigned char*)(ws + WS_WQ0T) + (size_t)D * D, D, n0, k0, n0, WX_SCALE, scr, F.lane);
            else cvt_tile64(INP(9), 2 * D, (bf16*)(ws + WS_WKVT), D, n0, k0, n0, scr, F.lane); continue; } r -= I_W2;
        if (r < 2 * I_SQ) { const int l = r / I_SQ, t = r % I_SQ, k0 = (t >> 4) * 64, n0 = (t & 15) * 64;
            if (DENSE_FP8_C1) cvt_tile64_f8(INP(10) + (size_t)l * D * D, D, (unsigned char*)(ws + (l == 0 ? WS_WQ0T : WS_WQ1T)), D, n0, k0, n0, WX_SCALE, scr, F.lane);
            else cvt_tile64(INP(10) + (size_t)l * D * D, D, (bf16*)(ws + (l == 0 ? WS_WQ0T : WS_WQ1T)), D, n0, k0, n0, scr, F.lane); continue; } r -= 2 * I_SQ;
        { const int l = r / I_SQ, t = r % I_SQ, k0 = (t >> 4) * 64, n0 = (t & 15) * 64;
            if (DENSE_FP8_C4) cvt_tile64_f8(INP(13) + (size_t)l * D * D, D, (unsigned char*)(ws + WS_WOT) + (size_t)l * D * D, D, n0, k0, n0, WX_SCALE, scr, F.lane);
            else cvt_tile64(INP(13) + (size_t)l * D * D, D, (bf16*)(ws + WS_WOT) + (size_t)l * D * D, D, n0, k0, n0, scr, F.lane); }
    }
    const float* x = INP(0); bf16* xb = (bf16*)(ws + WS_XBF);
    for (int m = gw; m < T; m += NGW) {
        const f32x4* xr = (const f32x4*)(x + (size_t)m * D) + F.lane; unsigned long long* o8 = (unsigned long long*)(xb + (size_t)m * D) + F.lane;
#pragma unroll
        for (int j = 0; j < 4; ++j) { const f32x4 v = xr[64 * j]; pg8::st8(o8 + 64 * j, (pg8::u32x2w){pk2(v.x, v.y), pk2(v.z, v.w)});
            if (DENSE_FP8_S1) { unsigned w = __builtin_amdgcn_cvt_pk_fp8_f32(v.x, v.y, 0, false); w = __builtin_amdgcn_cvt_pk_fp8_f32(v.z, v.w, w, true); *((unsigned*)(ws + WS_XS8 + (size_t)m * D) + F.lane + 64 * j) = w; } }
    }
}
constexpr int MOE_CVT_ITEMS = NE * 384, MOE_CVT_SPLIT = 3686;
__device__ __forceinline__ void moe_cvt_item(unsigned char* ws, int l, int it, LAS unsigned* scr, int lane) {
    constexpr int I_G = (D / 64) * (DE / 64);
    constexpr int PER_E = 3 * I_G;
    const int e = it / PER_E; int r = it % PER_E;
    bf16* gut = (bf16*)(ws + ws_wgut(l)); bf16* dt = (bf16*)(ws + ws_wdt(l));
#if MOE_FP8
    if (r < 2 * I_G) { const int up = r >= I_G, t = r - up * I_G, k0 = (t >> 3) * 64, n0 = (t & 7) * 64;
        cvt_tile64_f8(INP(up ? 22 : 21) + ((size_t)l * NE + e) * D * DE, DE, (unsigned char*)gut + (size_t)e * 2 * DE * D, D, il_row(n0, up), k0, n0, WG_SCALE, scr, lane); }
    else { r -= 2 * I_G; const int k0 = (r >> 4) * 64, n0 = (r & 15) * 64; cvt_tile64_f8(INP(23) + ((size_t)l * NE + e) * DE * D, D, (unsigned char*)dt + (size_t)e * D * DE, DE, n0, k0, n0, WD_SCALE, scr, lane); }
#else
    if (r < 2 * I_G) { const int up = r >= I_G, t = r - up * I_G, k0 = (t >> 3) * 64, n0 = (t & 7) * 64;
        cvt_tile64(INP(up ? 22 : 21) + ((size_t)l * NE + e) * D * DE, DE, gut + (size_t)e * 2 * DE * D, D, il_row(n0, up), k0, n0, scr, lane); }
    else { r -= 2 * I_G; const int k0 = (r >> 4) * 64, n0 = (r & 15) * 64; cvt_tile64(INP(23) + ((size_t)l * NE + e) * DE * D, D, dt + (size_t)e * D * DE, DE, n0, k0, n0, scr, lane); }
#endif
}
constexpr int MOE_CVT_SIDEN = 1792;
constexpr int MOE_CVT_SIDE0 = 5376;
__device__ __forceinline__ void ph_moe_cvt(Frame& F, unsigned char* ws, int l, int lo) {
    LAS unsigned* scr = (LAS unsigned*)(F.lds + RING_OFF + F.wave * 8192);
    const int gw = F.vcu * NWAVES + F.wave, NGW = F.G * NWAVES;
    for (int it = lo + gw; it < MOE_CVT_ITEMS; it += NGW) moe_cvt_item(ws, l, it, scr, F.lane);
}
__device__ __forceinline__ void moe_cvt_tail(Frame& F, unsigned char* ws, int l, int units, int lo, int hi) {
    LAS unsigned* scr = (LAS unsigned*)(F.lds + RING_OFF + F.wave * 8192);
    const int r = units % F.G; int n_early = F.G - r, rank = F.vcu - r;
    if (r == 0 || 2 * n_early < F.G) { n_early = F.G; rank = F.vcu; }
    if (rank < 0) return;
    for (int it = lo + rank * NWAVES + F.wave; it < hi; it += n_early * NWAVES) moe_cvt_item(ws, l, it, scr, F.lane);
}

typedef float f32x2_ __attribute__((ext_vector_type(2)));
typedef _Float16 f16x2_ __attribute__((ext_vector_type(2)));
template <int I, int J> struct ConvStep { static __device__ __forceinline__ void run(f16x2_ (&acc)[32], const f16x2_ (&w)[CONVW], const f16x2_ x) {
    if constexpr (I - J >= 0 && I - J < 32) acc[I - J] += w[J] * x;
    if constexpr (J + 1 < CONVW) ConvStep<I, J + 1>::run(acc, w, x); } };
template <int I> struct ConvRow { static __device__ __forceinline__ void run(f16x2_ (&acc)[32], const f16x2_ (&w)[CONVW], const unsigned (&xv)[32 + CONVW - 1]) {
    const f16x2_ x = __builtin_bit_cast(f16x2_, __builtin_amdgcn_cvt_pkrtz(bflo(xv[I]), bfhi(xv[I])));
    ConvStep<I, 0>::run(acc, w, x);
    if constexpr (I + 1 < 32 + CONVW - 1) ConvRow<I + 1>::run(acc, w, xv); } };
__device__ __forceinline__ void ph_conv(Frame& F, const bf16* G, const float* wdw  , const float* bdw, const float* lng, const float* lnb, bf16* U) {
    constexpr int R = 32, NIN = R + CONVW - 1;
    const int c0 = 2 * F.tid;
    f16x2_ w[CONVW];
#pragma unroll
    for (int j = 0; j < CONVW; ++j) w[j] = __builtin_convertvector(*(const f32x2_*)(wdw + j * D + c0), f16x2_);
    const f32x2_ bd = *(const f32x2_*)(bdw + c0), g2 = *(const f32x2_*)(lng + c0), b2 = *(const f32x2_*)(lnb + c0);
    LAS float* red = (LAS float*)(F.lds + RING_OFF);
    LAS float* tot = red + 512;
    for (int tile = F.vcu; tile < T / R; tile += F.G) {
        const int t0 = tile * R, bstart = t0 & ~(SEQ - 1);
        unsigned xv[NIN];
#pragma unroll
        for (int i = 0; i < NIN; ++i) { const int r = t0 - (CONVW - 1) + i; xv[i] = 0u; if (r >= bstart) xv[i] = *(const unsigned*)(G + (size_t)r * D + c0); }
        f16x2_ acc16[R]; const f16x2_ bd16 = __builtin_convertvector(bd, f16x2_);
#pragma unroll
        for (int o = 0; o < R; ++o) acc16[o] = bd16;
        ConvRow<0>::run(acc16, w, xv);
        f32x2_ acc[R];
#pragma unroll
        for (int o = 0; o < R; ++o) acc[o] = __builtin_convertvector(acc16[o], f32x2_);
        float v[64];
#pragma unroll
        for (int o = 0; o < R; ++o) { v[2 * o] = acc[o].x + acc[o].y; v[2 * o + 1] = acc[o].x * acc[o].x + acc[o].y * acc[o].y; }
#define RS_STEP(MSK, N) { const bool up = (F.lane & (MSK)) != 0; _Pragma("unroll") for (int q = 0; q < (N); ++q) { const float a = up ? v[q + (N)] : v[q], b = up ? v[q] : v[q + (N)]; v[q] = a + __shfl_xor(b, (MSK)); } }
        RS_STEP(32, 32) RS_STEP(16, 16) RS_STEP(8, 8) RS_STEP(4, 4) RS_STEP(2, 2) RS_STEP(1, 1)
#undef RS_STEP
        __syncthreads();
        red[F.wave * 64 + F.lane] = v[0];
        __syncthreads();
        if (F.tid < 64) { float s = 0.f;
#pragma unroll
            for (int wv = 0; wv < 8; ++wv) s += red[wv * 64 + F.tid];
            tot[F.tid] = s; }
        __syncthreads();
#pragma unroll
        for (int o = 0; o < R; ++o) { const float mean = tot[2 * o] * (1.f / D), var = fmaxf(tot[2 * o + 1] * (1.f / D) - mean * mean, 0.f), rstd = __builtin_amdgcn_rsqf(var + LN_EPS);
            const f32x2_ y = (acc[o] - mean) * rstd * g2 + b2;
            const float y0 = y.x * sigmoidf_(y.x), y1 = y.y * sigmoidf_(y.y);
            if (DENSE_FP8_S3) *(unsigned short*)((unsigned char*)U + (size_t)(t0 + o) * D + c0) = (unsigned short)__builtin_amdgcn_cvt_pk_fp8_f32(y0 * U_SCALE, y1 * U_SCALE, 0, false);
            else pg8::st4(U + (size_t)(t0 + o) * D + c0, pk2(y0, y1)); }
    }
    __syncthreads();
}

#ifndef ROUTER_MFMA
#define ROUTER_MFMA 1
#endif
__device__ __forceinline__ void ph_router(Frame& F, bf16* XS, bf16* XSO  , unsigned char* XS8, const bf16* MIXB, const float* lng, const float* lnb, const float* rw  , const float* rb, const bf16* RWB  ,
                                          int2* tok_e, int2* tok_pos, float2* tok_w, int* elist  , unsigned* cnt  ,
                                          unsigned char* side_ws = nullptr, int side_l = 0, int side_lo = 0, int side_hi = 0  ) {
    constexpr int RWS = 1028;
    LAS float* rwT = (LAS float*)(F.lds + RING_OFF);
#if ROUTER_MFMA
    LAS unsigned char* x1l = F.lds + RING_OFF;
    LAS int* lcount = (LAS int*)(F.lds + LDSCTL_OFF + 4096);
#else
    LAS int* lcount = (LAS int*)(F.lds + RING_OFF + 16 * RWS * 4);
#endif
    LAS int* lbase = lcount + 16;
    LAS int* st_e = lcount + 32;
    LAS int* st_p = st_e + 128;
    LAS float* st_w = (LAS float*)(st_p + 128);
    LAS float* lg = st_w + 128;
    if (!ROUTER_MFMA) for (int i4 = F.tid; i4 < 4 * 1024; i4 += NTHR) { const int c = i4 >> 2, k = i4 & 3; const f32x4 wv = *((const f32x4*)rw + i4); rwT[(4 * k + 0) * RWS + c] = wv.x; rwT[(4 * k + 1) * RWS + c] = wv.y; rwT[(4 * k + 2) * RWS + c] = wv.z; rwT[(4 * k + 3) * RWS + c] = wv.w; }
    f32x4 gg[4], bb[4];
#pragma unroll
    for (int j = 0; j < 4; ++j) { gg[j] = *((const f32x4*)lng + F.lane + 64 * j); bb[j] = *((const f32x4*)lnb + F.lane + 64 * j); }
    __syncthreads();
    for (int chunk = F.bid; chunk < T / 64; chunk += F.G) {
        if (F.tid < 16) lcount[F.tid] = 0;
        for (int kb = 0; kb < 8; kb += 2) {
        unsigned long long xa[2][4], ma[2][4];
#pragma unroll
        for (int k = 0; k < 2; ++k) { const int t = chunk * 64 + F.wave * 8 + kb + k;
#pragma unroll
            for (int j = 0; j < 4; ++j) { xa[k][j] = *((const unsigned long long*)(XS + (size_t)t * D) + F.lane + 64 * j); ma[k][j] = LN_FUSED ? 0ull : (OUT_FP8_MIX ? (unsigned long long)*((const unsigned*)((const unsigned char*)MIXB + (size_t)t * D) + F.lane + 64 * j) : *((const unsigned long long*)(MIXB + (size_t)t * D) + F.lane + 64 * j)); } }
        f32x4 vv[2][4];
#pragma unroll
        for (int k = 0; k < 2; ++k) {
            const int t = chunk * 64 + F.wave * 8 + kb + k;
#if LN_FUSED
#pragma unroll
            for (int j = 0; j < 4; ++j) { const unsigned xl = (unsigned)xa[k][j], xh = (unsigned)(xa[k][j] >> 32); vv[k][j] = (f32x4){bflo(xl), bfhi(xl), bflo(xh), bfhi(xh)}; }
            (void)t; (void)ma;
#else
            float s = 0.f;
#pragma unroll
            for (int j = 0; j < 4; ++j) { const unsigned xl = (unsigned)xa[k][j], xh = (unsigned)(xa[k][j] >> 32), ml = (unsigned)ma[k][j], mh = (unsigned)(ma[k][j] >> 32);
                f32x4 mv; if (OUT_FP8_MIX) { mv = fp8x4_to_f32(ml) * (1.0f / OUT_SCALE); (void)mh; } else mv = (f32x4){bflo(ml), bfhi(ml), bflo(mh), bfhi(mh)};
                vv[k][j] = (f32x4){bflo(xl), bfhi(xl), bflo(xh), bfhi(xh)} * ALPHA + mv; s += (vv[k][j].x + vv[k][j].y) + (vv[k][j].z + vv[k][j].w); }
            float s2 = 0.f;
#pragma unroll
            for (int j = 0; j < 4; ++j) s2 += (vv[k][j].x * vv[k][j].x + vv[k][j].y * vv[k][j].y) + (vv[k][j].z * vv[k][j].z + vv[k][j].w * vv[k][j].w);
            const float mean = wave_sum(s) * (1.f / D);
            const float rstd = __builtin_amdgcn_rsqf(fmaxf(wave_sum(s2) * (1.f / D) - mean * mean, 0.f) + LN_EPS);
            unsigned long long* o8 = (unsigned long long*)(XSO + (size_t)t * D) + F.lane;
#pragma unroll
            for (int j = 0; j < 4; ++j) { vv[k][j] = (vv[k][j] - mean) * rstd * gg[j] + bb[j]; const pg8::u32x2w xw_ = (pg8::u32x2w){pk2(vv[k][j].x, vv[k][j].y), pk2(vv[k][j].z, vv[k][j].w)}; pg8::st8(o8 + 64 * j, xw_);
#if ROUTER_MFMA
                { const int tl_ = F.wave * 8 + kb + k, q_ = (F.lane >> 1) + 32 * j; *(LAS pg8::u32x2w*)(x1l + tl_ * 2048 + ((q_ ^ (tl_ & 15)) << 4) + (F.lane & 1) * 8) = xw_; }
#endif
            }
#endif
        }
#if MOE_FP8
#pragma unroll
        for (int k = 0; k < 2; ++k) { const int t = chunk * 64 + F.wave * 8 + kb + k; unsigned* o4 = (unsigned*)(XS8 + (size_t)t * D) + F.lane;
#pragma unroll
            for (int j = 0; j < 4; ++j) { unsigned w = __builtin_amdgcn_cvt_pk_fp8_f32(vv[k][j].x, vv[k][j].y, 0, false); w = __builtin_amdgcn_cvt_pk_fp8_f32(vv[k][j].z, vv[k][j].w, w, true); pg8::st4(o4 + 64 * j, w); } }
#endif
#if !ROUTER_MFMA
        float p0[16], p1[16];
#pragma unroll
        for (int e = 0; e < 16; ++e) { float a0 = 0.f, a1 = 0.f;
#pragma unroll
            for (int j = 0; j < 4; ++j) { const f32x4 wv = *((const LAS f32x4*)(rwT + e * RWS) + F.lane + 64 * j);
                a0 += (vv[0][j].x * wv.x + vv[0][j].y * wv.y) + (vv[0][j].z * wv.z + vv[0][j].w * wv.w); a1 += (vv[1][j].x * wv.x + vv[1][j].y * wv.y) + (vv[1][j].z * wv.z + vv[1][j].w * wv.w); }
            p0[e] = a0; p1[e] = a1; if ((e & 3) == 3) asm volatile("" ::: "memory"); }
#define RS_STEP(P, MSK, N) { const bool up = (F.lane & (MSK)) != 0; _Pragma("unroll") for (int q = 0; q < (N); ++q) { const float a = up ? P[q + (N)] : P[q], b = up ? P[q] : P[q + (N)]; P[q] = a + __shfl_xor(b, (MSK)); } }
        RS_STEP(p0, 32, 8) RS_STEP(p0, 16, 4) RS_STEP(p0, 8, 2) RS_STEP(p0, 4, 1)
        RS_STEP(p1, 32, 8) RS_STEP(p1, 16, 4) RS_STEP(p1, 8, 2) RS_STEP(p1, 4, 1)
#undef RS_STEP
        float l0 = p0[0], l1 = p1[0]; l0 += __shfl_xor(l0, 1); l1 += __shfl_xor(l1, 1); l0 += __shfl_xor(l0, 2); l1 += __shfl_xor(l1, 2);
        if ((F.lane & 3) == 0) { const int e = ((F.lane >> 5) & 1) * 8 + ((F.lane >> 4) & 1) * 4 + ((F.lane >> 3) & 1) * 2 + ((F.lane >> 2) & 1); const int tl = F.wave * 8 + kb; lg[tl * 16 + e] = l0; lg[(tl + 1) * 16 + e] = l1; }
#endif
        }
#if ROUTER_MFMA
        bf16x8 aw_[16];
        { const bf16* wrow0_ = RWB + (F.lane & 15) * 1024 + (F.wave >> 2) * 512 + (F.lane >> 4) * 8;
#pragma unroll
          for (int s_ = 0; s_ < 16; ++s_) aw_[s_] = *(const bf16x8*)(wrow0_ + s_ * 32); }
#endif
        __syncthreads();
#if ROUTER_MFMA
        {
            const int tb_ = F.wave & 3, kh_ = F.wave >> 2, i_ = F.lane & 15, g_ = F.lane >> 4, row_ = tb_ * 16 + i_;
            const bf16* wrow_ = RWB + i_ * 1024 + kh_ * 512 + g_ * 8;
            f32x4 acc_ = (f32x4){0.f, 0.f, 0.f, 0.f};
#pragma unroll
            for (int s_ = 0; s_ < 16; ++s_) { const bf16x8 a_ = aw_[s_]; (void)wrow_; const int q_ = kh_ * 64 + s_ * 4 + g_;
                const bf16x8 b_ = *(const LAS bf16x8*)(x1l + row_ * 2048 + ((q_ ^ (row_ & 15)) << 4));
                acc_ = __builtin_amdgcn_mfma_f32_16x16x32_bf16(a_, b_, acc_, 0, 0, 0); }
            *(LAS f32x4*)(lg + (kh_ * 64 + row_) * 16 + 4 * g_) = acc_;
        }
        __syncthreads();
#endif
        if (F.wave == 0) {
        {
            const int tl = F.lane; float aff[16], sel[16];
#pragma unroll
            for (int e = 0; e < 16; ++e) { const float lgv = ROUTER_MFMA ? lg[tl * 16 + e] + lg[(64 + tl) * 16 + e] : lg[tl * 16 + e]; aff[e] = ROUTER_MFMA ? __builtin_amdgcn_rcpf(1.0f + __builtin_amdgcn_exp2f(lgv * -1.4426950408889634f)) : 1.0f / (1.0f + expf(-lgv)); sel[e] = aff[e] + rb[e]; }
            int gbest = 0; float gscore = -INFINITY;
#pragma unroll
            for (int g = 0; g < 4; ++g) { float m1 = -INFINITY, m2 = -INFINITY;
#pragma unroll
                for (int j = 0; j < 4; ++j) { const float sv = sel[4 * g + j]; if (sv > m1) { m2 = m1; m1 = sv; } else if (sv > m2) m2 = sv; }
                const float sc = m1 + m2; if (sc > gscore) { gscore = sc; gbest = g; } }
            float sg[4], ag[4];
#pragma unroll
            for (int j = 0; j < 4; ++j) { sg[j] = gbest == 0 ? sel[j] : gbest == 1 ? sel[4 + j] : gbest == 2 ? sel[8 + j] : sel[12 + j]; ag[j] = gbest == 0 ? aff[j] : gbest == 1 ? aff[4 + j] : gbest == 2 ? aff[8 + j] : aff[12 + j]; }
            int i0 = 0; float best = sg[0];
#pragma unroll
            for (int j = 1; j < 4; ++j) if (sg[j] > best) { best = sg[j]; i0 = j; }
            int i1 = -1; float best2 = -INFINITY;
#pragma unroll
            for (int j = 0; j < 4; ++j) if (j != i0 && sg[j] > best2) { best2 = sg[j]; i1 = j; }
            if (i1 < 0) i1 = (i0 == 0) ? 1 : 0;
            float w0 = i0 == 0 ? ag[0] : i0 == 1 ? ag[1] : i0 == 2 ? ag[2] : ag[3], w1 = i1 == 0 ? ag[0] : i1 == 1 ? ag[1] : i1 == 2 ? ag[2] : ag[3];
            const float ws_ = w0 + w1; w0 /= ws_; w1 /= ws_;
            const int e0 = 4 * gbest + i0, e1 = 4 * gbest + i1; const int p0 = atomicAdd((int*)&lcount[e0], 1), p1 = atomicAdd((int*)&lcount[e1], 1);
            st_e[2 * tl] = e0; st_e[2 * tl + 1] = e1; st_p[2 * tl] = p0; st_p[2 * tl + 1] = p1; st_w[2 * tl] = w0; st_w[2 * tl + 1] = w1;
        }
        asm volatile("s_waitcnt lgkmcnt(0)" ::: "memory");
        if (F.lane < 16) lbase[F.lane] = (int)__hip_atomic_fetch_add(cnt + 64 * F.lane, (unsigned)lcount[F.lane], __ATOMIC_RELAXED, __HIP_MEMORY_SCOPE_AGENT);
        asm volatile("s_waitcnt lgkmcnt(0)" ::: "memory");
        { const int t = chunk * 64 + F.lane; const int e0 = st_e[2 * F.lane], e1 = st_e[2 * F.lane + 1];
            const int q0 = lbase[e0] + st_p[2 * F.lane], q1 = lbase[e1] + st_p[2 * F.lane + 1];
            tok_e[t] = make_int2(e0, e1); tok_pos[t] = make_int2(q0, q1); tok_w[t] = make_float2(st_w[2 * F.lane], st_w[2 * F.lane + 1]); elist[e0 * T + q0] = t; elist[e1 * T + q1] = t; }
        } else if (side_hi > side_lo && chunk == F.bid) {
            LAS unsigned* scr = (LAS unsigned*)(F.lds + RING_OFF + 73728 + (F.wave - 1) * 4608);
            for (int it = side_lo + F.vcu * 7 + (F.wave - 1); it < side_hi; it += F.G * 7) moe_cvt_item(side_ws, side_l, it, scr, F.lane);
        }
        __syncthreads();
    }
}

__device__ __forceinline__ void moe_offsets(Frame& F, const unsigned* cnt) {
    LAS int* li = (LAS int*)(F.lds + LDSCTL_OFF);
    __syncthreads();
    if (F.tid < NE) li[LI_CNT + F.tid] = (int)__hip_atomic_load(cnt + 64 * F.tid, __ATOMIC_RELAXED, __HIP_MEMORY_SCOPE_AGENT);
    __syncthreads();
    if (F.tid == 0) {
        int off = 0, nt = 0;
        for (int e = 0; e < NE; ++e) { const int c = li[LI_CNT + e]; li[LI_OFF + e] = off; const int tiles = (c + 255) >> 8;
            for (int k = 0; k < tiles && nt < MAXTILES; ++k) li[LI_TEXP + nt++] = e; off += tiles * 256; }
        li[LI_OFF + NE] = off; li[LI_NT] = nt;
    }
    __syncthreads();
}

__device__ __forceinline__ void ph_gather(Frame& F, const bf16* XBF, const int2* tok_e, const int2* tok_pos, bf16* XG) {
    const LAS int* li = (const LAS int*)(F.lds + LDSCTL_OFF);
    const int gw = F.vcu * NWAVES + F.wave, NGW = F.G * NWAVES;
    for (int t = gw; t < T; t += NGW) {
        const int2 e = tok_e[t], p = tok_pos[t]; const int r0 = li[LI_OFF + e.x] + p.x, r1 = li[LI_OFF + e.y] + p.y;
        const v4u* src = (const v4u*)(XBF + (size_t)t * D) + F.lane; const v4u a = src[0], b = src[64];
        v4u* d0 = (v4u*)(XG + (size_t)r0 * D) + F.lane; v4u* d1 = (v4u*)(XG + (size_t)r1 * D) + F.lane;
        d0[0] = a; d0[64] = b; d1[0] = a; d1[64] = b;
    }
}

struct GroupedOrder {
    const LAS int* texp; int ntiles, nN, G, c; size_t bstride; const LAS unsigned* rowsrc;
    __device__ __forceinline__ bool next(int i, pg8::Unit& u) const {
        const long L = (long)i * G + c; if (L >= (long)ntiles * nN) return false;
        const int ti = (int)(L / nN); u.pm = ti; u.pn = (int)(L % nN); u.boff = (size_t)texp[ti] * bstride; u.slot = i; return true;
    }
    __device__ __forceinline__ unsigned rowoff(const pg8::Unit& u, int r) const { return rowsrc[u.slot * 256 + r]; }
    __device__ __forceinline__ void a_ready(const pg8::Unit&) const {}
    __device__ __forceinline__ void done(const pg8::Unit&) const {}
};
__device__ __forceinline__ void moe_rowsrc(Frame& F, const unsigned* cnt, const int* elist, int c) {
    LAS int* li = (LAS int*)(F.lds + LDSCTL_OFF); LAS unsigned* rs = (LAS unsigned*)(li + LI_ROWS);
    const int nt = li[LI_NT];
    for (int idx = F.tid; idx < 3 * 256; idx += NTHR) { const int slot = idx >> 8, r = idx & 255; const long L = (long)slot * F.G + c; unsigned off = 0u;
        if (L < (long)nt * 4) { const int ti = (int)(L >> 2), e = li[LI_TEXP + ti], pos = ti * 256 + r - li[LI_OFF + e]; if (pos < li[LI_CNT + e]) off = (unsigned)elist[e * T + pos] * (unsigned)(MOE_FP8 ? D : D * 2); }
        rs[idx] = off; }
    __syncthreads();
}

__device__ __forceinline__ void ph_silumul(Frame& F, const bf16* HU, bf16* HH) {
    const LAS int* li = (const LAS int*)(F.lds + LDSCTL_OFF);
    const int rows = li[LI_OFF + NE];
    const long n8 = (long)rows * (DE / 8);
    for (long i = (long)F.bid * NTHR + F.tid; i < n8; i += (long)F.G * NTHR) {
        const long r = i / (DE / 8); const int j8 = (int)(i % (DE / 8)) * 8;
        const v4u g = *(const v4u*)(HU + r * 1024 + j8), u = *(const v4u*)(HU + r * 1024 + 512 + j8);
        v4u o;
#define SM1(gw_, uw_) ({ float a = bflo(gw_), b = bfhi(gw_); a = a * sigmoidf_(a) * bflo(uw_); b = b * sigmoidf_(b) * bfhi(uw_); pk2(a, b); })
        o.x = SM1(g.x, u.x); o.y = SM1(g.y, u.y); o.z = SM1(g.z, u.z); o.w = SM1(g.w, u.w);
#undef SM1
        *(v4u*)(HH + r * 512 + j8) = o;
    }
}

__device__ __forceinline__ void ph_combine(Frame& F, bf16* XS, bf16* XSO  , const bf16* Y, const int2* tok_e, const int2* tok_pos, const float2* tok_w, const float* lng, const float* lnb, float* out, unsigned char* XS8) {
    const LAS int* li = (const LAS int*)(F.lds + LDSCTL_OFF);
    const int gw = F.vcu * NWAVES + F.wave, NGW = F.G * NWAVES;
    f32x4 gg[4], bb[4];
#pragma unroll
    for (int j = 0; j < 4; ++j) { gg[j] = *((const f32x4*)lng + F.lane + 64 * j); bb[j] = *((const f32x4*)lnb + F.lane + 64 * j); }
    for (int tb = gw; tb < T; tb += 4 * NGW) {
        int2 e[4], p[4]; float2 w[4];
#pragma unroll
        for (int k = 0; k < 4; ++k) { const int t = tb + k * NGW < T ? tb + k * NGW : tb; e[k] = tok_e[t]; p[k] = tok_pos[t]; w[k] = tok_w[t]; }
        unsigned long long xa[4][4], ya[4][4], yb[4][4];
#pragma unroll
        for (int k = 0; k < 4; ++k) { const int t = tb + k * NGW < T ? tb + k * NGW : tb; const int r0 = li[LI_OFF + e[k].x] + p[k].x, r1 = li[LI_OFF + e[k].y] + p[k].y;
            const unsigned long long* xs = (const unsigned long long*)(XS + (size_t)t * D) + F.lane;
#if OUT_FP8_Y
            const unsigned* y0 = (const unsigned*)((const unsigned char*)Y + (size_t)r0 * D) + F.lane; const unsigned* y1 = (const unsigned*)((const unsigned char*)Y + (size_t)r1 * D) + F.lane;
#else
            const unsigned long long* y0 = (const unsigned long long*)(Y + (size_t)r0 * D) + F.lane; const unsigned long long* y1 = (const unsigned long long*)(Y + (size_t)r1 * D) + F.lane;
#endif
#pragma unroll
            for (int j = 0; j < 4; ++j) { xa[k][j] = xs[64 * j]; ya[k][j] = y0[64 * j]; yb[k][j] = y1[64 * j]; } }
#pragma unroll
        for (int k = 0; k < 4; ++k) {
            const int t = tb + k * NGW; if (t >= T) break;
            f32x4 v[4]; float s = 0.f;
#pragma unroll
            for (int j = 0; j < 4; ++j) { const unsigned long long a = ya[k][j], b = yb[k][j], x = xa[k][j]; const unsigned al = (unsigned)a, ah = (unsigned)(a >> 32), bl = (unsigned)b, bh = (unsigned)(b >> 32), xl = (unsigned)x, xh = (unsigned)(x >> 32);
                f32x4 va, vb;
                if (OUT_FP8_Y) { va = fp8x4_to_f32(al) * (1.0f / OUT_SCALE); vb = fp8x4_to_f32(bl) * (1.0f / OUT_SCALE); (void)ah; (void)bh; }
                else { va = (f32x4){bflo(al), bfhi(al), bflo(ah), bfhi(ah)}; vb = (f32x4){bflo(bl), bfhi(bl), bflo(bh), bfhi(bh)}; }
                const f32x4 xv = (f32x4){bflo(xl), bfhi(xl), bflo(xh), bfhi(xh)};
                v[j] = xv * ALPHA + (va * w[k].x + vb * w[k].y); s += (v[j].x + v[j].y) + (v[j].z + v[j].w); }
            float s2 = 0.f;
#pragma unroll
            for (int j = 0; j < 4; ++j) s2 += (v[j].x * v[j].x + v[j].y * v[j].y) + (v[j].z * v[j].z + v[j].w * v[j].w);
            const float mean = wave_sum(s) * (1.f / D);
            const float rstd = __builtin_amdgcn_rsqf(fmaxf(wave_sum(s2) * (1.f / D) - mean * mean, 0.f) + LN_EPS);
            unsigned long long* xs = (unsigned long long*)(XSO + (size_t)t * D) + F.lane;
#pragma unroll
            for (int j = 0; j < 4; ++j) { v[j] = (v[j] - mean) * rstd * gg[j] + bb[j]; if (!out) pg8::st8(xs + 64 * j, (pg8::u32x2w){pk2(v[j].x, v[j].y), pk2(v[j].z, v[j].w)}); }
            if (XS8) { unsigned* o4 = (unsigned*)(XS8 + (size_t)t * D) + F.lane;
#pragma unroll
                for (int j = 0; j < 4; ++j) { unsigned w = __builtin_amdgcn_cvt_pk_fp8_f32(v[j].x, v[j].y, 0, false); w = __builtin_amdgcn_cvt_pk_fp8_f32(v[j].z, v[j].w, w, true); pg8::st4(o4 + 64 * j, w); } }
            if (out) { f32x4* o4 = (f32x4*)(out + (size_t)t * D) + F.lane;
#pragma unroll
                for (int j = 0; j < 4; ++j) pg8::st16(o4 + 64 * j, __builtin_bit_cast(pg8::u32x4, v[j])); }
        }
    }
}

__device__ __forceinline__ void ph_attn_slow(Frame& F, const bf16* Q, const bf16* K, const bf16* V, const float* relb  , float* O12) {
    LAS float* Ks = (LAS float*)(F.lds + RING_OFF);
    LAS float* Vs = Ks + 32 * 64;
    LAS float* bt = Vs + 32 * 128;
    const int r = F.tid & 255, vh = F.tid >> 8;
    for (int U = F.bid; U < 1024; U += F.G) {
        const int rnd = U >> 8, v = U & 255, bch = v >> 3, s = v & 7;
        const int qt = rnd == 0 ? s : rnd == 1 ? 15 - s : rnd == 2 ? 16 + s : 31 - s;
        const int b = bch >> 4, comp = (bch >> 3) & 1, h = bch & 7;
        __syncthreads();
        if (F.tid < 128) bt[F.tid] = relb[(int)c_bucket[F.tid] * NH + h];
        const float bfar = relb[31 * NH + h];
        const int i = qt * 256 + r; const size_t row = (size_t)b * SEQ + i;
        float q[64];
        { const v4u* qp = (const v4u*)(Q + row * 1024 + comp * 512 + h * 64);
#pragma unroll
          for (int d8 = 0; d8 < 8; ++d8) { const v4u w = qp[d8]; q[8 * d8 + 0] = bflo(w.x) * 0.125f; q[8 * d8 + 1] = bfhi(w.x) * 0.125f; q[8 * d8 + 2] = bflo(w.y) * 0.125f; q[8 * d8 + 3] = bfhi(w.y) * 0.125f;
              q[8 * d8 + 4] = bflo(w.z) * 0.125f; q[8 * d8 + 5] = bfhi(w.z) * 0.125f; q[8 * d8 + 6] = bflo(w.w) * 0.125f; q[8 * d8 + 7] = bfhi(w.w) * 0.125f; } }
        float o[64];
#pragma unroll
        for (int d = 0; d < 64; ++d) o[d] = 0.f;
        float m = -INFINITY, l = 0.f;
        const int nkt = (qt * 256 + 256) / 32;
        for (int kt = 0; kt < nkt; ++kt) {
            __syncthreads();
            { const int kk = F.tid >> 4, c = F.tid & 15; const size_t krow = (size_t)b * SEQ + kt * 32 + kk;
              const unsigned long long kw = *(const unsigned long long*)(K + krow * 1024 + comp * 512 + h * 64 + c * 4);
              LAS float* kd = Ks + kk * 64 + c * 4; kd[0] = bflo((unsigned)kw); kd[1] = bfhi((unsigned)kw); kd[2] = bflo((unsigned)(kw >> 32)); kd[3] = bfhi((unsigned)(kw >> 32));
              const v4u vw = *(const v4u*)(V + krow * 1024 + h * 128 + c * 8);
              LAS float* vd = Vs + kk * 128 + c * 8; vd[0] = bflo(vw.x); vd[1] = bfhi(vw.x); vd[2] = bflo(vw.y); vd[3] = bfhi(vw.y); vd[4] = bflo(vw.z); vd[5] = bfhi(vw.z); vd[6] = bflo(vw.w); vd[7] = bfhi(vw.w); }
            __syncthreads();
            if (kt * 32 <= i) {
                for (int jj = 0; jj < 32; ++jj) {
                    const int j = kt * 32 + jj;
                    if (j <= i) {
                        const LAS f32x4* kp = (const LAS f32x4*)(Ks + jj * 64);
                        float sc = 0.f;
#pragma unroll
                        for (int d4 = 0; d4 < 16; ++d4) { const f32x4 kv = kp[d4]; sc += (q[4 * d4] * kv.x + q[4 * d4 + 1] * kv.y) + (q[4 * d4 + 2] * kv.z + q[4 * d4 + 3] * kv.w); }
                        const int n = i - j; sc += (n < 128) ? bt[n] : bfar;
                        if (sc > m) { const float f = __expf(m - sc); l *= f;
#pragma unroll
                            for (int d = 0; d < 64; ++d) o[d] *= f;
                            m = sc; }
                        const float p = __expf(sc - m); l += p;
                        const LAS f32x4* vp = (const LAS f32x4*)(Vs + jj * 128 + vh * 64);
#pragma unroll
                        for (int d4 = 0; d4 < 16; ++d4) { const f32x4 vv = vp[d4]; o[4 * d4] += p * vv.x; o[4 * d4 + 1] += p * vv.y; o[4 * d4 + 2] += p * vv.z; o[4 * d4 + 3] += p * vv.w; }
                    }
                }
            }
        }
        const float il = 1.0f / l;
        f32x4* op = (f32x4*)(O12 + (size_t)comp * T * 1024 + row * 1024 + h * 128 + vh * 64);
#pragma unroll
        for (int d4 = 0; d4 < 16; ++d4) op[d4] = (f32x4){o[4 * d4] * il, o[4 * d4 + 1] * il, o[4 * d4 + 2] * il, o[4 * d4 + 3] * il};
    }
    __syncthreads();
}

__device__ __forceinline__ void ph_subln(Frame& F, const void* O12, const float* lamp  , const float* sg  , int layer, bf16* U) {
    const float linit = 0.8f - 0.6f * expf(-0.3f * (float)layer);
    const float a = wave_sum(lamp[F.lane] * lamp[64 + F.lane]), b = wave_sum(lamp[128 + F.lane] * lamp[192 + F.lane]);
    const float lam = expf(a) - expf(b) + linit;
    const f32x4 g4 = *((const f32x4*)sg + (F.lane & 31));
    const int gw = F.vcu * NWAVES + F.wave, NGW = F.G * NWAVES;
    for (int t = gw; t < T; t += NGW) {
        unsigned long long* o8 = (unsigned long long*)(U + (size_t)t * D) + F.lane;
#pragma unroll
        for (int j = 0; j < 4; ++j) {
#if ATTN_SLOW
            const f32x4* p1 = (const f32x4*)((const float*)O12 + (size_t)t * 1024) + F.lane; const f32x4* p2 = (const f32x4*)((const float*)O12 + (size_t)T * 1024 + (size_t)t * 1024) + F.lane;
            f32x4 v = p1[64 * j] - p2[64 * j] * lam;
#else
            const unsigned long long q1 = *((const unsigned long long*)((const bf16*)O12 + (size_t)t * 1024) + F.lane + 64 * j), q2 = *((const unsigned long long*)((const bf16*)O12 + (size_t)T * 1024 + (size_t)t * 1024) + F.lane + 64 * j);
            const f32x4 x1 = (f32x4){bflo((unsigned)q1), bfhi((unsigned)q1), bflo((unsigned)(q1 >> 32)), bfhi((unsigned)(q1 >> 32))}, x2 = (f32x4){bflo((unsigned)q2), bfhi((unsigned)q2), bflo((unsigned)(q2 >> 32)), bfhi((unsigned)(q2 >> 32))};
            f32x4 v = x1 - x2 * lam;
#endif
            float ss = (v.x * v.x + v.y * v.y) + (v.z * v.z + v.w * v.w);
#pragma unroll
            for (int o = 1; o < 32; o <<= 1) ss += __shfl_xor(ss, o);
            const float rs = (1.0f / sqrtf(ss * (1.f / VD) + LN_EPS)) * (1.0f - linit);
            v = v * rs * g4; pg8::st8(o8 + 64 * j, (pg8::u32x2w){pk2(v.x, v.y), pk2(v.z, v.w)}); }
    }
}

namespace pg8 {
struct EpiLnMix {
    static constexpr bool PERM = false, AFTER_DRAIN = true;
    bf16_t* XS; int ldc; const float* bias; const float* g; const float* b; float alpha; PanelStats st; unsigned poison;
    __device__ __forceinline__ void fused(f32x4 (&acc)[2][2][4][2], const Unit& u, int wr, int wc, int fr, int fq, PG8_LAS unsigned char* lds, int wid, int lane) const {
        typedef float f32x2v __attribute__((ext_vector_type(2))); typedef unsigned u32x2v __attribute__((ext_vector_type(2)));
        const PG8_LAS f32x2v* S = (const PG8_LAS f32x2v*)(lds + 8192);
        const int col0 = u.pn * BM + wc * 32 + 4 * fq;
#pragma unroll
        for (int bj = 0; bj < 2; ++bj)
#pragma unroll
            for (int n = 0; n < 2; ++n) { const f32x4 bv = bias ? *(const f32x4*)(bias + col0 + bj * HALF + n * 16) : (f32x4){0.f, 0.f, 0.f, 0.f};
#pragma unroll
                for (int ai = 0; ai < 2; ++ai)
#pragma unroll
                    for (int m = 0; m < 4; ++m) acc[ai][bj][m][n] += bv; }
#pragma unroll
        for (int ai = 0; ai < 2; ++ai)
#pragma unroll
            for (int m = 0; m < 4; ++m) { const size_t off = (size_t)(u.pm * BM + ai * HALF + wr * 64 + m * 16 + fr) * ldc + col0;
#pragma unroll
                for (int bj = 0; bj < 2; ++bj)
#pragma unroll
                    for (int n = 0; n < 2; ++n) { const u32x2v w = *(const u32x2v*)(XS + off + bj * HALF + n * 16);
                        const f32x4 xv = (f32x4){__builtin_bit_cast(float, w.x << 16), __builtin_bit_cast(float, w.x & 0xffff0000u), __builtin_bit_cast(float, w.y << 16), __builtin_bit_cast(float, w.y & 0xffff0000u)};
                        acc[ai][bj][m][n] += xv * alpha; }
                asm volatile("" : "+v"(acc[ai][0][m][0]), "+v"(acc[ai][0][m][1]), "+v"(acc[ai][1][m][0]), "+v"(acc[ai][1][m][1]));
                if (m & 1) asm volatile("" ::: "memory"); }
        const bool bad = st.run(acc, u, wr, wc, fr, fq, lds, wid, lane) || poison != 0u;
        f32x4 gv[2][2], bv2[2][2];
#pragma unroll
        for (int bj = 0; bj < 2; ++bj)
#pragma unroll
            for (int n = 0; n < 2; ++n) { gv[bj][n] = *(const f32x4*)(g + col0 + bj * HALF + n * 16); bv2[bj][n] = *(const f32x4*)(b + col0 + bj * HALF + n * 16); }
#pragma unroll
        for (int ai = 0; ai < 2; ++ai)
#pragma unroll
            for (int m = 0; m < 4; ++m) { const int r = ai * HALF + wr * 64 + m * 16 + fr; const f32x2v sr = S[r]; const size_t off = (size_t)(u.pm * BM + r) * ldc + col0;
#pragma unroll
                for (int bj = 0; bj < 2; ++bj)
#pragma unroll
                    for (int n = 0; n < 2; ++n) { const f32x4 o = (acc[ai][bj][m][n] - sr.x) * sr.y * gv[bj][n] + bv2[bj][n]; u32x2v w; w.x = cvt_pk_bf16(o[0], o[1]); w.y = cvt_pk_bf16(o[2], o[3]);
                        if (bad) { w.x = 0x7fc07fc0u; w.y = 0x7fc07fc0u; } *(u32x2v*)(XS + off + bj * HALF + n * 16) = w; } }
    }
};
}
namespace pg8 {
struct EpiF8B {
    static constexpr bool PERM = true, AFTER_DRAIN = false;
    unsigned char* O; int ldc; const float* bias; float in_scale, out_scale;
    __device__ __forceinline__ void operator()(const f32x4 (&acc)[2][2][4][2], const Unit& u, int wr, int wc, int fr, int fq) const {
        const int row0 = u.pm * BM + wr * 64 + fr, col0 = u.pn * BM + wc * 32 + 8 * fq;
        f32x4 bv[2][2];
#pragma unroll
        for (int bj = 0; bj < 2; ++bj)
#pragma unroll
            for (int n = 0; n < 2; ++n) bv[bj][n] = bias ? *(const f32x4*)(bias + col0 + bj * HALF + 4 * n) : (f32x4){0.f, 0.f, 0.f, 0.f};
#pragma unroll
        for (int ai = 0; ai < 2; ++ai)
#pragma unroll
            for (int m = 0; m < 4; ++m) { unsigned char* rowp = O + (size_t)(row0 + ai * HALF + m * 16) * ldc + col0;
#pragma unroll
                for (int bj = 0; bj < 2; ++bj) { const f32x4 v0 = (acc[ai][bj][m][0] * in_scale + bv[bj][0]) * out_scale, v1 = (acc[ai][bj][m][1] * in_scale + bv[bj][1]) * out_scale;
                    u32x2w w; w.x = __builtin_amdgcn_cvt_pk_fp8_f32(v0[0], v0[1], 0, false); w.x = __builtin_amdgcn_cvt_pk_fp8_f32(v0[2], v0[3], w.x, true);
                    w.y = __builtin_amdgcn_cvt_pk_fp8_f32(v1[0], v1[1], 0, false); w.y = __builtin_amdgcn_cvt_pk_fp8_f32(v1[2], v1[3], w.y, true);
                    st8(rowp + bj * HALF, w); } }
    }
};
struct EpiF8QK {
    static constexpr bool PERM = true, AFTER_DRAIN = false;
    unsigned char* O; long koff; float qscale, kscale;
    __device__ __forceinline__ void operator()(const f32x4 (&acc)[2][2][4][2], const Unit& u, int wr, int wc, int fr, int fq) const {
        const int row0 = u.pm * BM + wr * 64 + fr; int colt = u.pn * BM; const int t = colt >> 10; unsigned char* base = O + (long)(t > 0) * koff; colt -= t << 10;
        const int col0 = colt + wc * 32 + 8 * fq; const float sc = t == 0 ? qscale : kscale;
#pragma unroll
        for (int ai = 0; ai < 2; ++ai)
#pragma unroll
            for (int m = 0; m < 4; ++m) { unsigned char* rowp = base + (size_t)(row0 + ai * HALF + m * 16) * 1024 + col0;
#pragma unroll
                for (int bj = 0; bj < 2; ++bj) { const f32x4 v0 = acc[ai][bj][m][0] * sc, v1 = acc[ai][bj][m][1] * sc;
                    u32x2w w; w.x = __builtin_amdgcn_cvt_pk_fp8_f32(v0[0], v0[1], 0, false); w.x = __builtin_amdgcn_cvt_pk_fp8_f32(v0[2], v0[3], w.x, true);
                    w.y = __builtin_amdgcn_cvt_pk_fp8_f32(v1[0], v1[1], 0, false); w.y = __builtin_amdgcn_cvt_pk_fp8_f32(v1[2], v1[3], w.y, true);
                    st8(rowp + bj * HALF, w); } }
    }
};
struct EpiVT8 {
    static constexpr bool PERM = true, AFTER_DRAIN = false;
    unsigned char* O; int ldc; float scale;
    __device__ __forceinline__ void operator()(const f32x4 (&acc)[2][2][4][2], const Unit& u, int wr, int wc, int fr, int fq) const {
        const int row0 = u.pm * BM + wr * 64 + fr;
        const int cbase = u.pn * BM + 64 * (wc >> 1), pos0 = 16 * (wc & 1) + 4 * fq;
#pragma unroll
        for (int ai = 0; ai < 2; ++ai)
#pragma unroll
            for (int m = 0; m < 4; ++m) { unsigned char* rowp = O + (size_t)(row0 + ai * HALF + m * 16) * ldc + cbase + pos0;
#pragma unroll
                for (int bj = 0; bj < 2; ++bj) { const f32x4 v0 = acc[ai][bj][m][0] * scale, v1 = acc[ai][bj][m][1] * scale;
                    unsigned w0 = __builtin_amdgcn_cvt_pk_fp8_f32(v0[0], v0[1], 0, false); w0 = __builtin_amdgcn_cvt_pk_fp8_f32(v0[2], v0[3], w0, true);
                    unsigned w1 = __builtin_amdgcn_cvt_pk_fp8_f32(v1[0], v1[1], 0, false); w1 = __builtin_amdgcn_cvt_pk_fp8_f32(v1[2], v1[3], w1, true);
                    st4(rowp + bj * HALF, w0); st4(rowp + bj * HALF + 32, w1); } }
    }
};
struct EpiBf16SB {
    static constexpr bool PERM = true, AFTER_DRAIN = false;
    bf16_t* O; int ldc; const float* bias; float scale;
    __device__ __forceinline__ void operator()(const f32x4 (&acc)[2][2][4][2], const Unit& u, int wr, int wc, int fr, int fq) const {
        const int row0 = u.pm * BM + wr * 64 + fr, col0 = u.pn * BM + wc * 32 + 8 * fq;
        f32x4 bv[2][2];
#pragma unroll
        for (int bj = 0; bj < 2; ++bj)
#pragma unroll
            for (int n = 0; n < 2; ++n) bv[bj][n] = bias ? *(const f32x4*)(bias + col0 + bj * HALF + 4 * n) : (f32x4){0.f, 0.f, 0.f, 0.f};
#pragma unroll
        for (int ai = 0; ai < 2; ++ai)
#pragma unroll
            for (int m = 0; m < 4; ++m) { bf16_t* rowp = O + (size_t)(row0 + ai * HALF + m * 16) * ldc + col0;
#pragma unroll
                for (int bj = 0; bj < 2; ++bj) { const f32x4 v0 = acc[ai][bj][m][0] * scale + bv[bj][0], v1 = acc[ai][bj][m][1] * scale + bv[bj][1];
                    u32x4 w; w.x = cvt_pk_bf16(v0[0], v0[1]); w.y = cvt_pk_bf16(v0[2], v0[3]); w.z = cvt_pk_bf16(v1[0], v1[1]); w.w = cvt_pk_bf16(v1[2], v1[3]);
                    st16(rowp + bj * HALF, w); } }
    }
};
struct EpiBf16S {
    static constexpr bool PERM = true, AFTER_DRAIN = false;
    bf16_t* O; int ldc; float scale;
    __device__ __forceinline__ void operator()(const f32x4 (&acc)[2][2][4][2], const Unit& u, int wr, int wc, int fr, int fq) const {
        const int row0 = u.pm * BM + wr * 64 + fr, col0 = u.pn * BM + wc * 32 + 8 * fq;
#pragma unroll
        for (int ai = 0; ai < 2; ++ai)
#pragma unroll
            for (int m = 0; m < 4; ++m) { bf16_t* rowp = O + (size_t)(row0 + ai * HALF + m * 16) * ldc + col0;
#pragma unroll
                for (int bj = 0; bj < 2; ++bj) { const f32x4 v0 = acc[ai][bj][m][0] * scale, v1 = acc[ai][bj][m][1] * scale;
                    u32x4 w; w.x = cvt_pk_bf16(v0[0], v0[1]); w.y = cvt_pk_bf16(v0[2], v0[3]); w.z = cvt_pk_bf16(v1[0], v1[1]); w.w = cvt_pk_bf16(v1[2], v1[3]);
                    st16(rowp + bj * HALF, w); } }
    }
};
struct EpiGated8 {
    static constexpr bool PERM = true, AFTER_DRAIN = false;
    unsigned char* O; int ldc; float in_scale, out_scale;
    __device__ __forceinline__ void operator()(const f32x4 (&acc)[2][2][4][2], const Unit& u, int wr, int wc, int fr, int fq) const {
        typedef unsigned u32x2v __attribute__((ext_vector_type(2)));
        const int row0 = u.pm * BM + wr * 64 + fr, col0 = u.pn * HALF + wc * 32 + 8 * fq;
#pragma unroll
        for (int ai = 0; ai < 2; ++ai)
#pragma unroll
            for (int m = 0; m < 4; ++m) { unsigned char* rowp = O + (size_t)(row0 + ai * HALF + m * 16) * ldc + col0; f32x4 r[2];
#pragma unroll
                for (int n = 0; n < 2; ++n) { const f32x4 x = acc[ai][0][m][n] * in_scale, y = acc[ai][1][m][n] * in_scale;
                    f32x4 sg; sg.x = __builtin_amdgcn_rcpf(1.0f + __builtin_amdgcn_exp2f(x.x * -1.4426950408889634f)); sg.y = __builtin_amdgcn_rcpf(1.0f + __builtin_amdgcn_exp2f(x.y * -1.4426950408889634f));
                    sg.z = __builtin_amdgcn_rcpf(1.0f + __builtin_amdgcn_exp2f(x.z * -1.4426950408889634f)); sg.w = __builtin_amdgcn_rcpf(1.0f + __builtin_amdgcn_exp2f(x.w * -1.4426950408889634f));
                    r[n] = x * sg * y * out_scale; }
                u32x2v w; w.x = __builtin_amdgcn_cvt_pk_fp8_f32(r[0][0], r[0][1], 0, false); w.x = __builtin_amdgcn_cvt_pk_fp8_f32(r[0][2], r[0][3], w.x, true);
                w.y = __builtin_amdgcn_cvt_pk_fp8_f32(r[1][0], r[1][1], 0, false); w.y = __builtin_amdgcn_cvt_pk_fp8_f32(r[1][2], r[1][3], w.y, true);
                st8(rowp, (u32x2w){w.x, w.y}); }
    }
};
template <int MODE> struct EpiGated {
    static constexpr bool PERM = true, AFTER_DRAIN = false;
    bf16_t* O; int ldc; const float* bias; int second_off; float in_scale;
    __device__ __forceinline__ void operator()(const f32x4 (&acc)[2][2][4][2], const Unit& u, int wr, int wc, int fr, int fq) const {
        const int row0 = u.pm * BM + wr * 64 + fr, col0 = u.pn * HALF + wc * 32 + 8 * fq;
        f32x4 b0[2], b1[2];
#pragma unroll
        for (int n = 0; n < 2; ++n) { b0[n] = (MODE == 0) ? *(const f32x4*)(bias + col0 + 4 * n) : (f32x4){0.f, 0.f, 0.f, 0.f}; b1[n] = (MODE == 0) ? *(const f32x4*)(bias + second_off + col0 + 4 * n) : (f32x4){0.f, 0.f, 0.f, 0.f}; }
#pragma unroll
        for (int ai = 0; ai < 2; ++ai)
#pragma unroll
            for (int m = 0; m < 4; ++m) { bf16_t* rowp = O + (size_t)(row0 + ai * HALF + m * 16) * ldc + col0; f32x4 r[2];
#pragma unroll
                for (int n = 0; n < 2; ++n) { const f32x4 x = acc[ai][0][m][n] * in_scale + b0[n], y = acc[ai][1][m][n] * in_scale + b1[n]; const f32x4 z = (MODE == 0) ? y : x;
                    f32x4 sg; sg.x = __builtin_amdgcn_rcpf(1.0f + __builtin_amdgcn_exp2f(z.x * -1.4426950408889634f)); sg.y = __builtin_amdgcn_rcpf(1.0f + __builtin_amdgcn_exp2f(z.y * -1.4426950408889634f));
                    sg.z = __builtin_amdgcn_rcpf(1.0f + __builtin_amdgcn_exp2f(z.z * -1.4426950408889634f)); sg.w = __builtin_amdgcn_rcpf(1.0f + __builtin_amdgcn_exp2f(z.w * -1.4426950408889634f));
                    r[n] = (MODE == 0) ? x * sg : x * sg * y; }
                u32x4 w; w.x = cvt_pk_bf16(r[0][0], r[0][1]); w.y = cvt_pk_bf16(r[0][2], r[0][3]); w.z = cvt_pk_bf16(r[1][0], r[1][1]); w.w = cvt_pk_bf16(r[1][2], r[1][3]);
                st16(rowp, w); }
    }
};
struct EpiBf16Split {
    static constexpr bool PERM = true, AFTER_DRAIN = false;
    bf16_t* O0; long d1, d2; float scale0, in_scale;
    __device__ __forceinline__ void operator()(const f32x4 (&acc)[2][2][4][2], const Unit& u, int wr, int wc, int fr, int fq) const {
        const int row0 = u.pm * BM + wr * 64 + fr; int colt = u.pn * BM; const int t = colt >> 10; bf16_t* base = O0 + (long)(t > 0) * d1 + (long)(t > 1) * d2; colt -= t << 10;
        const int col0 = colt + wc * 32 + 8 * fq; const float sc = (t == 0 ? scale0 : 1.f) * in_scale;
#pragma unroll
        for (int ai = 0; ai < 2; ++ai)
#pragma unroll
            for (int m = 0; m < 4; ++m) { bf16_t* rowp = base + (size_t)(row0 + ai * HALF + m * 16) * 1024 + col0;
#pragma unroll
                for (int bj = 0; bj < 2; ++bj) { const f32x4 v0 = acc[ai][bj][m][0] * sc, v1 = acc[ai][bj][m][1] * sc;
                    u32x4 w; w.x = cvt_pk_bf16(v0[0], v0[1]); w.y = cvt_pk_bf16(v0[2], v0[3]); w.z = cvt_pk_bf16(v1[0], v1[1]); w.w = cvt_pk_bf16(v1[2], v1[3]);
                    st16(rowp + bj * HALF, w); } }
    }
};
}

constexpr int PH_PER_LAYER = 16, N_PHASES = 1 + NLAYER * PH_PER_LAYER;

#ifndef PROBE_DUP
#define PROBE_DUP 0
#endif
#if PROBE_DUP == 20
#define PROBE_EXTRA_BAR(b) do { xcd_barrier(b); xcd_barrier(b); } while (0)
#elif PROBE_DUP == 21 || PROBE_DUP == 22 || PROBE_DUP == 23
#define PROBE_EXTRA_BAR(b) do { xcd_barrier_nofence(b); xcd_barrier_nofence(b); } while (0)
#else
#define PROBE_EXTRA_BAR(b) do {} while (0)
#endif
#define NREP(c) ((PROBE_DUP == (c)) ? 2 : 1)
#define IN(k) (lo <= (k) && (k) < hi)
#define SEAM(k) do { if ((k) + 1 < hi) { XcdBarrier b_; b_.bar = (unsigned*)(kargs()->ws + WS_CTL) + CW_BAR; b_.x = xb_xcc_id(); b_.st = (volatile LAS unsigned*)(F.lds + LDSCTL_OFF) + 8; xcd_barrier(b_); PROBE_EXTRA_BAR(b_); } } while (0)
#define FRESH() do { int t_ = threadIdx.x; asm volatile("" : "+v"(t_)); F.tid = t_; F.lane = t_ & 63; F.wave = __builtin_amdgcn_readfirstlane(t_ >> 6); int b_ = blockIdx.x, g_ = gridDim.x; asm volatile("" : "+s"(b_), "+s"(g_)); F.bid = b_; F.G = g_; F.vcu = (g_ % 8 == 0) ? (b_ % 8) * (g_ / 8) + b_ / 8 : b_; } while (0)

#define WSP (kargs()->ws)
#define XBF ((bf16*)(WSP + WS_XBF))
#define MIX ((float*)(WSP + WS_MIX))
#define KB ((bf16*)(WSP + WS_KB))
#define VB ((bf16*)(WSP + WS_VB))
#define tok_e ((int2*)(WSP + WS_ROUT))
#define tok_pos (((int2*)(WSP + WS_ROUT)) + T)
#define tok_w ((float2*)(((int2*)(WSP + WS_ROUT)) + 2 * T))
#define OUTP (kargs()->out)
#define elist_ ((int*)(WSP + WS_ROUT + 512 * 1024))
template <int l> __device__ __forceinline__ void run_layer(Frame& F, const int lo, const int hi, unsigned char* lds) {
        const int pb = 1 + l * PH_PER_LAYER;
        #define cnt ((unsigned*)(WSP + WS_CTL) + CW_CNT + l * NE * 64)
        if (l < NSELF) {
            if (IN(pb + 1)) for (int rep_ = 0; rep_ < NREP(2); ++rep_) { FRESH();
#if DENSE_FP8_S1
                pg8::Gemm g{(const bf16*)(WSP + WS_XS8), (const bf16*)(WSP + WS_PW1T + (size_t)l * 2 * D * D), T, 2 * D, D / 2}; pg8::StaticOrder S; S.init(T, 2 * D, F.G, F.bid);
                pg8::EpiGated<0> E{(bf16*)(WSP + WS_H1), D, INP(2) + (size_t)l * 2 * D, D, 1.0f / WX_SCALE};
                pg8::gemm_phase<pg8::EpiGated<0>, pg8::StaticOrder, true, true, false, true>(F.lds + RING_OFF, g, S, E);
#else
                pg8::Gemm g{XBF, (const bf16*)(WSP + WS_PW1T) + (size_t)l * 2 * D * D, T, 2 * D, D}; pg8::StaticOrder S; S.init(T, 2 * D, F.G, F.bid);
                pg8::EpiGated<0> E{(bf16*)(WSP + WS_H1), D, INP(2) + (size_t)l * 2 * D, D, 1.f};
                pg8::gemm_phase<pg8::EpiGated<0>, pg8::StaticOrder, true, true>(F.lds + RING_OFF, g, S, E);
#endif
                SEAM(pb + 1);
            }
            if (IN(pb + 2)) for (int rep_ = 0; rep_ < NREP(4); ++rep_) { FRESH(); ph_conv(F, (const bf16*)(WSP + WS_H1), INP(3) + (size_t)l * CONVW * D, INP(4) + (size_t)l * D, INP(5) + (size_t)l * D, INP(6) + (size_t)l * D, (bf16*)(WSP + WS_US)); SEAM(pb + 2); }
            if (IN(pb + 4)) for (int rep_ = 0; rep_ < NREP(2); ++rep_) { FRESH();
                pg8::Gemm g{(const bf16*)(WSP + WS_US), (const bf16*)(WSP + WS_PW2T) + (size_t)l * D * D, T, D, D}; pg8::StaticOrder S; S.init(T, D, F.G, F.bid);
#if LN_FUSED
                pg8::PanelStats st{(unsigned*)(WSP + WS_XCH + (size_t)l * 512 * 1024), (unsigned*)(WSP + WS_CTL) + CW_SEAM + l * 64 * 64, (unsigned*)(WSP + WS_CTL) + CW_TMO, D / 256, LN_EPS, 0x700u + 16u * l};
                pg8::EpiLnMix E{XBF, D, INP(8) + (size_t)l * D, INP(15) + (size_t)l * D, INP(16) + (size_t)l * D, ALPHA, st, 0u};
                pg8::gemm_phase<pg8::EpiLnMix, pg8::StaticOrder, false, true>(F.lds + RING_OFF, g, S, E);
#elif DENSE_FP8_S3
                { (void)g; pg8::Gemm g8{(const bf16*)(WSP + WS_US), (const bf16*)(WSP + WS_PW2T + (size_t)l * D * D), T, D, D / 2};
                  pg8::EpiBf16SB E{(bf16*)MIX, D, INP(8) + (size_t)l * D, 1.0f / (WX_SCALE * U_SCALE)};
                  pg8::gemm_phase<pg8::EpiBf16SB, pg8::StaticOrder, true, true, false, true>(F.lds + RING_OFF, g8, S, E); }
#else
#if OUT_FP8_MIX
                pg8::EpiF8B E{(unsigned char*)MIX, D, INP(8) + (size_t)l * D, 1.f, OUT_SCALE};
                pg8::gemm_phase<pg8::EpiF8B, pg8::StaticOrder, true, true>(F.lds + RING_OFF, g, S, E);
#else
                pg8::EpiBf16<0> E{(bf16*)MIX, D, INP(8) + (size_t)l * D, 0, 0, 1.f};
                pg8::gemm_phase<pg8::EpiBf16<0>, pg8::StaticOrder, true, true>(F.lds + RING_OFF, g, S, E);
#endif
#endif
                SEAM(pb + 4);
            }
        } else {
            const int j = l - NSELF;
            if (IN(pb + 1)) for (int rep_ = 0; rep_ < NREP(2); ++rep_) { FRESH();
                const int N = (j == 0) ? 3 * D : D;
#if ATTN_FP8
                { const int N1 = (j == 0) ? 2 * D : D;
                  pg8::Gemm g{(const bf16*)(WSP + WS_XS8), (const bf16*)(WSP + (j == 0 ? WS_WQ0T : WS_WQ1T)), T, N1, D / 2}; pg8::StaticOrder S; S.init(T, N1, F.G, F.bid);
                  pg8::EpiF8QK E{(unsigned char*)(WSP + WS_Q), (long)WS_KB - (long)WS_Q, ATTN_QSCALE * 8.f / WX_SCALE, 0.125f / WX_SCALE};
                  pg8::gemm_phase<pg8::EpiF8QK, pg8::StaticOrder, true, true, false, true>(F.lds + RING_OFF, g, S, E); }
                if (j == 0) {
                  int kq_ = D / 2; asm volatile("" : "+s"(kq_));
                  pg8::Gemm g{(const bf16*)(WSP + WS_WQ0T + 2 * (size_t)D * D), (const bf16*)(WSP + WS_XS8), D, T, kq_}; pg8::StaticOrder S; S.init(D, T, F.G, F.bid);
                  pg8::EpiVT8 E{(unsigned char*)(WSP + WS_VB), T, 1.f / WX_SCALE};
                  pg8::gemm_phase<pg8::EpiVT8, pg8::StaticOrder, true, true, false, true>(F.lds + RING_OFF, g, S, E); }
#elif DENSE_FP8_C1
                pg8::Gemm g{(const bf16*)(WSP + WS_XS8), (const bf16*)(WSP + (j == 0 ? WS_WQ0T : WS_WQ1T)), T, N, D / 2}; pg8::StaticOrder S; S.init(T, N, F.G, F.bid);
                pg8::EpiBf16Split E3{(bf16*)(WSP + WS_Q), ((long)WS_KB - (long)WS_Q) / 2, ((long)WS_VB - (long)WS_KB) / 2, ATTN_QSCALE, 1.0f / WX_SCALE};
                pg8::gemm_phase<pg8::EpiBf16Split, pg8::StaticOrder, true, true, false, true>(F.lds + RING_OFF, g, S, E3);
#else
                pg8::Gemm g{XBF, (const bf16*)(WSP + (j == 0 ? WS_WQ0T : WS_WQ1T)), T, N, D}; pg8::StaticOrder S; S.init(T, N, F.G, F.bid);
                pg8::EpiBf16Split E3{(bf16*)(WSP + WS_Q), ((long)WS_KB - (long)WS_Q) / 2, ((long)WS_VB - (long)WS_KB) / 2, ATTN_QSCALE, 1.f};
                pg8::gemm_phase<pg8::EpiBf16Split, pg8::StaticOrder, true, true>(F.lds + RING_OFF, g, S, E3);
#endif
                SEAM(pb + 1);
            }
            if (IN(pb + 2)) for (int rep_ = 0; rep_ < NREP(3); ++rep_) { FRESH();
#if ATTN_SLOW
                ph_attn_slow(F, (const bf16*)(WSP + WS_Q), KB, VB, INP(14), (float*)(WSP + WS_O12));
#else
#if ATTN_FP8
                { const float* lamp = INP(11) + (size_t)j * 4 * HD; const float linit = 0.8f - 0.6f * expf(-0.3f * (float)l);
                  const float la = wave_sum(lamp[F.lane] * lamp[64 + F.lane]), lb = wave_sum(lamp[128 + F.lane] * lamp[192 + F.lane]); const float lam = expf(la) - expf(lb) + linit;
                  attn8::attn_phase<8>((char*)lds + RING_OFF, (const unsigned char*)(WSP + WS_Q), (const unsigned char*)KB, (const unsigned char*)VB, (attn8::bf16*)(WSP + WS_O12), (attn8::bf16*)(WSP + WS_O12 + 32 * MiB),
                                       INP(12) + (size_t)j * VD, lam, 1.0f - linit, INP(14), F.vcu, F.G); }
#elif ATTN_DV128
                { const float* lamp = INP(11) + (size_t)j * 4 * HD; const float linit = 0.8f - 0.6f * expf(-0.3f * (float)l);
                  const float la = wave_sum(lamp[F.lane] * lamp[64 + F.lane]), lb = wave_sum(lamp[128 + F.lane] * lamp[192 + F.lane]); const float lam = expf(la) - expf(lb) + linit;
                  attn128::attn_phase<8>((char*)lds + RING_OFF, (const attn128::bf16*)(WSP + WS_Q), (const attn128::bf16*)KB, (const attn128::bf16*)VB, (attn128::bf16*)(WSP + WS_O12), (attn128::bf16*)(WSP + WS_O12 + 32 * MiB),
                                         INP(12) + (size_t)j * VD, lam, 1.0f - linit, INP(14), F.vcu, F.G); }
#else
                attn_body::attn_phase<8>((char*)lds + RING_OFF, (const attn_body::bf16*)(WSP + WS_Q), (const attn_body::bf16*)KB, (const attn_body::bf16*)VB, (attn_body::bf16*)(WSP + WS_O12), INP(14), F.vcu, F.G);
#endif
#endif
                SEAM(pb + 2); }
            if (!ATTN_DV128 && IN(pb + 3)) for (int rep_ = 0; rep_ < NREP(10); ++rep_) { FRESH(); ph_subln(F, (const void*)(WSP + WS_O12), INP(11) + (size_t)j * 4 * HD, INP(12) + (size_t)j * VD, l, (bf16*)(WSP + WS_Q)); SEAM(pb + 3); }
            if (IN(pb + 4)) for (int rep_ = 0; rep_ < NREP(2); ++rep_) { FRESH();
                pg8::Gemm g{(const bf16*)(WSP + (ATTN_DV128 ? WS_O12 + 32 * MiB : WS_Q)), (const bf16*)(WSP + WS_WOT) + (size_t)j * D * D, T, D, D}; pg8::StaticOrder S; S.init(T, D, F.G, F.bid);
#if LN_FUSED
                pg8::PanelStats st{(unsigned*)(WSP + WS_XCH + (size_t)l * 512 * 1024), (unsigned*)(WSP + WS_CTL) + CW_SEAM + l * 64 * 64, (unsigned*)(WSP + WS_CTL) + CW_TMO, D / 256, LN_EPS, 0x700u + 16u * l};
                pg8::EpiLnMix E{XBF, D, nullptr, INP(15) + (size_t)l * D, INP(16) + (size_t)l * D, ALPHA, st, 0u};
                pg8::gemm_phase<pg8::EpiLnMix, pg8::StaticOrder, false, true>(F.lds + RING_OFF, g, S, E);
#elif DENSE_FP8_C4
                { (void)g; pg8::Gemm g8{(const bf16*)(WSP + WS_O12 + 32 * MiB), (const bf16*)(WSP + WS_WOT + (size_t)j * D * D), T, D, D / 2};
                  pg8::EpiBf16SB E{(bf16*)MIX, D, nullptr, 1.0f / (WX_SCALE * U_SCALE)};
                  pg8::gemm_phase<pg8::EpiBf16SB, pg8::StaticOrder, true, true, false, true>(F.lds + RING_OFF, g8, S, E); }
#else
#if OUT_FP8_MIX
                pg8::EpiF8B E{(unsigned char*)MIX, D, nullptr, 1.f, OUT_SCALE};
                pg8::gemm_phase<pg8::EpiF8B, pg8::StaticOrder, true, true>(F.lds + RING_OFF, g, S, E);
#else
                pg8::EpiBf16<0> E{(bf16*)MIX, D, nullptr, 0, 0, 1.f};
                pg8::gemm_phase<pg8::EpiBf16<0>, pg8::StaticOrder, true, true>(F.lds + RING_OFF, g, S, E);
#endif
#endif
                SEAM(pb + 4);
            }
        }
        if (IN(pb + 5)) for (int rep_ = 0; rep_ < NREP(5); ++rep_) { FRESH();
            if (PROBE_DUP == 5 && rep_ == 0) ph_router(F, XBF, (bf16*)(WSP + WS_H1), (unsigned char*)(WSP + WS_US), (const bf16*)MIX, INP(15) + (size_t)l * D, INP(16) + (size_t)l * D, INP(19), INP(20), (const bf16*)(WSP + WS_XCH), (int2*)(WSP + WS_US + 16 * MiB), (int2*)(WSP + WS_US + 16 * MiB) + T, (float2*)((int2*)(WSP + WS_US + 16 * MiB) + 2 * T), (int*)(WSP + WS_US + 20 * MiB), (unsigned*)(WSP + WS_CTL) + 200000 + l * NE * 64);
            else ph_router(F, XBF, XBF, (unsigned char*)(WSP + WS_XS8), (const bf16*)MIX, INP(15) + (size_t)l * D, INP(16) + (size_t)l * D, INP(19), INP(20), (const bf16*)(WSP + WS_XCH), tok_e, tok_pos, tok_w, elist_, cnt, WSP, (l == 0) ? 0 : l + 1, 0, (l == 0) ? MOE_CVT_SIDE0 : (l + 1 < NLAYER ? MOE_CVT_SIDEN : 0)); SEAM(pb + 5); }
        if (IN(pb + 7)) for (int rep_ = 0; rep_ < NREP(7); ++rep_) { FRESH();
            moe_offsets(F, cnt);
            const LAS int* li = (const LAS int*)(F.lds + LDSCTL_OFF);
            moe_rowsrc(F, cnt, elist_, F.vcu);
#if MOE_FP8
            pg8::Gemm g{(const bf16*)(WSP + WS_XS8), (const bf16*)(WSP + ws_wgut(l)), XG_ROWS, 2 * DE, D / 2};
#else
            pg8::Gemm g{XBF, (const bf16*)(WSP + ws_wgut(l)), XG_ROWS, 2 * DE, D};
#endif
            GroupedOrder S{li + LI_TEXP, li[LI_NT], 4, F.G, F.vcu, (size_t)2 * DE * D * (MOE_FP8 ? 1 : 2), (const LAS unsigned*)(li + LI_ROWS)};
#if MOE_FP8
            pg8::EpiGated8 E{(unsigned char*)(WSP + WS_HH), DE, 1.0f / WG_SCALE, H_SCALE};
            pg8::gemm_phase<pg8::EpiGated8, GroupedOrder, true, true, true, true>(F.lds + RING_OFF, g, S, E);
#else
            pg8::EpiGated<1> E{(bf16*)(WSP + WS_HH), DE, nullptr, 0, 1.f};
            pg8::gemm_phase<pg8::EpiGated<1>, GroupedOrder, true, true, true>(F.lds + RING_OFF, g, S, E);
#endif
            if (l + 1 < NLAYER) moe_cvt_tail(F, WSP, l + 1, 4 * li[LI_NT], (l == 0) ? 0 : MOE_CVT_SIDEN, (l == 0) ? MOE_CVT_SPLIT : MOE_CVT_SIDEN + 2560);
            SEAM(pb + 7);
        }
        if (IN(pb + 9)) for (int rep_ = 0; rep_ < NREP(8); ++rep_) { FRESH();
            if (!IN(pb + 7)) moe_offsets(F, cnt);
            const LAS int* li = (const LAS int*)(F.lds + LDSCTL_OFF);
            int kq_ = MOE_FP8 ? DE / 2 : DE; asm volatile("" : "+s"(kq_));
            pg8::Gemm g{(const bf16*)(WSP + WS_HH), (const bf16*)(WSP + ws_wdt(l)), XG_ROWS, D, kq_};
            GroupedOrder S{li + LI_TEXP, li[LI_NT], 4, F.G, F.vcu, (size_t)D * DE * (MOE_FP8 ? 1 : 2), nullptr};
#if MOE_FP8
#if OUT_FP8_Y
            pg8::EpiF8B E{(unsigned char*)(WSP + WS_Y), D, nullptr, 1.0f / (H_SCALE * WD_SCALE), OUT_SCALE};
            pg8::gemm_phase<pg8::EpiF8B, GroupedOrder, true, true, false, true>(F.lds + RING_OFF, g, S, E);
#else
            pg8::EpiBf16S E{(bf16*)(WSP + WS_Y), D, 1.0f / (H_SCALE * WD_SCALE)};
            pg8::gemm_phase<pg8::EpiBf16S, GroupedOrder, true, true, false, true>(F.lds + RING_OFF, g, S, E);
#endif
#else
            pg8::EpiBf16<0> E{(bf16*)(WSP + WS_Y), D, nullptr, 0, 0, 1.f};
            pg8::gemm_phase<pg8::EpiBf16<0>, GroupedOrder, true, true>(F.lds + RING_OFF, g, S, E);
#endif
            if (l + 1 < NLAYER) moe_cvt_tail(F, WSP, l + 1, 4 * li[LI_NT], (l == 0) ? MOE_CVT_SPLIT : MOE_CVT_SIDEN + 2560, MOE_CVT_ITEMS);
            SEAM(pb + 9);
        }
        if (IN(pb + 10)) for (int rep_ = 0; rep_ < NREP(9); ++rep_) { FRESH(); if (!IN(pb + 7)) moe_offsets(F, cnt); { const bool dry_ = (PROBE_DUP == 9 && rep_ == 0);
            ph_combine(F, XBF, dry_ ? (bf16*)(WSP + WS_H1) : XBF, (const bf16*)(WSP + WS_Y), tok_e, tok_pos, tok_w, INP(17) + (size_t)l * D, INP(18) + (size_t)l * D, (l == NLAYER - 1) ? (dry_ ? (float*)(WSP + WS_H1) : OUTP) : (float*)nullptr, ((l + 1 < NSELF ? DENSE_FP8_S1 : DENSE_FP8_C1) && l + 1 < NLAYER) ? (unsigned char*)(WSP + (dry_ ? WS_US : WS_XS8)) : (unsigned char*)nullptr); } if (l + 1 < NLAYER) SEAM(pb + 10); }
    }

__global__ void __launch_bounds__(NTHR, 2) yoco_fwd(Args args) {
    extern __shared__ __attribute__((aligned(16))) unsigned char lds[];
    Frame F;
    F.lds = (LAS unsigned char*)lds;
    F.MISC = (volatile LAS unsigned*)(F.lds + LDSCTL_OFF);
    F.tid = threadIdx.x; F.lane = F.tid & 63; F.wave = __builtin_amdgcn_readfirstlane(F.tid >> 6);
    F.G = gridDim.x; F.bid = blockIdx.x; { const int bx = blockIdx.x; F.vcu = (F.G % 8 == 0) ? (bx % 8) * (F.G / 8) + bx / 8 : bx; }
    F.ctl = (gu32*)(args.ws + WS_CTL);
    for (int u = F.tid; u < (LDS_BYTES - LDSCTL_OFF) / 4; u += NTHR) ((LAS unsigned*)(F.lds + LDSCTL_OFF))[u] = 0u;
    __syncthreads();
    const int lo = args.ph_lo, hi = args.ph_hi;
    if (hi - lo > 1) (void)xcd_barrier_post((unsigned*)(F.ctl + CW_BAR), F.MISC + 8);
    if (IN(0)) for (int rep_ = 0; rep_ < NREP(1); ++rep_) { FRESH(); ph_prologue(F, WSP); ph_moe_cvt(F, WSP, 0, MOE_CVT_SIDE0);
        if (ROUTER_MFMA) { const float* rw_ = INP(19); bf16* rwb_ = (bf16*)(WSP + WS_XCH); for (int i = F.bid * NTHR + F.tid; i < 16 * 1024; i += F.G * NTHR) rwb_[i] = (bf16)f2bf(rw_[(i & 1023) * 16 + (i >> 10)]); }
        SEAM(0); }

    run_layer<0>(F, lo, hi, lds); run_layer<1>(F, lo, hi, lds); run_layer<2>(F, lo, hi, lds); run_layer<3>(F, lo, hi, lds);
#undef IN
#undef SEAM
#undef WSP
#undef XBF
#undef MIX
#undef KB
#undef VB
#undef tok_e
#undef tok_pos
#undef tok_w
#undef OUTP
#undef cnt
}

extern "C" void kernel_launch(void* const* d_in, const int* in_sizes, int n_in, void* d_out, int out_size, void* d_ws, size_t ws_size, hipStream_t stream) {
    static int grid = 0;
    if (grid == 0) {
        if (n_in != 24 || in_sizes[0] != T * D || out_size != T * D || ws_size < WS_END) { fprintf(stderr, "kernel_launch: unexpected shapes / workspace (n_in %d, ws %zu); nothing launched\n", n_in, ws_size); grid = -1; return; }
        int dev = 0, cus = 0, per_cu = 0;
        if (hipGetDevice(&dev) != hipSuccess || hipDeviceGetAttribute(&cus, hipDeviceAttributeMultiprocessorCount, dev) != hipSuccess) { grid = -1; return; }
        if (hipFuncSetAttribute((const void*)yoco_fwd, hipFuncAttributeMaxDynamicSharedMemorySize, LDS_BYTES) != hipSuccess) { grid = -1; return; }
        if (hipOccupancyMaxActiveBlocksPerMultiprocessor(&per_cu, (const void*)yoco_fwd, NTHR, LDS_BYTES) != hipSuccess || per_cu < 1) { fprintf(stderr, "kernel_launch: occupancy query says %d\n", per_cu); }
        (void)hipGetLastError();
        if (cus != 256) { fprintf(stderr, "kernel_launch: built for a 256-CU device (one 256x256 unit per workgroup in the fused-LayerNorm GEMM phases, three unit slots per workgroup in the MoE GEMMs); got %d CUs; nothing launched\n", cus); grid = -1; return; }
        grid = cus;
    }
    if (grid < 0) return;
    (void)hipMemsetAsync((char*)d_ws + WS_CTL, 0, CTL_ZERO_BYTES, stream);
    Args a{};
    for (int i = 0; i < 24; ++i) a.in[i] = (const float*)d_in[i];
    a.out = (float*)d_out; a.ws = (unsigned char*)d_ws;
#if MK_ONE_LAUNCH
    a.ph_lo = 0; a.ph_hi = N_PHASES;
    hipLaunchKernelGGL(yoco_fwd, dim3(grid), dim3(NTHR), LDS_BYTES, stream, a);
#else
    for (int ph = 0; ph < N_PHASES; ++ph) {
        const int k = (ph - 1) % PH_PER_LAYER, l = (ph - 1) / PH_PER_LAYER;
        if (ph > 0) { if (k > 10) continue; if (k == 3 && l < NSELF) continue; }
        a.ph_lo = ph; a.ph_hi = ph + 1;
        hipLaunchKernelGGL(yoco_fwd, dim3(grid), dim3(NTHR), LDS_BYTES, stream, a);
    }
#endif
}
```
